# Optimizing an MI355X kernel written in HIP

```python
import jax
import jax.numpy as jnp
from jax import lax
import numpy as np

D_MODEL = 1024
BATCH = 1
SEQ = 16384
DEPTH = 4

A_HEADS = 8
A_HEAD_DIM = 64
A_WIDTH = A_HEADS * A_HEAD_DIM
A_DECAY_LORA = 64
A_ICLR_LORA = 64
A_VRES_LORA = 32
A_GATE_LORA = 128
A_GN_EPS = 64e-5
B_HEADS = 8
B_NOPE_DIM = 64
B_ROPE_DIM = 32
B_V_DIM = 64
B_Q_RANK = 384
B_KV_RANK = 256
B_WIDTH = B_HEADS * B_V_DIM
ROPE_THETA = 10000.0
Q_BLOCK = 128
C_HEADS = 4
C_EXPAND = 128
C_HEAD_DIM = 128
C_FDIM = C_HEADS * C_EXPAND
C_WIDTH = C_HEADS * C_HEAD_DIM
C_CHUNK = 64
C_MIN_FORGET = 1e-6
D_FF = 2816
N_BRANCH = 3
MACARON_WEIGHT = 0.5
NORM_EPS = 1e-6

A_SPLITS = (A_WIDTH, A_WIDTH, A_WIDTH, A_DECAY_LORA, A_ICLR_LORA, A_GATE_LORA)
REST_SPLITS = (B_Q_RANK, B_KV_RANK, B_ROPE_DIM, C_FDIM, C_FDIM, C_WIDTH, C_WIDTH, N_BRANCH * D_MODEL)
A_COLS = sum(A_SPLITS)
N_IN = A_COLS + sum(REST_SPLITS)

kernel_name = 'hybrid_rwkv7_mla_hgrn2_macaron'


def split_cols(t, sizes):
    return jnp.split(t, np.cumsum(sizes)[:-1].tolist(), axis=-1)


def rms_norm(x, g):
    x32 = x.astype(jnp.float32)
    y = x32 * lax.rsqrt(jnp.mean(x32 * x32, axis=-1, keepdims=True) + NORM_EPS)
    return (y * g.astype(jnp.float32)).astype(x.dtype)


def token_shift(p):
    return jnp.pad(p, ((0, 0), (1, 0), (0, 0)))[:, :-1]


def shift_mix(p, mu):
    return p + (token_shift(p) - p) * mu


def swiglu(x, w_gate, w_up, w_down):
    return (jax.nn.silu(x @ w_gate) * (x @ w_up)) @ w_down


def rope_tables(positions):
    inv_freq = ROPE_THETA ** (-jnp.arange(0, B_ROPE_DIM, 2, dtype=jnp.float32) / B_ROPE_DIM)
    ang = positions.astype(jnp.float32)[..., None] * inv_freq
    return jnp.cos(ang), jnp.sin(ang)


def apply_rope(x, cos, sin):
    x1, x2 = jnp.split(x.astype(jnp.float32), 2, axis=-1)
    return jnp.concatenate([x1 * cos - x2 * sin, x2 * cos + x1 * sin], axis=-1).astype(x.dtype)


def rwkv7_scan(r, w, k, v, kk, a):
    bsz, _, n_h, n = r.shape

    def step(state, inp):
        r_t, w_t, k_t, v_t, kk_t, a_t = inp
        sa = jnp.einsum('bhvk,bhk->bhv', state, -kk_t)
        state = (state * w_t[:, :, None, :]
                 + sa[..., None] * (kk_t * a_t)[:, :, None, :]
                 + v_t[..., None] * k_t[:, :, None, :])
        return state, jnp.einsum('bhvk,bhk->bhv', state, r_t)

    xs = tuple(jnp.moveaxis(t, 1, 0) for t in (r, w, k, v, kk, a))
    state0 = jnp.zeros((bsz, n_h, n, n), jnp.float32)
    _, y = lax.scan(step, state0, xs)
    return jnp.moveaxis(y, 0, 1)


def rwkv7_branch(r, k, v, wl, al, gl, w0, w_up, a0, a_up, g_up, k_k, k_a, r_k, gn_g, gn_b):
    bsz, seq, _ = r.shape
    f32 = jnp.float32

    def heads(t):
        return t.astype(f32).reshape(bsz, seq, A_HEADS, A_HEAD_DIM)

    w = -jax.nn.softplus(-(w0 + jnp.tanh(wl) @ w_up)) - 0.5
    decay = jnp.exp(-jnp.exp(w.astype(f32)))
    a = jax.nn.sigmoid(a0 + al @ a_up)
    g = jax.nn.sigmoid(gl) @ g_up
    kk = heads(k * k_k)
    kk = kk / jnp.maximum(jnp.sqrt(jnp.sum(kk * kk, axis=-1, keepdims=True)), 1e-12)
    k = k * (1.0 + (a - 1.0) * k_a)
    rh, kh, vh, ah = heads(r), heads(k), heads(v), heads(a)
    y = rwkv7_scan(rh, heads(decay), kh, vh, kk, ah)
    mean = jnp.mean(y, axis=-1, keepdims=True)
    var = jnp.mean(jnp.square(y - mean), axis=-1, keepdims=True)
    y = ((y - mean) * lax.rsqrt(var + A_GN_EPS)).reshape(bsz, seq, A_WIDTH) * gn_g.astype(f32) + gn_b.astype(f32)
    bonus = jnp.sum(rh * kh * r_k.astype(f32), axis=-1, keepdims=True) * vh
    y = y + bonus.reshape(bsz, seq, A_WIDTH)
    return y.astype(r.dtype) * g


def causal_block_attention(q, k, v):
    bsz, seq, n_h, d_qk = q.shape
    n_blk = seq // Q_BLOCK
    scale = d_qk ** -0.5
    q_blocks = jnp.moveaxis(q.reshape(bsz, n_blk, Q_BLOCK, n_h, d_qk), 1, 0)
    k_pos = jnp.arange(seq)
    neg = jnp.finfo(jnp.float32).min

    def one_block(args):
        q_blk, blk = args
        s = jnp.einsum('bqhd,bkhd->bhqk', q_blk, k).astype(jnp.float32) * scale
        q_pos = blk * Q_BLOCK + jnp.arange(Q_BLOCK)
        s = jnp.where(k_pos[None, :] <= q_pos[:, None], s, neg)
        p = jax.nn.softmax(s, axis=-1)
        return jnp.einsum('bhqk,bkhd->bqhd', p.astype(v.dtype), v)

    o = lax.map(one_block, (q_blocks, jnp.arange(n_blk)))
    return jnp.moveaxis(o, 0, 1).reshape(bsz, seq, n_h, v.shape[-1])


def mla_branch(cq, ckv, kr, cos, sin, q_norm_g, w_uq, kv_norm_g, w_ukv):
    bsz, seq, _ = cq.shape
    q = (rms_norm(cq, q_norm_g) @ w_uq).reshape(bsz, seq, B_HEADS, B_NOPE_DIM + B_ROPE_DIM)
    q_nope, q_rope = q[..., :B_NOPE_DIM], q[..., B_NOPE_DIM:]
    q_rope = apply_rope(q_rope, cos[:, :, None], sin[:, :, None])
    kv = (rms_norm(ckv, kv_norm_g) @ w_ukv).reshape(bsz, seq, B_HEADS, B_NOPE_DIM + B_V_DIM)
    k_nope, v = kv[..., :B_NOPE_DIM], kv[..., B_NOPE_DIM:]
    k_rope = apply_rope(kr, cos, sin)[:, :, None, :]
    k = jnp.concatenate([k_nope, jnp.broadcast_to(k_rope, (bsz, seq, B_HEADS, B_ROPE_DIM))], axis=-1)
    q = jnp.concatenate([q_nope, q_rope], axis=-1)
    o = causal_block_attention(q, k, v)
    return o.reshape(bsz, seq, B_WIDTH)


def hgrn2_chunk_scan(q, k, log_f, v):
    bsz, seq, n_h, d_k = q.shape
    d_v = v.shape[-1]
    n_chunk = seq // C_CHUNK

    def to_chunks(t):
        return jnp.moveaxis(t.reshape(bsz, n_chunk, C_CHUNK, *t.shape[2:]), 1, 0)

    causal = jnp.tril(jnp.ones((C_CHUNK, C_CHUNK), dtype=bool))[None, :, :, None, None]

    def step(state, inp):
        qc, kc, lfc, vc = inp
        b = jnp.cumsum(lfc, axis=1)
        diff = b[:, :, None] - b[:, None, :]
        decay = jnp.where(causal, jnp.exp(jnp.where(causal, diff, 0.0)), 0.0)
        attn = jnp.einsum('bthk,btshk,bshk->btsh', qc, decay, kc)
        o = (jnp.einsum('btsh,bshv->bthv', attn, vc)
             + jnp.einsum('bthk,bhkv->bthv', qc * jnp.exp(b), state))
        b_last = b[:, -1]
        state = (jnp.exp(b_last)[..., None] * state
                 + jnp.einsum('bshk,bshv->bhkv', kc * jnp.exp(b_last[:, None] - b), vc))
        return state, o

    state0 = jnp.zeros((bsz, n_h, d_k, d_v), jnp.float32)
    _, o = lax.scan(step, state0, tuple(to_chunks(t) for t in (q, k, log_f, v)))
    return jnp.moveaxis(o, 0, 1).reshape(bsz, seq, n_h, d_v)


def hgrn2_branch(cq, cf, ci, cg, lb, norm_g):
    bsz, seq, _ = cq.shape
    f32 = jnp.float32
    fz = cf.astype(f32)
    lb = lb.astype(f32)
    f = lb + (1.0 - lb) * jax.nn.sigmoid(fz)
    log_f = jnp.log(jnp.maximum(f, C_MIN_FORGET))
    k = (1.0 - lb) * jax.nn.sigmoid(-fz)
    q = jax.nn.silu(cq.astype(f32))

    def fheads(t):
        return t.reshape(bsz, seq, C_HEADS, C_EXPAND)

    o = hgrn2_chunk_scan(fheads(q), fheads(k), fheads(log_f),
                         ci.astype(f32).reshape(bsz, seq, C_HEADS, C_HEAD_DIM))
    o = rms_norm(o, norm_g) * jax.nn.silu(cg.astype(f32)).reshape(bsz, seq, C_HEADS, C_HEAD_DIM)
    return o.reshape(bsz, seq, C_WIDTH).astype(cq.dtype)


def setup_inputs(seed: int = 0) -> dict:
    key = jax.random.key(seed)
    it = iter(list(jax.random.split(key, 48)))
    f32 = jnp.float32
    L = DEPTH

    def dense(shape):
        return jax.random.normal(next(it), shape, f32) * (shape[-2] ** -0.5)

    def gain(shape):
        return 1.0 + 0.05 * jax.random.normal(next(it), shape, f32)

    def noise(shape, scale, offset=0.0):
        return offset + scale * jax.random.normal(next(it), shape, f32)

    def mix_coef(shape):
        return jax.random.uniform(next(it), shape, f32, 0.05, 0.95)

    return {
        'x': jax.random.normal(next(it), (BATCH, SEQ, D_MODEL), f32),
        'positions': jnp.broadcast_to(jnp.arange(SEQ, dtype=jnp.int32), (BATCH, SEQ)),
        'ffn1_pre_g': gain((L, D_MODEL)),
        'ffn1_post_g': gain((L, D_MODEL)),
        'ffn1_w_gate': dense((L, D_MODEL, D_FF)),
        'ffn1_w_up': dense((L, D_MODEL, D_FF)),
        'ffn1_w_down': dense((L, D_FF, D_MODEL)),
        'mix_pre_g': gain((L, D_MODEL)),
        'mix_post_g': gain((L, D_MODEL)),
        'w_in': dense((L, D_MODEL, N_IN)),
        'rwkv_mu': mix_coef((L, A_COLS)),
        'rwkv_w0': noise((L, A_WIDTH), 0.5),
        'rwkv_w_up': dense((L, A_DECAY_LORA, A_WIDTH)),
        'rwkv_a0': noise((L, A_WIDTH), 0.1),
        'rwkv_a_up': dense((L, A_ICLR_LORA, A_WIDTH)),
        'rwkv_g_up': dense((L, A_GATE_LORA, A_WIDTH)),
        'rwkv_k_k': noise((L, A_WIDTH), 0.05, 0.85),
        'rwkv_k_a': gain((L, A_WIDTH)),
        'rwkv_r_k': noise((L, A_HEADS, A_HEAD_DIM), 0.1),
        'rwkv_gn_g': gain((L, A_WIDTH)),
        'rwkv_gn_b': noise((L, A_WIDTH), 0.02),
        'rwkv_vres_down': dense((L - 1, D_MODEL, A_VRES_LORA)),
        'rwkv_vres_mu': mix_coef((L - 1, A_VRES_LORA)),
        'rwkv_vres_up': dense((L - 1, A_VRES_LORA, A_WIDTH)),
        'rwkv_v0': noise((L - 1, A_WIDTH), 0.1, 1.0),
        'rwkv_out': dense((L, A_WIDTH, D_MODEL)),
        'mla_q_norm_g': gain((L, B_Q_RANK)),
        'mla_w_uq': dense((L, B_Q_RANK, B_HEADS * (B_NOPE_DIM + B_ROPE_DIM))),
        'mla_kv_norm_g': gain((L, B_KV_RANK)),
        'mla_w_ukv': dense((L, B_KV_RANK, B_HEADS * (B_NOPE_DIM + B_V_DIM))),
        'mla_out': dense((L, B_WIDTH, D_MODEL)),
        'hgrn_lower_bounds': gain((L, C_FDIM)),
        'hgrn_norm_g': gain((L, C_HEAD_DIM)),
        'hgrn_out': dense((L, C_WIDTH, D_MODEL)),
        'w_o': dense((L, D_MODEL, D_MODEL)),
        'ffn2_pre_g': gain((L, D_MODEL)),
        'ffn2_post_g': gain((L, D_MODEL)),
        'ffn2_w_gate': dense((L, D_MODEL, D_FF)),
        'ffn2_w_up': dense((L, D_MODEL, D_FF)),
        'ffn2_w_down': dense((L, D_FF, D_MODEL)),
    }


def reference(x, positions, ffn1_pre_g, ffn1_post_g, ffn1_w_gate, ffn1_w_up, ffn1_w_down,
              mix_pre_g, mix_post_g, w_in,
              rwkv_mu, rwkv_w0, rwkv_w_up, rwkv_a0, rwkv_a_up, rwkv_g_up, rwkv_k_k, rwkv_k_a, rwkv_r_k,
              rwkv_gn_g, rwkv_gn_b, rwkv_vres_down, rwkv_vres_mu, rwkv_vres_up, rwkv_v0, rwkv_out,
              mla_q_norm_g, mla_w_uq, mla_kv_norm_g, mla_w_ukv, mla_out,
              hgrn_lower_bounds, hgrn_norm_g, hgrn_out,
              w_o, ffn2_pre_g, ffn2_post_g, ffn2_w_gate, ffn2_w_up, ffn2_w_down):
    bsz, seq, _ = x.shape
    cos, sin = rope_tables(positions)
    lb_p = jax.nn.softmax(hgrn_lower_bounds.astype(jnp.float32), axis=0)
    lower_bounds = jnp.cumsum(lb_p, axis=0) - lb_p[0]
    h = x
    v_first = None
    for l in range(DEPTH):
        y = swiglu(rms_norm(h, ffn1_pre_g[l]), ffn1_w_gate[l], ffn1_w_up[l], ffn1_w_down[l])
        h = h + MACARON_WEIGHT * rms_norm(y, ffn1_post_g[l])

        u = rms_norm(h, mix_pre_g[l])
        if l == 0:
            proj = u @ w_in[l]
        else:
            proj = u @ jnp.concatenate([w_in[l], rwkv_vres_down[l - 1]], axis=1)
        a_r, a_k, a_v, a_wl, a_al, a_gl = split_cols(shift_mix(proj[..., :A_COLS], rwkv_mu[l]), A_SPLITS)
        b_cq, b_ckv, b_kr, c_q, c_f, c_i, c_g, gate_logits = split_cols(proj[..., A_COLS:N_IN], REST_SPLITS)
        if l == 0:
            v_first = a_v
        else:
            a_vl = shift_mix(proj[..., N_IN:], rwkv_vres_mu[l - 1])
            a_v = a_v + (v_first - a_v) * jax.nn.sigmoid(rwkv_v0[l - 1] + a_vl @ rwkv_vres_up[l - 1])

        y_a = rwkv7_branch(a_r, a_k, a_v, a_wl, a_al, a_gl, rwkv_w0[l], rwkv_w_up[l], rwkv_a0[l],
                           rwkv_a_up[l], rwkv_g_up[l], rwkv_k_k[l], rwkv_k_a[l], rwkv_r_k[l],
                           rwkv_gn_g[l], rwkv_gn_b[l])
        y_b = mla_branch(b_cq, b_ckv, b_kr, cos, sin, mla_q_norm_g[l], mla_w_uq[l],
                         mla_kv_norm_g[l], mla_w_ukv[l])
        y_c = hgrn2_branch(c_q, c_f, c_i, c_g, lower_bounds[l], hgrn_norm_g[l])

        gates = jax.nn.sigmoid(gate_logits).reshape(bsz, seq, N_BRANCH, D_MODEL)
        merged = (gates[:, :, 0] * (y_a @ rwkv_out[l])
                  + gates[:, :, 1] * (y_b @ mla_out[l])
                  + gates[:, :, 2] * (y_c @ hgrn_out[l]))
        h = h + rms_norm(merged @ w_o[l], mix_post_g[l])

        y = swiglu(rms_norm(h, ffn2_pre_g[l]), ffn2_w_gate[l], ffn2_w_up[l], ffn2_w_down[l])
        h = h + MACARON_WEIGHT * rms_norm(y, ffn2_post_g[l])
    return h
```

```cpp
#include <hip/hip_runtime.h>
#include <hip/hip_cooperative_groups.h>
#include <cstdio>
#include <cstdint>
namespace cg = cooperative_groups;
__device__ __forceinline__ int opaque_tid() { int t = threadIdx.x; asm volatile("" : "+v"(t)); return t; }
__device__ __forceinline__ unsigned char* opaque_ptr(unsigned char* p) {
    const unsigned long long v = (unsigned long long)p;
    unsigned lo = __builtin_amdgcn_readfirstlane((unsigned)v), hi = __builtin_amdgcn_readfirstlane((unsigned)(v >> 32));
    asm volatile("" : "+s"(lo), "+s"(hi));
    return (unsigned char*)(__attribute__((address_space(1))) unsigned char*)(((unsigned long long)hi << 32) | lo);
}
#define GAS1 __attribute__((address_space(1)))
#define GPF(p) ((const float*)(const GAS1 float*)(p))
#define GPI(p) ((const int*)(const GAS1 int*)(p))
#define PHASE_IDS const int tid = opaque_tid(), lane = tid & 63, wave = __builtin_amdgcn_readfirstlane(tid >> 6), bid = blockIdx.x, G = gridDim.x, gw = bid * 8 + wave, ngw = G * 8, gtid = bid * 512 + tid, gthreads = G * 512; (void)lane; (void)gw; (void)ngw; (void)gtid; (void)gthreads;
namespace pg8 {
#define PG8_LAS __attribute__((address_space(3)))
typedef unsigned short bf16_t;
typedef short bf16x8 __attribute__((ext_vector_type(8)));
typedef float f32x4 __attribute__((ext_vector_type(4)));
typedef unsigned u32x4 __attribute__((ext_vector_type(4)));
constexpr int BM = 256, BK = 64, HALF = 128, HTB = HALF * BK * 2  , STAGE_BYTES = 8 * HTB, NXCD = 8, WGM = 8;

__host__ __device__ __forceinline__ int lds_byte(int r, int c) { const int st = (r >> 4) * 2 + (c >> 5), rr = r & 15, cc = c & 31, ob = rr * 64 + cc * 2; return st * 1024 + (ob ^ (((ob >> 9) & 1) << 5)); }
__host__ __device__ __forceinline__ void stage_rc(int b, int& R, int& C) { const int st = b / 1024, sb = b % 1024, swz = sb ^ (((sb >> 9) & 1) << 5); R = (st >> 1) * 16 + swz / 64; C = (st & 1) * 32 + (swz % 64) / 2; }
__host__ __device__ __forceinline__ int perm32(int rho) { const int n = rho >> 4, i = rho & 15; return 8 * (i >> 2) + 4 * n + (i & 3); }

struct Unit { int pm, pn; };
struct Gemm { const bf16_t* A; const bf16_t* Bt; int M, N, K; };

struct StaticOrder {
    int nM, nN, nwg, G, c;
    __host__ __device__ void init(int M, int N, int G_, int c_) { nM = M / BM; nN = N / BM; nwg = nM * nN; G = G_; c = c_; }
    __host__ __device__ bool next(int i, Unit& u) const {
        const long L = (long)i * G + c; if (L >= nwg) return false;
        int wgid = (int)L; { const int q = nwg / NXCD, r = nwg % NXCD, xcd = wgid % NXCD, off = wgid / NXCD; wgid = (xcd < r ? xcd * (q + 1) : r * (q + 1) + (xcd - r) * q) + off; }
        const int nig = WGM * nN, gid = wgid / nig, fm = gid * WGM, gsz = (nM - fm) < WGM ? (nM - fm) : WGM;
        u.pm = fm + ((wgid % nig) % gsz); u.pn = (wgid % nig) / gsz; return true;
    }
    __device__ __forceinline__ void a_ready(const Unit&) const {}
    __device__ __forceinline__ void done(const Unit&) const {}
};

typedef float f32x2e __attribute__((ext_vector_type(2))); typedef __bf16 bf16x2e __attribute__((ext_vector_type(2)));
__device__ __forceinline__ unsigned cvt_pk_bf16(float lo, float hi) { f32x2e v = {lo, hi}; bf16x2e b = __builtin_convertvector(v, bf16x2e); return __builtin_bit_cast(unsigned, b); }
__device__ __forceinline__ float bflo(unsigned w) { return __uint_as_float(w << 16); }
__device__ __forceinline__ float bfhi(unsigned w) { return __uint_as_float(w & 0xffff0000u); }
__device__ __forceinline__ float sigm(float x) { return 1.0f / (1.0f + __expf(-x)); }

struct EpiBf16Split {
    static constexpr bool PERM = true, AFTER_DRAIN = false;
    bf16_t* O0; int ld0; int split_pn; bf16_t* O1; int ld1;
    __device__ __forceinline__ void operator()(const f32x4 (&acc)[2][2][4][2], const Unit& u, int wr, int wc, int fr, int fq) const {
        int pn = u.pn; bf16_t* base = O0; int ld = ld0;
        if (pn >= split_pn) { pn -= split_pn; base = O1; ld = ld1; }
        const int row0 = u.pm * BM + wr * 64 + fr, col0 = pn * BM + wc * 32 + 8 * fq;
#pragma unroll
        for (int ai = 0; ai < 2; ++ai)
#pragma unroll
            for (int m = 0; m < 4; ++m) { bf16_t* rowp = base + (size_t)(row0 + ai * HALF + m * 16) * ld + col0;
#pragma unroll
                for (int bj = 0; bj < 2; ++bj) { const f32x4 v0 = acc[ai][bj][m][0], v1 = acc[ai][bj][m][1];
                    u32x4 w; w.x = cvt_pk_bf16(v0[0], v0[1]); w.y = cvt_pk_bf16(v0[2], v0[3]); w.z = cvt_pk_bf16(v1[0], v1[1]); w.w = cvt_pk_bf16(v1[2], v1[3]);
                    *(u32x4*)(rowp + bj * HALF) = w; } }
    }
};
struct EpiF32 {
    static constexpr bool PERM = false, AFTER_DRAIN = false;
    float* O; int ldc;
    __device__ __forceinline__ void operator()(const f32x4 (&acc)[2][2][4][2], const Unit& u, int wr, int wc, int fr, int fq) const {
        const int row0 = u.pm * BM + wr * 64 + fr, col0 = u.pn * BM + wc * 32 + 4 * fq;
#pragma unroll
        for (int ai = 0; ai < 2; ++ai)
#pragma unroll
            for (int m = 0; m < 4; ++m) { float* rowp = O + (size_t)(row0 + ai * HALF + m * 16) * ldc + col0;
#pragma unroll
                for (int bj = 0; bj < 2; ++bj)
#pragma unroll
                    for (int n = 0; n < 2; ++n) *(f32x4*)(rowp + bj * HALF + n * 16) = acc[ai][bj][m][n]; }
    }
};
struct EpiSwiGLU {
    static constexpr bool PERM = false, AFTER_DRAIN = false;
    bf16_t* O; int ldo;
    __device__ __forceinline__ void operator()(const f32x4 (&acc)[2][2][4][2], const Unit& u, int wr, int wc, int fr, int fq) const {
        const int row0 = u.pm * BM + wr * 64 + fr, j0 = u.pn * 128 + wc * 16 + 4 * fq;
#pragma unroll
        for (int ai = 0; ai < 2; ++ai)
#pragma unroll
            for (int m = 0; m < 4; ++m) { bf16_t* rowp = O + (size_t)(row0 + ai * HALF + m * 16) * ldo + j0;
#pragma unroll
                for (int bj = 0; bj < 2; ++bj) { const f32x4 g = acc[ai][bj][m][0], up = acc[ai][bj][m][1];
                    float a[4];
#pragma unroll
                    for (int i = 0; i < 4; ++i) a[i] = g[i] * sigm(g[i]) * up[i];
                    unsigned long long w = (unsigned long long)cvt_pk_bf16(a[0], a[1]) | ((unsigned long long)cvt_pk_bf16(a[2], a[3]) << 32);
                    *(unsigned long long*)(rowp + bj * 64) = w; } }
    }
};
struct EpiGate {
    static constexpr bool PERM = true, AFTER_DRAIN = false;
    const bf16_t* G; int ldg; bf16_t* O; int ldo; int first;
    __device__ __forceinline__ void operator()(const f32x4 (&acc)[2][2][4][2], const Unit& u, int wr, int wc, int fr, int fq) const {
        const int row0 = u.pm * BM + wr * 64 + fr, col0 = u.pn * BM + wc * 32 + 8 * fq;
#pragma unroll
        for (int ai = 0; ai < 2; ++ai)
#pragma unroll
            for (int m = 0; m < 4; ++m) { const size_t row = (size_t)(row0 + ai * HALF + m * 16);
#pragma unroll
                for (int bj = 0; bj < 2; ++bj) { const f32x4 v0 = acc[ai][bj][m][0], v1 = acc[ai][bj][m][1];
                    const u32x4 gw = *(const u32x4*)(G + row * ldg + col0 + bj * HALF);
                    float r[8];
                    r[0] = sigm(bflo(gw.x)) * v0[0]; r[1] = sigm(bfhi(gw.x)) * v0[1]; r[2] = sigm(bflo(gw.y)) * v0[2]; r[3] = sigm(bfhi(gw.y)) * v0[3];
                    r[4] = sigm(bflo(gw.z)) * v1[0]; r[5] = sigm(bfhi(gw.z)) * v1[1]; r[6] = sigm(bflo(gw.w)) * v1[2]; r[7] = sigm(bfhi(gw.w)) * v1[3];
                    bf16_t* op = O + row * ldo + col0 + bj * HALF;
                    if (!first) { const u32x4 ow = *(const u32x4*)op;
                        r[0] += bflo(ow.x); r[1] += bfhi(ow.x); r[2] += bflo(ow.y); r[3] += bfhi(ow.y); r[4] += bflo(ow.z); r[5] += bfhi(ow.z); r[6] += bflo(ow.w); r[7] += bfhi(ow.w); }
                    u32x4 w; w.x = cvt_pk_bf16(r[0], r[1]); w.y = cvt_pk_bf16(r[2], r[3]); w.z = cvt_pk_bf16(r[4], r[5]); w.w = cvt_pk_bf16(r[6], r[7]);
                    *(u32x4*)op = w; } }
    }
};

struct EpiGate3 {
    static constexpr bool PERM = true, AFTER_DRAIN = false;
    const bf16_t* G; int ldg; bf16_t* O; int ldo;
    __device__ __forceinline__ void operator()(const f32x4 (&acc)[2][2][4][2], const Unit& u, int wr, int wc, int fr, int fq) const {
        const int br = u.pm >> 6, pm = u.pm & 63, pn = u.pn & 3;
        const int row0 = pm * BM + wr * 64 + fr, col0 = pn * BM + wc * 32 + 8 * fq;
        const bf16_t* Gb = G + br * 1024;
#pragma unroll
        for (int ai = 0; ai < 2; ++ai)
#pragma unroll
            for (int m = 0; m < 4; ++m) { const size_t row = (size_t)(row0 + ai * HALF + m * 16);
#pragma unroll
                for (int bj = 0; bj < 2; ++bj) { const f32x4 v0 = acc[ai][bj][m][0], v1 = acc[ai][bj][m][1];
                    const u32x4 gw = *(const u32x4*)(Gb + row * ldg + col0 + bj * HALF);
                    float r[8];
                    r[0] = sigm(bflo(gw.x)) * v0[0]; r[1] = sigm(bfhi(gw.x)) * v0[1]; r[2] = sigm(bflo(gw.y)) * v0[2]; r[3] = sigm(bfhi(gw.y)) * v0[3];
                    r[4] = sigm(bflo(gw.z)) * v1[0]; r[5] = sigm(bfhi(gw.z)) * v1[1]; r[6] = sigm(bflo(gw.w)) * v1[2]; r[7] = sigm(bfhi(gw.w)) * v1[3];
                    bf16_t* op = O + row * ldo + col0 + bj * HALF;
                    if (br != 0) { const u32x4 ow = *(const u32x4*)op;
                        r[0] += bflo(ow.x); r[1] += bfhi(ow.x); r[2] += bflo(ow.y); r[3] += bfhi(ow.y); r[4] += bflo(ow.z); r[5] += bfhi(ow.z); r[6] += bflo(ow.w); r[7] += bfhi(ow.w); }
                    u32x4 w; w.x = cvt_pk_bf16(r[0], r[1]); w.y = cvt_pk_bf16(r[2], r[3]); w.z = cvt_pk_bf16(r[4], r[5]); w.w = cvt_pk_bf16(r[6], r[7]);
                    *(u32x4*)op = w; } }
    }
};
struct MergeOrder {
    StaticOrder base;
    __device__ bool next(int i, Unit& u) const { Unit b; if (!base.next(i / 3, b)) return false; const int br = i % 3; u.pm = br * 64 + b.pm; u.pn = br * 4 + b.pn; return true; }
    __device__ __forceinline__ void a_ready(const Unit&) const {}
    __device__ __forceinline__ void done(const Unit&) const {}
};
template <class Epi, class Sched, bool ALIGN_EPI = false, bool SP2 = false>
__device__ __forceinline__ void gemm_phase(PG8_LAS unsigned char* lds, const Gemm g, const Sched& S, const Epi& E) {
    const int tid = opaque_tid(), wid = __builtin_amdgcn_readfirstlane(tid >> 6), lane = tid & 63, wr = wid >> 2, wc = wid & 3, fr = lane & 15, fq = lane >> 4;
    const int K = g.K, nt = K / BK;
    unsigned voffA[2], voffB[2];
#pragma unroll
    for (int i = 0; i < 2; ++i) { int R, C; stage_rc(tid * 16 + i * 8192, R, C); const int Rb = Epi::PERM ? ((R & ~31) + perm32(R & 31)) : R;
        voffA[i] = (unsigned)(R * K + C) * 2u; voffB[i] = (unsigned)(Rb * K + C) * 2u; }
    const size_t kstep = (size_t)(BK * 2);
    const size_t hstep = (size_t)HALF * K * 2;
    const size_t tstep = 2 * hstep;
    const unsigned ldsw = (unsigned)wid * 1024u;
    const int aoff = lds_byte(wr * 64 + fr, fq * 8), boff = lds_byte(wc * 32 + fr, fq * 8);
#define PG8_SA(b, h) (((b) * 2 + (h)) * HTB)
#define PG8_SB(b, h) ((4 + (b) * 2 + (h)) * HTB)
#define PG8_STAGE(bufoff, gbase, voff) do { _Pragma("unroll") for (int _i = 0; _i < 2; ++_i) \
        __builtin_amdgcn_global_load_lds((const unsigned*)((const char*)(gbase) + (voff)[_i]), (PG8_LAS unsigned*)(lds + (bufoff) + ldsw + _i * 8192), 16, 0, 0); } while (0)
#define PG8_LDA(dst, b, h) do { _Pragma("unroll") for (int m = 0; m < 4; ++m) _Pragma("unroll") for (int k = 0; k < 2; ++k) dst[m][k] = *(const PG8_LAS bf16x8*)(lds + PG8_SA(b, h) + aoff + m * 2048 + k * 1024); } while (0)
#define PG8_LDB(dst, b, h) do { _Pragma("unroll") for (int n = 0; n < 2; ++n) _Pragma("unroll") for (int k = 0; k < 2; ++k) dst[n][k] = *(const PG8_LAS bf16x8*)(lds + PG8_SB(b, h) + boff + n * 2048 + k * 1024); } while (0)
#define PG8_MMA(ai, bj, At, Bt) do { __builtin_amdgcn_s_setprio(1); _Pragma("unroll") for (int m = 0; m < 4; ++m) _Pragma("unroll") for (int n = 0; n < 2; ++n) _Pragma("unroll") for (int k = 0; k < 2; ++k) \
        acc[ai][bj][m][n] = __builtin_amdgcn_mfma_f32_16x16x32_bf16(Bt[n][k], At[m][k], acc[ai][bj][m][n], 0, 0, 0); __builtin_amdgcn_s_setprio(0); } while (0)
#define PG8_WAIT_V(n) asm volatile("s_waitcnt vmcnt(" #n ")" ::: "memory")
#define PG8_WAIT_L(n) asm volatile("s_waitcnt lgkmcnt(" #n ")" ::: "memory")
#define PG8_BAR __builtin_amdgcn_s_barrier()
#define PG8_SCHED __builtin_amdgcn_sched_barrier(0)
    Unit cur, nxt; int ui = 0;
    if (!S.next(0, cur)) return;
    f32x4 acc[2][2][4][2];
#pragma unroll
    for (int a = 0; a < 2; ++a)
#pragma unroll
        for (int b = 0; b < 2; ++b)
#pragma unroll
            for (int m = 0; m < 4; ++m)
#pragma unroll
                for (int n = 0; n < 2; ++n) acc[a][b][m][n] = (f32x4){0.f, 0.f, 0.f, 0.f};
    bf16x8 At[4][2], B0[2][2], B1[2][2];
    const char* cA = (const char*)g.A + (size_t)cur.pm * tstep; const char* cB = (const char*)g.Bt + (size_t)cur.pn * tstep;
    S.a_ready(cur);
    if constexpr (SP2) {
        PG8_STAGE(PG8_SB(0, 0), cB, voffB); PG8_STAGE(PG8_SB(0, 1), cB + hstep, voffB); PG8_STAGE(PG8_SA(0, 0), cA, voffA); PG8_STAGE(PG8_SA(0, 1), cA + hstep, voffA);
        if (wr == 1) PG8_BAR;
        PG8_WAIT_V(2); PG8_BAR;
        PG8_STAGE(PG8_SB(1, 0), cB + kstep, voffB); PG8_STAGE(PG8_SA(1, 0), cA + kstep, voffA); PG8_STAGE(PG8_SB(1, 1), cB + hstep + kstep, voffB);
        PG8_WAIT_V(6); PG8_BAR;
    } else {
        PG8_STAGE(PG8_SB(0, 0), cB, voffB); PG8_STAGE(PG8_SA(0, 0), cA, voffA); PG8_STAGE(PG8_SB(0, 1), cB + hstep, voffB); PG8_STAGE(PG8_SA(0, 1), cA + hstep, voffA);
        if (wr == 1) PG8_BAR;
        PG8_WAIT_V(4); PG8_BAR;
        PG8_STAGE(PG8_SB(1, 0), cB + kstep, voffB); PG8_STAGE(PG8_SA(1, 0), cA + kstep, voffA); PG8_STAGE(PG8_SB(1, 1), cB + hstep + kstep, voffB);
        PG8_WAIT_V(6); PG8_BAR;
    }
    for (;;) {
        const bool has_next = S.next(ui + 1, nxt);
        const char* nA = has_next ? (const char*)g.A + (size_t)nxt.pm * tstep : cA; const char* nB = has_next ? (const char*)g.Bt + (size_t)nxt.pn * tstep : cB;
        for (int t = 0; t < nt; t += 2) {
            const bool last = (t == nt - 2);
            const char* a1 = cA + (size_t)(t + 1) * kstep;
            const char* a2 = last ? nA : cA + (size_t)(t + 2) * kstep; const char* b2 = last ? nB : cB + (size_t)(t + 2) * kstep;
            const char* a3 = a2 + kstep; const char* b3 = b2 + kstep;
            if (last && has_next) S.a_ready(nxt);
            if constexpr (SP2) {
            PG8_LDB(B0, 0, 0); PG8_LDB(B1, 0, 1); PG8_SCHED; PG8_LDA(At, 0, 0); PG8_STAGE(PG8_SA(1, 1), a1 + hstep, voffA);
            PG8_WAIT_V(8); PG8_WAIT_L(0); PG8_BAR; PG8_MMA(0, 0, At, B0); PG8_MMA(0, 1, At, B1); PG8_BAR; PG8_SCHED;
            PG8_LDA(At, 0, 1); PG8_STAGE(PG8_SB(0, 0), b2, voffB); PG8_STAGE(PG8_SB(0, 1), b2 + hstep, voffB); PG8_STAGE(PG8_SA(0, 0), a2, voffA);
            PG8_WAIT_V(8); PG8_WAIT_L(0); PG8_BAR; PG8_MMA(1, 0, At, B0); PG8_MMA(1, 1, At, B1); PG8_BAR; PG8_SCHED;
            PG8_LDB(B0, 1, 0); PG8_LDB(B1, 1, 1); PG8_SCHED; PG8_LDA(At, 1, 0); PG8_STAGE(PG8_SA(0, 1), a2 + hstep, voffA);
            PG8_WAIT_V(8); PG8_WAIT_L(0); PG8_BAR; PG8_MMA(0, 0, At, B0); PG8_MMA(0, 1, At, B1); PG8_BAR; PG8_SCHED;
            PG8_LDA(At, 1, 1); PG8_STAGE(PG8_SB(1, 0), b3, voffB); PG8_STAGE(PG8_SB(1, 1), b3 + hstep, voffB); PG8_STAGE(PG8_SA(1, 0), a3, voffA);
            PG8_WAIT_V(8); PG8_WAIT_L(0); PG8_BAR; PG8_MMA(1, 0, At, B0); PG8_MMA(1, 1, At, B1); PG8_BAR; PG8_SCHED;
            } else {
            PG8_LDB(B0, 0, 0); PG8_SCHED; PG8_LDA(At, 0, 0); PG8_STAGE(PG8_SA(1, 1), a1 + hstep, voffA);
            PG8_WAIT_L(8); PG8_BAR; PG8_WAIT_L(0); PG8_MMA(0, 0, At, B0); PG8_BAR; PG8_SCHED;
            PG8_LDB(B1, 0, 1); PG8_STAGE(PG8_SB(0, 0), b2, voffB);
            PG8_BAR; PG8_WAIT_L(0); PG8_MMA(0, 1, At, B1); PG8_BAR;
            PG8_LDA(At, 0, 1); PG8_STAGE(PG8_SA(0, 0), a2, voffA);
            PG8_BAR; PG8_WAIT_L(0); PG8_MMA(1, 0, At, B0); PG8_BAR; PG8_SCHED;
            PG8_STAGE(PG8_SB(0, 1), b2 + hstep, voffB);
            PG8_WAIT_V(6); PG8_BAR; PG8_MMA(1, 1, At, B1); PG8_BAR;
            PG8_LDB(B0, 1, 0); PG8_SCHED; PG8_LDA(At, 1, 0); PG8_STAGE(PG8_SA(0, 1), a2 + hstep, voffA);
            PG8_WAIT_L(8); PG8_BAR; PG8_WAIT_L(0); PG8_MMA(0, 0, At, B0); PG8_BAR; PG8_SCHED;
            PG8_LDB(B1, 1, 1); PG8_STAGE(PG8_SB(1, 0), b3, voffB);
            PG8_BAR; PG8_WAIT_L(0); PG8_MMA(0, 1, At, B1); PG8_BAR;
            PG8_LDA(At, 1, 1); PG8_STAGE(PG8_SA(1, 0), a3, voffA);
            PG8_BAR; PG8_WAIT_L(0); PG8_MMA(1, 0, At, B0); PG8_BAR; PG8_SCHED;
            PG8_STAGE(PG8_SB(1, 1), b3 + hstep, voffB);
            PG8_WAIT_V(6); PG8_BAR; PG8_MMA(1, 1, At, B1); PG8_BAR;
            }
        }
        if constexpr (ALIGN_EPI) { if (wr == 0) PG8_BAR; }
        if constexpr (!Epi::AFTER_DRAIN) { E(acc, cur, wr, wc, fr, fq); S.done(cur); }
        if (!has_next) break;
#pragma unroll
        for (int a = 0; a < 2; ++a)
#pragma unroll
            for (int b = 0; b < 2; ++b)
#pragma unroll
                for (int m = 0; m < 4; ++m)
#pragma unroll
                    for (int n = 0; n < 2; ++n) acc[a][b][m][n] = (f32x4){0.f, 0.f, 0.f, 0.f};
        cur = nxt; cA = nA; cB = nB; ++ui;
        if constexpr (ALIGN_EPI) { if (wr == 1) PG8_BAR; }
    }
    PG8_WAIT_V(0);
    if constexpr (!ALIGN_EPI) { if (wr == 0) PG8_BAR; }
    PG8_BAR;
    if constexpr (Epi::AFTER_DRAIN) { E.fused(acc, cur, wr, wc, fr, fq, lds, wid, lane); S.done(cur); }
#undef PG8_SA
#undef PG8_SB
#undef PG8_STAGE
#undef PG8_LDA
#undef PG8_LDB
#undef PG8_MMA
#undef PG8_WAIT_V
#undef PG8_WAIT_L
#undef PG8_BAR
#undef PG8_SCHED
}
}
constexpr int T = 16384, DM = 1024, NL = 4, DFF = 2816;
constexpr int NP1 = 2560, NP2 = 5120;
constexpr int C1_VRES = 1792, C1_CQ = 1824, C1_CKV = 2208, C1_KR = 2464;
constexpr int C2_HQ = 0, C2_HF = 512, C2_HI = 1024, C2_HG = 1536, C2_GATE = 2048;
constexpr float NORM_EPS = 1e-6f;
constexpr float QSCALE = 0.10206207261596575f * 1.4426950408889634f;
constexpr float LOG2E = 1.4426950408889634f;

constexpr size_t MiB = 1u << 20;
constexpr size_t WS_CTL = 0;
constexpr size_t WS_COS = 1 * MiB, WS_SIN = 2 * MiB, WS_LB = 3 * MiB;
constexpr size_t WS_WA = 4 * MiB;
constexpr size_t WA_GU = WS_WA, WA_D = WS_WA + (size_t)5632 * 1024 * 2;
constexpr size_t WS_WB = 22 * MiB;
constexpr size_t WB_IN = WS_WB;
constexpr size_t WB_LORA = WB_IN + (size_t)7680 * 1024 * 2;
constexpr size_t WB_UQ = WB_LORA + (size_t)2048 * 384 * 2;
constexpr size_t WB_UK = WB_UQ + (size_t)768 * 384 * 2;
constexpr size_t WB_UV = WB_UK + (size_t)512 * 256 * 2;
constexpr size_t WB_OUT = WB_UV + (size_t)512 * 256 * 2;
constexpr size_t WB_O = WB_OUT + (size_t)3 * 1024 * 512 * 2;
static_assert(WB_O + (size_t)1024 * 1024 * 2 <= 46 * MiB, "W_B region");
static_assert(WA_D + (size_t)1024 * 2816 * 2 <= 22 * MiB, "W_A region");
constexpr size_t WS_VFIRST = 46 * MiB;
constexpr size_t WS_P1 = 62 * MiB;
constexpr size_t WS_P2 = 142 * MiB;
constexpr size_t WS_ACT = WS_P1;
constexpr size_t WS_LORA = WS_P1;
constexpr size_t WS_YA = 382 * MiB;
constexpr size_t WS_MERGED = WS_P1;
constexpr size_t WS_Y = 302 * MiB;
constexpr size_t WS_XN = 366 * MiB;
constexpr size_t WS_RB = 302 * MiB, WS_KB = 318 * MiB, WS_VB = 334 * MiB;
constexpr size_t WS_Q = 350 * MiB;
constexpr size_t WS_KNOPE = 374 * MiB;
constexpr size_t WS_LIN = 398 * MiB;
constexpr size_t WS_CQN = 410 * MiB;
constexpr size_t WS_CKVN = 422 * MiB;
constexpr size_t WS_KROPE = 430 * MiB;
constexpr size_t WS_DVEC = 431 * MiB;
constexpr size_t WS_DS = 432 * MiB;
constexpr size_t WS_VT = 464 * MiB;
constexpr size_t WS_YB = 398 * MiB, WS_YC = 414 * MiB;
static_assert(WS_YB == WS_YA + 16 * MiB && WS_YC == WS_YB + 16 * MiB, "branch outputs contiguous");
constexpr size_t WS_PU = 480 * MiB;
constexpr size_t WS_SINIT = 488 * MiB;
constexpr size_t WS_END = 492 * MiB;

constexpr int LDS_BYTES = 159744;

typedef unsigned short bf16_t;
typedef unsigned v4u __attribute__((ext_vector_type(4)));
typedef unsigned v2u __attribute__((ext_vector_type(2)));
typedef float f32x4 __attribute__((ext_vector_type(4)));
typedef float f32x16 __attribute__((ext_vector_type(16)));
typedef short bf16x8 __attribute__((ext_vector_type(8)));
#define LDS_WAIT() asm volatile("s_waitcnt lgkmcnt(0)" ::: "memory")
__device__ __forceinline__ unsigned f2bf(float f) { unsigned u = __float_as_uint(f); return (u + 0x7fffu + ((u >> 16) & 1u)) >> 16; }
typedef float f32x2_t __attribute__((ext_vector_type(2))); typedef __bf16 bf16x2_t __attribute__((ext_vector_type(2)));
__device__ __forceinline__ unsigned pk2(float lo, float hi) { f32x2_t v = {lo, hi}; bf16x2_t b = __builtin_convertvector(v, bf16x2_t); return __builtin_bit_cast(unsigned, b); }
__device__ __forceinline__ float bflo(unsigned w) { return __uint_as_float(w << 16); }
__device__ __forceinline__ float bfhi(unsigned w) { return __uint_as_float(w & 0xffff0000u); }
__device__ __forceinline__ float bf1(bf16_t v) { return __uint_as_float(((unsigned)v) << 16); }
__device__ __forceinline__ float sigm(float x) { return 1.0f / (1.0f + __expf(-x)); }
__device__ __forceinline__ float wave_sum(float v) {
#pragma unroll
    for (int o = 1; o < 64; o <<= 1) v += __shfl_xor(v, o);
    return v;
}
template <int CTRL> __device__ __forceinline__ float dppf(float x) { return __int_as_float(__builtin_amdgcn_update_dpp(0, __float_as_int(x), CTRL, 0xF, 0xF, true)); }
__device__ __forceinline__ float red16(float x) {
    x += dppf<0xB1>(x);
    x += dppf<0x4E>(x);
    x += dppf<0x141>(x);
    x += dppf<0x140>(x);
    return x;
}
__device__ __forceinline__ void unpack8(const v4u w, float* f) { f[0] = bflo(w.x); f[1] = bfhi(w.x); f[2] = bflo(w.y); f[3] = bfhi(w.y); f[4] = bflo(w.z); f[5] = bfhi(w.z); f[6] = bflo(w.w); f[7] = bfhi(w.w); }
__device__ __forceinline__ v4u pack8(const float* f) { v4u w; w.x = pk2(f[0], f[1]); w.y = pk2(f[2], f[3]); w.z = pk2(f[4], f[5]); w.w = pk2(f[6], f[7]); return w; }

struct Params { const void* in[40]; float* out; unsigned char* ws; };

__device__ __forceinline__ void conv_item(const float* __restrict__ W, int ldw, int k0, int n0, bf16_t* WT, int ldk, int drow0, int extra16, float* scr, int lane) {
#pragma unroll 8
    for (int i = 0; i < 32; ++i) { const int kk = 2 * i + (lane >> 5); scr[kk * 33 + (lane & 31)] = W[(size_t)(k0 + kk) * ldw + n0 + (lane & 31)]; }
    LDS_WAIT();
    const int c = lane & 7;
#pragma unroll
    for (int j = 0; j < 4; ++j) { const int n = (lane >> 3) + 8 * j; const float* s = scr + (8 * c) * 33 + n;
        v4u o; o.x = pk2(s[0 * 33], s[1 * 33]); o.y = pk2(s[2 * 33], s[3 * 33]); o.z = pk2(s[4 * 33], s[5 * 33]); o.w = pk2(s[6 * 33], s[7 * 33]);
        const int row = drow0 + n + (n >= 16 ? extra16 : 0);
        *(v4u*)(WT + (size_t)row * ldk + k0 + 8 * c) = o; }
    LDS_WAIT();
}
__device__ __forceinline__ void zero_item(bf16_t* WT, int ldk, int row0, int k0, int lane) {
    const int c = lane & 7;
#pragma unroll
    for (int j = 0; j < 4; ++j) { const int n = (lane >> 3) + 8 * j; *(v4u*)(WT + (size_t)(row0 + n) * ldk + k0 + 8 * c) = (v4u){0u, 0u, 0u, 0u}; }
}
__device__ __forceinline__ void conv_ffn(const float* wg, const float* wu, const float* wd, unsigned char* ws, unsigned char* lds, int wg0) {
    PHASE_IDS; float* scr = (float*)(lds + wave * 8448);
    if (bid < wg0) return;
    const int gw_ = (bid - wg0) * 8 + wave, ngw_ = (G - wg0) * 8;
    bf16_t* GU = (bf16_t*)(ws + WA_GU); bf16_t* Dn = (bf16_t*)(ws + WA_D);
    for (int it = gw_; it < 3 * 1408; it += ngw_) {
        int r = it;
        if (r < 1408) { const int kb = r / 88, nb = r % 88; conv_item(wg, DFF, 64 * kb, 32 * nb, GU, 1024, 64 * nb, 16, scr, lane); continue; } r -= 1408;
        if (r < 1408) { const int kb = r / 88, nb = r % 88; conv_item(wu, DFF, 64 * kb, 32 * nb, GU, 1024, 64 * nb + 16, 16, scr, lane); continue; } r -= 1408;
        { const int kb = r / 32, nb = r % 32; conv_item(wd, 1024, 64 * kb, 32 * nb, Dn, DFF, 32 * nb, 0, scr, lane); }
    }
}
__device__ __forceinline__ void conv_ffn_item(const float* wg, const float* wu, const float* wd, unsigned char* ws, unsigned char* lds, int item) {
    const int tid = opaque_tid(), lane = tid & 63, wave = __builtin_amdgcn_readfirstlane(tid >> 6); float* scr = (float*)(lds + wave * 8448);
    bf16_t* GU = (bf16_t*)(ws + WA_GU); bf16_t* Dn = (bf16_t*)(ws + WA_D);
    __syncthreads();
    for (int j = 0; j < 8; ++j) {
        int r = item * 64 + wave * 8 + j;
        if (r >= 3 * 1408) break;
        if (r < 1408) { const int kb = r / 88, nb = r % 88; conv_item(wg, DFF, 64 * kb, 32 * nb, GU, 1024, 64 * nb, 16, scr, lane); continue; } r -= 1408;
        if (r < 1408) { const int kb = r / 88, nb = r % 88; conv_item(wu, DFF, 64 * kb, 32 * nb, GU, 1024, 64 * nb + 16, 16, scr, lane); continue; } r -= 1408;
        { const int kb = r / 32, nb = r % 32; conv_item(wd, 1024, 64 * kb, 32 * nb, Dn, DFF, 32 * nb, 0, scr, lane); }
    }
}
__device__ __forceinline__ void conv_mixer(const Params& P, int l, unsigned char* lds) {
    PHASE_IDS; float* scr = (float*)(lds + wave * 8448);
    unsigned char* ws = opaque_ptr(P.ws);
    bf16_t* WIN = (bf16_t*)(ws + WB_IN); bf16_t* WLORA = (bf16_t*)(ws + WB_LORA); bf16_t* WUQ = (bf16_t*)(ws + WB_UQ); bf16_t* WUK = (bf16_t*)(ws + WB_UK);
    bf16_t* WUV = (bf16_t*)(ws + WB_UV); bf16_t* WOUT = (bf16_t*)(ws + WB_OUT); bf16_t* WO = (bf16_t*)(ws + WB_O);
    const float* w_in = GPF(P.in[9]) + (size_t)l * 1024 * 7584;
    const float* w_up = GPF(P.in[12]) + (size_t)l * 64 * 512;
    const float* a_up = GPF(P.in[14]) + (size_t)l * 64 * 512;
    const float* g_up = GPF(P.in[15]) + (size_t)l * 128 * 512;
    const float* vdown = (l > 0) ? GPF(P.in[21]) + (size_t)(l - 1) * 1024 * 32 : nullptr;
    const float* vup = (l > 0) ? GPF(P.in[23]) + (size_t)(l - 1) * 32 * 512 : nullptr;
    const float* w_uq = GPF(P.in[27]) + (size_t)l * 384 * 768;
    const float* w_ukv = GPF(P.in[29]) + (size_t)l * 256 * 1024;
    const float* w_o = GPF(P.in[34]) + (size_t)l * 1024 * 1024;
    constexpr int I_IN = 16 * 237, I_VD = 16, I_PAD = 32, I_LORA = 6 * 64, I_UQ = 6 * 24, I_UKV = 4 * 32, I_OUT = 3 * 256, I_O = 16 * 32;
    constexpr int NITEMS = I_IN + I_VD + I_PAD + I_LORA + I_UQ + I_UKV + I_OUT + I_O;
    for (int it = gw; it < NITEMS; it += ngw) {
        int r = it;
        if (r < I_IN) { const int kb = r / 237, nb = r % 237, n0 = 32 * nb; const int dr = n0 + (n0 < 1792 ? 0 : (n0 < 2464 ? 32 : 96));
            conv_item(w_in, 7584, 64 * kb, n0, WIN, 1024, dr, 0, scr, lane); continue; } r -= I_IN;
        if (r < I_VD) { if (l > 0) conv_item(vdown, 32, 64 * r, 0, WIN, 1024, C1_VRES, 0, scr, lane); else zero_item(WIN, 1024, C1_VRES, 64 * r, lane); continue; } r -= I_VD;
        if (r < I_PAD) { zero_item(WIN, 1024, 2496 + 32 * (r >> 4), 64 * (r & 15), lane); continue; } r -= I_PAD;
        if (r < I_LORA) { const int kb = r / 64, nb = r % 64; const int b = nb >> 4, nn = (32 * nb) & 511;
            const float* src = b == 0 ? w_up : (b == 1 ? a_up : (b == 2 ? g_up : vup));
            const int ks = b == 0 ? 0 : (b == 1 ? 64 : (b == 2 ? 128 : 256)), ke = b == 0 ? 64 : (b == 1 ? 128 : (b == 2 ? 256 : 288));
            const int c = lane & 7;
#pragma unroll
            for (int j = 0; j < 4; ++j) { const int n = (lane >> 3) + 8 * j; float f[8];
#pragma unroll
                for (int e = 0; e < 8; ++e) { const int k = 64 * kb + 8 * c + e; f[e] = (src != nullptr && k >= ks && k < ke) ? src[(size_t)(k - ks) * 512 + nn + n] : 0.f; }
                *(v4u*)(WLORA + (size_t)(32 * nb + n) * 384 + 64 * kb + 8 * c) = pack8(f); }
            continue; } r -= I_LORA;
        if (r < I_UQ) { const int kb = r / 24, nb = r % 24; conv_item(w_uq, 768, 64 * kb, 32 * nb, WUQ, 384, 32 * nb, 0, scr, lane); continue; } r -= I_UQ;
        if (r < I_UKV) { const int kb = r / 32, nb = r % 32, n0 = 32 * nb, h = n0 >> 7, j = n0 & 127;
            if (j < 64) conv_item(w_ukv, 1024, 64 * kb, n0, WUK, 256, h * 64 + j, 0, scr, lane); else conv_item(w_ukv, 1024, 64 * kb, n0, WUV, 256, h * 64 + j - 64, 0, scr, lane);
            continue; } r -= I_UKV;
        if (r < I_OUT) { const int br = r / 256, q = r % 256, kb = q / 32, nb = q % 32;
            const float* src = GPF(P.in[br == 0 ? 25 : (br == 1 ? 30 : 33)]) + (size_t)l * 512 * 1024;
            conv_item(src, 1024, 64 * kb, 32 * nb, WOUT + (size_t)br * 1024 * 512, 512, 32 * nb, 0, scr, lane); continue; } r -= I_OUT;
        { const int kb = r / 32, nb = r % 32; conv_item(w_o, 1024, 64 * kb, 32 * nb, WO, 1024, 32 * nb, 0, scr, lane); }
    }
}

__device__ __forceinline__ void phase_rowwise(const bf16_t* ysrc, const float* hin, float* hout, float wt, const float* g_post, const float* g_pre, bf16_t* xn) {
    PHASE_IDS;
    for (int row = gw; row < T; row += 2 * ngw) {
        const int rowb = row + ngw; const bool two = rowb < T; const int rb = two ? rowb : row;
        f32x4 ha[4], hb[4]; v2u ya[4], yb[4];
        { const f32x4* hr = (const f32x4*)(hin + (size_t)row * DM) + lane; const f32x4* hr2 = (const f32x4*)(hin + (size_t)rb * DM) + lane;
#pragma unroll
          for (int j = 0; j < 4; ++j) { ha[j] = hr[64 * j]; hb[j] = hr2[64 * j]; }
          if (ysrc) { const v2u* yr = (const v2u*)(ysrc + (size_t)row * DM) + lane; const v2u* yr2 = (const v2u*)(ysrc + (size_t)rb * DM) + lane;
#pragma unroll
            for (int j = 0; j < 4; ++j) { ya[j] = yr[64 * j]; yb[j] = yr2[64 * j]; } } }
#pragma unroll
        for (int half = 0; half < 2; ++half) {
            if (half == 1 && !two) break;
            const int r = half ? rowb : row;
            f32x4 h[4];
#pragma unroll
            for (int j = 0; j < 4; ++j) h[j] = half ? hb[j] : ha[j];
            if (ysrc) {
                f32x4 y[4]; float s = 0.f;
#pragma unroll
                for (int j = 0; j < 4; ++j) { const v2u w = half ? yb[j] : ya[j]; y[j] = (f32x4){bflo(w.x), bfhi(w.x), bflo(w.y), bfhi(w.y)}; s += (y[j].x * y[j].x + y[j].y * y[j].y) + (y[j].z * y[j].z + y[j].w * y[j].w); }
                const float rinv = wt * rsqrtf(wave_sum(s) * (1.f / DM) + NORM_EPS);
#pragma unroll
                for (int j = 0; j < 4; ++j) { const f32x4 g = *((const f32x4*)g_post + lane + 64 * j); h[j] = h[j] + y[j] * g * rinv; }
            }
            f32x4* ho = (f32x4*)(hout + (size_t)r * DM) + lane;
#pragma unroll
            for (int j = 0; j < 4; ++j) ho[64 * j] = h[j];
            if (g_pre) {
                float s = 0.f;
#pragma unroll
                for (int j = 0; j < 4; ++j) s += (h[j].x * h[j].x + h[j].y * h[j].y) + (h[j].z * h[j].z + h[j].w * h[j].w);
                const float rinv = rsqrtf(wave_sum(s) * (1.f / DM) + NORM_EPS);
                unsigned long long* o8 = (unsigned long long*)(xn + (size_t)r * DM) + lane;
#pragma unroll
                for (int j = 0; j < 4; ++j) { const f32x4 g = *((const f32x4*)g_pre + lane + 64 * j); const f32x4 v = h[j] * g * rinv;
                    o8[64 * j] = (unsigned long long)pk2(v.x, v.y) | ((unsigned long long)pk2(v.z, v.w) << 32); }
            }
        }
    }
}
#define LAS __attribute__((address_space(3)))
#define XB_TMO      128
#define XB_XCNT(j)  (256  + 64 * (j))
#define XB_XSUB(j)  (1280 + 64 * (j))
#define XB_XGEN(j)  (2304 + 64 * (j))
#define XB_TOP      3328
#define XB_TOPGEN   3392
#define XCD_BAR_WORDS 3456
#define XB_SPIN_CAP (1u << 18)

__device__ __forceinline__ unsigned xb_ld(unsigned* p)              { return __hip_atomic_load(p, __ATOMIC_RELAXED, __HIP_MEMORY_SCOPE_AGENT); }
__device__ __forceinline__ unsigned xb_add(unsigned* p, unsigned v) { return __hip_atomic_fetch_add(p, v, __ATOMIC_RELAXED, __HIP_MEMORY_SCOPE_AGENT); }
__device__ __forceinline__ unsigned xb_xcc_id() { return (unsigned)__builtin_amdgcn_s_getreg((3 << 11) | 20) & 0xFu; }
#define XB_SPIN(cond, bar) do { unsigned _sp = 0; while (cond) { __builtin_amdgcn_s_sleep(1); \
    if ((++_sp & 255u) == 0u) { if (xb_ld(&(bar)[XB_TMO])) break; if (_sp > XB_SPIN_CAP) { atomicAdd(&(bar)[XB_TMO], 1u); break; } } } } while (0)

struct XcdBarrier {
    unsigned* bar; unsigned x;
    volatile LAS unsigned* st;
};

__device__ __forceinline__ XcdBarrier xcd_barrier_post(unsigned* bar, volatile LAS unsigned* st) {
    XcdBarrier b; b.bar = bar; b.x = xb_xcc_id(); b.st = st;
    if (threadIdx.x == 0) (void)xb_add(&bar[XB_XCNT(b.x)], 1u);
    return b;
}
__device__ __forceinline__ void xcd_barrier_complete(unsigned* bar, unsigned x, unsigned& nloc, unsigned& nx) {
    const unsigned G = gridDim.x * gridDim.y * gridDim.z;
    unsigned sum, cnt, mine, sp = 0u;
    for (;;) {
        sum = 0u; cnt = 0u; mine = 0u;
#pragma unroll
        for (unsigned j = 0; j < 16; ++j) { const unsigned c = xb_ld(&bar[XB_XCNT(j)]); sum += c; cnt += (c > 0u) ? 1u : 0u; mine = (j == x) ? c : mine; }
        if (sum == G) break;
        __builtin_amdgcn_s_sleep(1);
        if ((++sp & 255u) == 0u) { if (xb_ld(&bar[XB_TMO])) break; if (sp > XB_SPIN_CAP) { atomicAdd(&bar[XB_TMO], 1u); break; } }
    }
    nloc = mine > 0u ? mine : 1u; nx = cnt > 0u ? cnt : 1u;
}

__device__ __forceinline__ void xcd_barrier(const XcdBarrier& b) {
    asm volatile("s_waitcnt vmcnt(0)" ::: "memory");
    __syncthreads();
    if (threadIdx.x == 0) {
        unsigned* bar = b.bar;
        __builtin_amdgcn_s_waitcnt(0);
        unsigned nloc = b.st[0], nx = b.st[1];
        if (nloc == 0u) { xcd_barrier_complete(bar, b.x, nloc, nx); b.st[0] = nloc; b.st[1] = nx; }
        const unsigned old = xb_add(&bar[XB_XSUB(b.x)], 1u);
        const unsigned gen = old / nloc;
        if (old + 1u == (gen + 1u) * nloc) {
            __builtin_amdgcn_fence(__ATOMIC_RELEASE, "agent");
            asm volatile("s_waitcnt vmcnt(0)" ::: "memory");
            const unsigned og = xb_add(&bar[XB_TOP], 1u);
            const unsigned tg = og / nx;
            if (og + 1u == (tg + 1u) * nx) xb_add(&bar[XB_TOPGEN], 1u);
            else XB_SPIN(xb_ld(&bar[XB_TOPGEN]) == tg, bar);
            __builtin_amdgcn_fence(__ATOMIC_ACQUIRE, "agent");
            xb_add(&bar[XB_XGEN(b.x)], 1u);
            asm volatile("s_waitcnt vmcnt(0)" ::: "memory");
        } else {
            XB_SPIN(xb_ld(&bar[XB_XGEN(b.x)]) == gen, bar);
            __builtin_amdgcn_fence(__ATOMIC_ACQUIRE, "agent");
            asm volatile("s_waitcnt vmcnt(0)" ::: "memory");
        }
    }
    __syncthreads();
}
__device__ __forceinline__ void phase_tables(const Params& P) {
    PHASE_IDS;
    float* COS = (float*)(opaque_ptr(P.ws) + WS_COS); float* SIN = (float*)(opaque_ptr(P.ws) + WS_SIN); float* LB = (float*)(opaque_ptr(P.ws) + WS_LB);
    const int* pos = GPI(P.in[1]);
    for (int e = gtid; e < T * 16; e += gthreads) {
        const int t = e >> 4, i = e & 15;
        const double inv_freq = exp(-(double)i * (9.210340371976184 / 16.0));
        double rev = (double)pos[t] * inv_freq * 0.15915494309189535;
        rev -= floor(rev);
        const float x = (float)rev;
        COS[e] = __builtin_amdgcn_cosf(x); SIN[e] = __builtin_amdgcn_sinf(x);
    }
    if (gtid < 512) {
        const float* lbw = GPF(P.in[31]);
        float v[NL], mx = -1e30f, s = 0.f;
#pragma unroll
        for (int l = 0; l < NL; ++l) { v[l] = lbw[l * 512 + gtid]; mx = fmaxf(mx, v[l]); }
#pragma unroll
        for (int l = 0; l < NL; ++l) { v[l] = __expf(v[l] - mx); s += v[l]; }
        float c = 0.f; const float p0 = v[0] / s;
#pragma unroll
        for (int l = 0; l < NL; ++l) { c += v[l] / s; LB[l * 512 + gtid] = c - p0; }
    }
}

__device__ __forceinline__ void phase_prep(const Params& P, int l) {
    PHASE_IDS;
    unsigned char* ws = opaque_ptr(P.ws);
    const bf16_t* P1 = (const bf16_t*)(ws + WS_P1);
    bf16_t* RB = (bf16_t*)(ws + WS_RB); bf16_t* KB = (bf16_t*)(ws + WS_KB); bf16_t* VB = (bf16_t*)(ws + WS_VB); bf16_t* VF = (bf16_t*)(ws + WS_VFIRST);
    bf16_t* LIN = (bf16_t*)(ws + WS_LIN); bf16_t* CQN = (bf16_t*)(ws + WS_CQN); bf16_t* CKVN = (bf16_t*)(ws + WS_CKVN); bf16_t* KROPE = (bf16_t*)(ws + WS_KROPE);
    const float* COS = (const float*)(ws + WS_COS); const float* SIN = (const float*)(ws + WS_SIN);
    const float* mu = GPF(P.in[10]) + (size_t)l * 1792;
    const float* vmu = (l > 0) ? GPF(P.in[22]) + (size_t)(l - 1) * 32 : nullptr;
    const float* qg = GPF(P.in[26]) + (size_t)l * 384;
    const float* kvg = GPF(P.in[28]) + (size_t)l * 256;
    for (int t = gw; t < T; t += ngw) {
        const unsigned* cur = (const unsigned*)(P1 + (size_t)t * NP1);
        const unsigned* prv = (const unsigned*)(P1 + (size_t)(t > 0 ? t - 1 : 0) * NP1);
        const bool hasp = t > 0;
#pragma unroll
        for (int i = 0; i < 14; ++i) {
            const int j = lane + 64 * i, col = 2 * j;
            const unsigned cw = cur[j], pw = hasp ? prv[j] : 0u;
            const float c0 = bflo(cw), c1 = bfhi(cw), p0 = bflo(pw), p1 = bfhi(pw);
            float m0 = c0 + (p0 - c0) * mu[col], m1 = c1 + (p1 - c1) * mu[col + 1];
            if (i < 4) { *(unsigned*)(RB + (size_t)t * 512 + col) = pk2(m0, m1); }
            else if (i < 8) { *(unsigned*)(KB + (size_t)t * 512 + col - 512) = pk2(m0, m1); }
            else if (i < 12) { const unsigned w = pk2(m0, m1); *(unsigned*)(VB + (size_t)t * 512 + col - 1024) = w; if (l == 0) *(unsigned*)(VF + (size_t)t * 512 + col - 1024) = w; }
            else {
                if (col < 1600) { m0 = tanhf(m0); m1 = tanhf(m1); } else if (col >= 1664) { m0 = sigm(m0); m1 = sigm(m1); }
                *(unsigned*)(LIN + (size_t)t * 384 + col - 1536) = pk2(m0, m1);
            }
        }
        if (lane < 16) {
            unsigned w = 0u;
            if (l > 0) { const int j = (C1_VRES >> 1) + lane; const unsigned cw = cur[j], pw = hasp ? prv[j] : 0u;
                const float c0 = bflo(cw), c1 = bfhi(cw), p0 = bflo(pw), p1 = bfhi(pw);
                w = pk2(c0 + (p0 - c0) * vmu[2 * lane], c1 + (p1 - c1) * vmu[2 * lane + 1]); }
            *(unsigned*)(LIN + (size_t)t * 384 + 256 + 2 * lane) = w;
        } else {
            *(unsigned*)(LIN + (size_t)t * 384 + 288 + 2 * (lane - 16)) = 0u;
        }
        {
            float c[6]; float s = 0.f;
#pragma unroll
            for (int i = 0; i < 3; ++i) { const unsigned w = cur[(C1_CQ >> 1) + lane + 64 * i]; c[2 * i] = bflo(w); c[2 * i + 1] = bfhi(w); s += c[2 * i] * c[2 * i] + c[2 * i + 1] * c[2 * i + 1]; }
            const float rinv = rsqrtf(wave_sum(s) * (1.f / 384.f) + NORM_EPS);
#pragma unroll
            for (int i = 0; i < 3; ++i) { const int cc = 2 * (lane + 64 * i); *(unsigned*)(CQN + (size_t)t * 384 + cc) = pk2(c[2 * i] * rinv * qg[cc], c[2 * i + 1] * rinv * qg[cc + 1]); }
        }
        {
            float c[4]; float s = 0.f;
#pragma unroll
            for (int i = 0; i < 2; ++i) { const unsigned w = cur[(C1_CKV >> 1) + lane + 64 * i]; c[2 * i] = bflo(w); c[2 * i + 1] = bfhi(w); s += c[2 * i] * c[2 * i] + c[2 * i + 1] * c[2 * i + 1]; }
            const float rinv = rsqrtf(wave_sum(s) * (1.f / 256.f) + NORM_EPS);
#pragma unroll
            for (int i = 0; i < 2; ++i) { const int cc = 2 * (lane + 64 * i); *(unsigned*)(CKVN + (size_t)t * 256 + cc) = pk2(c[2 * i] * rinv * kvg[cc], c[2 * i + 1] * rinv * kvg[cc + 1]); }
        }
        if (lane < 16) {
            const bf16_t* row = P1 + (size_t)t * NP1 + C1_KR;
            const float x1 = bf1(row[lane]), x2 = bf1(row[16 + lane]);
            const float cs = COS[t * 16 + lane], sn = SIN[t * 16 + lane];
            KROPE[(size_t)t * 32 + lane] = (bf16_t)f2bf(x1 * cs - x2 * sn);
            KROPE[(size_t)t * 32 + 16 + lane] = (bf16_t)f2bf(x2 * cs + x1 * sn);
        }
    }
}

__device__ __forceinline__ void hgrn_a_unit(const Params& P, int l, int unit, unsigned char* lds) {
    const int tid = opaque_tid();
    const int c = unit >> 2, h = unit & 3, t0 = c * 64;
    const bf16_t* P2 = (const bf16_t*)(opaque_ptr(P.ws) + WS_P2);
    const float* LB = (const float*)(opaque_ptr(P.ws) + WS_LB) + l * 512 + h * 128;
    float* kd = (float*)lds;
    float* kg = (float*)(lds + 32768);
    bf16_t* vT = (bf16_t*)(lds + 65536);
    bf16_t* kdT = (bf16_t*)(lds + 102400);
    float* bl = (float*)(lds + 98304);
    __syncthreads();
#pragma unroll
    for (int i = 0; i < 8; ++i) {
        const int e = tid + 512 * i, s = e >> 6, k2 = (e & 63) * 2;
        const unsigned fw = *(const unsigned*)(P2 + (size_t)(t0 + s) * NP2 + C2_HF + h * 128 + k2);
        const unsigned iw = *(const unsigned*)(P2 + (size_t)(t0 + s) * NP2 + C2_HI + h * 128 + k2);
        const float lb0 = LB[k2], lb1 = LB[k2 + 1];
        const float z0 = bflo(fw), z1 = bfhi(fw);
        const float f0 = lb0 + (1.f - lb0) * sigm(z0), f1 = lb1 + (1.f - lb1) * sigm(z1);
        kd[s * 128 + k2] = __logf(fmaxf(f0, 1e-6f)); kd[s * 128 + k2 + 1] = __logf(fmaxf(f1, 1e-6f));
        kg[s * 128 + k2] = (1.f - lb0) * sigm(-z0); kg[s * 128 + k2 + 1] = (1.f - lb1) * sigm(-z1);
        vT[k2 * 72 + s] = (bf16_t)(iw & 0xffffu); vT[(k2 + 1) * 72 + s] = (bf16_t)(iw >> 16);
    }
    __syncthreads();
    {
        float* tot = bl + 128;
        const int k = tid & 127, seg = tid >> 7; float b = 0.f;
#pragma unroll 4
        for (int s = 16 * seg; s < 16 * seg + 16; ++s) { b += kd[s * 128 + k]; kd[s * 128 + k] = b; }
        tot[seg * 128 + k] = b;
        __syncthreads();
        float off = 0.f;
        if (seg > 0) off += tot[k]; if (seg > 1) off += tot[128 + k]; if (seg > 2) off += tot[256 + k];
#pragma unroll 4
        for (int s = 16 * seg; s < 16 * seg + 16; ++s) kd[s * 128 + k] += off;
        if (seg == 3) { const float bt_ = b + off; bl[k] = bt_; ((float*)(opaque_ptr(P.ws) + WS_DVEC))[(size_t)unit * 128 + k] = __expf(bt_); }
    }
    __syncthreads();
#pragma unroll
    for (int i = 0; i < 16; ++i) { const int e = tid + 512 * i, k = e & 127, s = e >> 7; kdT[k * 72 + s] = (bf16_t)f2bf(kg[e] * __expf(bl[k] - kd[e])); }
    __syncthreads();
    {
        const int lane = tid & 63, w = __builtin_amdgcn_readfirstlane(tid >> 6), lr = lane & 15, kgp = lane >> 4;
        const bf16x8 B0 = *(const bf16x8*)(vT + (16 * w + lr) * 72 + 8 * kgp), B1 = *(const bf16x8*)(vT + (16 * w + lr) * 72 + 32 + 8 * kgp);
        bf16_t* DS = (bf16_t*)(opaque_ptr(P.ws) + WS_DS) + (size_t)unit * 16384;
#pragma unroll
        for (int kt_ = 0; kt_ < 8; ++kt_) {
            const bf16x8 A0 = *(const bf16x8*)(kdT + (16 * kt_ + lr) * 72 + 8 * kgp), A1 = *(const bf16x8*)(kdT + (16 * kt_ + lr) * 72 + 32 + 8 * kgp);
            f32x4 a4 = (f32x4){0.f, 0.f, 0.f, 0.f};
            a4 = __builtin_amdgcn_mfma_f32_16x16x32_bf16(A0, B0, a4, 0, 0, 0);
            a4 = __builtin_amdgcn_mfma_f32_16x16x32_bf16(A1, B1, a4, 0, 0, 0);
            *(v2u*)(DS + (16 * w + lr) * 128 + 16 * kt_ + 4 * kgp) = (v2u){pk2(a4[0], a4[1]), pk2(a4[2], a4[3])};
        }
    }
}
__device__ __forceinline__ void hgrn_b(const Params& P, unsigned char* lds) {
    const int tid = opaque_tid(), el = tid & 127, qtr = __builtin_amdgcn_readfirstlane(tid >> 7);
    float* xd = (float*)lds;
    float* xs = xd + 512;
    for (int it = blockIdx.x; it < 512; it += gridDim.x) {
        const int h = it >> 7, kvb = (it & 127) * 128;
        bf16_t* dsb = (bf16_t*)(opaque_ptr(P.ws) + WS_DS) + ((size_t)(64 * qtr) * 4 + h) * 16384 + kvb;
        const float* dvb = (const float*)(opaque_ptr(P.ws) + WS_DVEC) + ((size_t)(64 * qtr) * 4 + h) * 128;
        float ds[64], dv[64];
#pragma unroll
        for (int i = 0; i < 64; ++i) { ds[i] = bf1(dsb[(size_t)i * 65536 + el]); dv[i] = dvb[(size_t)i * 512 + el]; }
        float D = 1.f, S = 0.f;
#pragma unroll
        for (int i = 0; i < 64; ++i) { S = dv[i] * S + ds[i]; D *= dv[i]; }
        __syncthreads();
        xd[qtr * 128 + el] = D; xs[qtr * 128 + el] = S;
        __syncthreads();
        S = 0.f;
        for (int j = 0; j < qtr; ++j) S = xd[j * 128 + el] * S + xs[j * 128 + el];
#pragma unroll
        for (int i = 0; i < 64; ++i) { dsb[(size_t)i * 65536 + el] = (bf16_t)f2bf(S); S = dv[i] * S + ds[i]; }
    }
}
__device__ __forceinline__ void hgrn_c_unit(const Params& P, int l, int unit, unsigned char* lds) {
    const int tid = opaque_tid();
    const int c = unit >> 2, h = unit & 3, t0 = c * 64;
    const bf16_t* P2 = (const bf16_t*)(opaque_ptr(P.ws) + WS_P2);
    const float* LB = (const float*)(opaque_ptr(P.ws) + WS_LB) + l * 512 + h * 128;
    constexpr int RS = 132;
    float* qs = (float*)lds;
    float* bs = (float*)(lds + 33792);
    float* ks = (float*)(lds + 67584);
    float* kt = (float*)(lds + 101376);
    float* at = (float*)(lds + 135168);
    float* bl = (float*)(lds + 152576);
    __syncthreads();
#pragma unroll
    for (int i = 0; i < 9; ++i) { const int e = tid + 512 * i; if (e < 64 * 68) at[e] = 0.f; }
#pragma unroll
    for (int i = 0; i < 8; ++i) {
        const int e = tid + 512 * i, s = e >> 6, k2 = (e & 63) * 2;
        const unsigned qw = *(const unsigned*)(P2 + (size_t)(t0 + s) * NP2 + C2_HQ + h * 128 + k2);
        const unsigned fw = *(const unsigned*)(P2 + (size_t)(t0 + s) * NP2 + C2_HF + h * 128 + k2);
        const float lb0 = LB[k2], lb1 = LB[k2 + 1];
        const float z0 = bflo(fw), z1 = bfhi(fw), q0 = bflo(qw), q1 = bfhi(qw);
        const float f0 = lb0 + (1.f - lb0) * sigm(z0), f1 = lb1 + (1.f - lb1) * sigm(z1);
        bs[s * RS + k2] = __logf(fmaxf(f0, 1e-6f)) * LOG2E; bs[s * RS + k2 + 1] = __logf(fmaxf(f1, 1e-6f)) * LOG2E;
        ks[s * RS + k2] = (1.f - lb0) * sigm(-z0); ks[s * RS + k2 + 1] = (1.f - lb1) * sigm(-z1);
        qs[s * RS + k2] = q0 * sigm(q0); qs[s * RS + k2 + 1] = q1 * sigm(q1);
    }
    __syncthreads();
    {
        float* tot = bl + 1024;
        const int k = tid & 127, seg = tid >> 7; float b = 0.f;
#pragma unroll 4
        for (int s = 16 * seg; s < 16 * seg + 16; ++s) { b += bs[s * RS + k]; bs[s * RS + k] = b; }
        tot[seg * 128 + k] = b;
        __syncthreads();
        float off = 0.f;
        if (seg > 0) off += tot[k]; if (seg > 1) off += tot[128 + k]; if (seg > 2) off += tot[256 + k];
#pragma unroll 4
        for (int s = 16 * seg; s < 16 * seg + 16; ++s) { const float v_ = bs[s * RS + k] + off; bs[s * RS + k] = v_; if ((s & 7) == 7) bl[(s >> 3) * 128 + k] = v_; }
    }
    __syncthreads();
    {
        bf16_t* k16 = (bf16_t*)kt;
#pragma unroll 1
        for (int pass = 0; pass < 2; ++pass) {
            const int p = tid + 512 * pass;
            if (p < 544) {
                int t, s;
                if (p < 288) { const int blk = p / 36, idx = p - 36 * blk; int tl = 0; while (((tl + 1) * (tl + 2) >> 1) <= idx) ++tl; t = 8 * blk + tl; s = 8 * blk + idx - (tl * (tl + 1) >> 1); }
                else { const int q_ = p - 288, m = q_ >> 6; t = 16 * m + 8 + ((q_ >> 3) & 7); s = 16 * m + (q_ & 7); }
                float a = 0.f;
                for (int k4 = 0; k4 < 128; k4 += 4) {
                    const f32x4 q4 = *(const f32x4*)(qs + t * RS + k4), bt = *(const f32x4*)(bs + t * RS + k4), k4v = *(const f32x4*)(ks + s * RS + k4), b4 = *(const f32x4*)(bs + s * RS + k4);
                    a += (q4[0] * k4v[0] * __builtin_amdgcn_exp2f(bt[0] - b4[0]) + q4[1] * k4v[1] * __builtin_amdgcn_exp2f(bt[1] - b4[1]))
                       + (q4[2] * k4v[2] * __builtin_amdgcn_exp2f(bt[2] - b4[2]) + q4[3] * k4v[3] * __builtin_amdgcn_exp2f(bt[3] - b4[3])); }
                at[t * 68 + s] = a;
            }
        }
#pragma unroll
        for (int i = 0; i < 4; ++i) { const int e = tid + 512 * i, s = e >> 5, k4 = (e & 31) * 4;
            const f32x4 kg4 = *(const f32x4*)(ks + s * RS + k4), b4 = *(const f32x4*)(bs + s * RS + k4), bj = *(const f32x4*)(bl + (2 * (s >> 4) + 1) * 128 + k4);
            *(v2u*)(k16 + s * 136 + k4) = (v2u){pk2(kg4[0] * __builtin_amdgcn_exp2f(bj[0] - b4[0]), kg4[1] * __builtin_amdgcn_exp2f(bj[1] - b4[1])),
                                               pk2(kg4[2] * __builtin_amdgcn_exp2f(bj[2] - b4[2]), kg4[3] * __builtin_amdgcn_exp2f(bj[3] - b4[3]))}; }
        __syncthreads();
        {
            const int lane = tid & 63, w = __builtin_amdgcn_readfirstlane(tid >> 6), lr = lane & 15, kgp = lane >> 4;
            if (w < 6) {
                const int m = (w == 0) ? 1 : (w < 3 ? 2 : 3), n = (w == 0) ? 0 : (w < 3 ? w - 1 : w - 3);
                const int trow = 16 * m + lr, srow = 16 * n + lr;
                f32x4 a4 = (f32x4){0.f, 0.f, 0.f, 0.f};
#pragma unroll
                for (int kstep = 0; kstep < 4; ++kstep) {
                    const int k0 = 32 * kstep + 8 * kgp;
                    const f32x4 q0 = *(const f32x4*)(qs + trow * RS + k0), q1 = *(const f32x4*)(qs + trow * RS + k0 + 4);
                    const f32x4 t0_ = *(const f32x4*)(bs + trow * RS + k0), t1_ = *(const f32x4*)(bs + trow * RS + k0 + 4);
                    const f32x4 j0 = *(const f32x4*)(bl + (2 * n + 1) * 128 + k0), j1 = *(const f32x4*)(bl + (2 * n + 1) * 128 + k0 + 4);
                    const bf16x8 A = __builtin_bit_cast(bf16x8, ((v4u){
                        pk2(q0[0] * __builtin_amdgcn_exp2f(t0_[0] - j0[0]), q0[1] * __builtin_amdgcn_exp2f(t0_[1] - j0[1])), pk2(q0[2] * __builtin_amdgcn_exp2f(t0_[2] - j0[2]), q0[3] * __builtin_amdgcn_exp2f(t0_[3] - j0[3])),
                        pk2(q1[0] * __builtin_amdgcn_exp2f(t1_[0] - j1[0]), q1[1] * __builtin_amdgcn_exp2f(t1_[1] - j1[1])), pk2(q1[2] * __builtin_amdgcn_exp2f(t1_[2] - j1[2]), q1[3] * __builtin_amdgcn_exp2f(t1_[3] - j1[3]))}));
                    const bf16x8 B = *(const bf16x8*)(k16 + srow * 136 + k0);
                    a4 = __builtin_amdgcn_mfma_f32_16x16x32_bf16(A, B, a4, 0, 0, 0);
                }
#pragma unroll
                for (int r = 0; r < 4; ++r) at[(16 * m + 4 * kgp + r) * 68 + 16 * n + lr] = a4[r];
            }
        }
    }
    __syncthreads();
#pragma unroll
    for (int i = 0; i < 16; ++i) { const int e = tid + 512 * i, s = e >> 7, k = e & 127; qs[s * RS + k] *= __builtin_amdgcn_exp2f(bs[s * RS + k]); }
    __syncthreads();
    bf16_t* S0T = (bf16_t*)(lds + 33792);
    bf16_t* vT = (bf16_t*)(lds + 68608);
    float* os = kt;
    {
        const bf16_t* DS = (const bf16_t*)(opaque_ptr(P.ws) + WS_DS) + (size_t)unit * 16384;
#pragma unroll
        for (int i = 0; i < 4; ++i) { const int e = tid + 512 * i, v = e >> 4, c8 = (e & 15) * 8; *(v4u*)(S0T + v * 136 + c8) = *(const v4u*)(DS + v * 128 + c8); }
#pragma unroll
        for (int i = 0; i < 8; ++i) { const int e = tid + 512 * i, s = e >> 6, k2 = (e & 63) * 2;
            const unsigned iw = *(const unsigned*)(P2 + (size_t)(t0 + s) * NP2 + C2_HI + h * 128 + k2);
            vT[k2 * 72 + s] = (bf16_t)(iw & 0xffffu); vT[(k2 + 1) * 72 + s] = (bf16_t)(iw >> 16); }
    }
    __syncthreads();
    {
        const int lane = tid & 63, w = __builtin_amdgcn_readfirstlane(tid >> 6), tb = w & 3, vh = w >> 2, lr = lane & 15, kg = lane >> 4;
        const int trow = 16 * tb + lr;
        f32x4 acc4[4];
#pragma unroll
        for (int n = 0; n < 4; ++n) acc4[n] = (f32x4){0.f, 0.f, 0.f, 0.f};
#pragma unroll
        for (int kstep = 0; kstep < 6; ++kstep) {
            const float* src = (kstep < 2) ? (at + trow * 68 + 32 * kstep + 8 * kg) : (qs + trow * RS + 32 * (kstep - 2) + 8 * kg);
            const f32x4 x0 = *(const f32x4*)src, x1 = *(const f32x4*)(src + 4);
            const bf16x8 A = __builtin_bit_cast(bf16x8, ((v4u){pk2(x0[0], x0[1]), pk2(x0[2], x0[3]), pk2(x1[0], x1[1]), pk2(x1[2], x1[3])}));
#pragma unroll
            for (int n = 0; n < 4; ++n) { const int col = 64 * vh + 16 * n + lr;
                const bf16x8 B = (kstep < 2) ? *(const bf16x8*)(vT + col * 72 + 32 * kstep + 8 * kg) : *(const bf16x8*)(S0T + col * 136 + 32 * (kstep - 2) + 8 * kg);
                acc4[n] = __builtin_amdgcn_mfma_f32_16x16x32_bf16(A, B, acc4[n], 0, 0, 0); }
        }
#pragma unroll
        for (int n = 0; n < 4; ++n)
#pragma unroll
            for (int r = 0; r < 4; ++r) os[(16 * tb + 4 * kg + r) * RS + 64 * vh + 16 * n + lr] = acc4[n][r];
    }
    __syncthreads();
    {
        const int t = tid >> 3, vg = tid & 7;
        float o[16];
#pragma unroll
        for (int j = 0; j < 4; ++j) { const f32x4 o4 = *(const f32x4*)(os + t * RS + vg * 16 + 4 * j); o[4 * j] = o4[0]; o[4 * j + 1] = o4[1]; o[4 * j + 2] = o4[2]; o[4 * j + 3] = o4[3]; }
        float ss = 0.f;
#pragma unroll
        for (int j = 0; j < 16; ++j) ss += o[j] * o[j];
        ss += __shfl_xor(ss, 1); ss += __shfl_xor(ss, 2); ss += __shfl_xor(ss, 4);
        const float rinv = rsqrtf(ss * (1.f / 128.f) + NORM_EPS);
        const float* ng = GPF(P.in[32]) + (size_t)l * 128 + vg * 16;
        const bf16_t* cg = P2 + (size_t)(t0 + t) * NP2 + C2_HG + h * 128 + vg * 16;
        const v4u g0 = *(const v4u*)cg, g1 = *(const v4u*)(cg + 8);
        float g[16]; unpack8(g0, g); unpack8(g1, g + 8);
        float r[16];
#pragma unroll
        for (int j = 0; j < 16; ++j) r[j] = o[j] * rinv * ng[j] * (g[j] * sigm(g[j]));
        bf16_t* yc = (bf16_t*)(opaque_ptr(P.ws) + WS_YC) + (size_t)(t0 + t) * 512 + h * 128 + vg * 16;
        *(v4u*)yc = pack8(r); *(v4u*)(yc + 8) = pack8(r + 8);
    }
}
__device__ __forceinline__ void phase_prep2(const Params& P, int l) {
    PHASE_IDS;
    unsigned char* ws = opaque_ptr(P.ws);
    bf16_t* LORA = (bf16_t*)(ws + WS_LORA); bf16_t* KB = (bf16_t*)(ws + WS_KB); bf16_t* VB = (bf16_t*)(ws + WS_VB); const bf16_t* VF = (const bf16_t*)(ws + WS_VFIRST);
    bf16_t* Q = (bf16_t*)(ws + WS_Q);
    const float* COS = (const float*)(ws + WS_COS); const float* SIN = (const float*)(ws + WS_SIN);
    const int ch = lane * 8;
    float w0[8], a0[8], kkw[8], kaw[8], v0[8];
#pragma unroll
    for (int e = 0; e < 8; ++e) {
        w0[e] = (GPF(P.in[11]))[l * 512 + ch + e]; a0[e] = (GPF(P.in[13]))[l * 512 + ch + e];
        kkw[e] = (GPF(P.in[16]))[l * 512 + ch + e]; kaw[e] = (GPF(P.in[17]))[l * 512 + ch + e];
        v0[e] = (l > 0) ? (GPF(P.in[24]))[(l - 1) * 512 + ch + e] : 0.f;
    }
    for (int t = gw; t < T; t += ngw) {
        bf16_t* lr = LORA + (size_t)t * 2048 + ch;
        float lw[8], la[8], lv[8], k[8];
        unpack8(*(const v4u*)lr, lw); unpack8(*(const v4u*)(lr + 512), la); unpack8(*(const v4u*)(lr + 1536), lv);
        unpack8(*(const v4u*)(KB + (size_t)t * 512 + ch), k);
        float ew[8], kk[8], bb[8], km[8]; float ss = 0.f;
#pragma unroll
        for (int e = 0; e < 8; ++e) {
            const float x = -(w0[e] + lw[e]);
            const float sp = fmaxf(x, 0.f) + __logf(1.f + __expf(-fabsf(x)));
            ew[e] = __expf(-sp - 0.5f);
            kk[e] = k[e] * kkw[e]; ss += kk[e] * kk[e];
        }
        ss += __shfl_xor(ss, 1); ss += __shfl_xor(ss, 2); ss += __shfl_xor(ss, 4);
        const float kinv = 1.f / fmaxf(sqrtf(ss), 1e-12f);
#pragma unroll
        for (int e = 0; e < 8; ++e) {
            const float a = sigm(a0[e] + la[e]);
            kk[e] *= kinv; bb[e] = kk[e] * a; km[e] = k[e] * (1.f + (a - 1.f) * kaw[e]);
        }
        *(v4u*)lr = pack8(ew); *(v4u*)(lr + 512) = pack8(kk); *(v4u*)(lr + 1536) = pack8(bb);
        *(v4u*)(KB + (size_t)t * 512 + ch) = pack8(km);
        if (l > 0) {
            float v[8], vf[8];
            unpack8(*(const v4u*)(VB + (size_t)t * 512 + ch), v); unpack8(*(const v4u*)(VF + (size_t)t * 512 + ch), vf);
#pragma unroll
            for (int e = 0; e < 8; ++e) v[e] = v[e] + (vf[e] - v[e]) * sigm(v0[e] + lv[e]);
            *(v4u*)(VB + (size_t)t * 512 + ch) = pack8(v);
        }
        {
            const int h = lane >> 3, sub = lane & 7;
            bf16_t* qh = Q + (size_t)t * 768 + h * 96;
            float qn[8]; unpack8(*(const v4u*)(qh + 8 * sub), qn);
#pragma unroll
            for (int e = 0; e < 8; ++e) qn[e] *= QSCALE;
            const unsigned x1w = *(const unsigned*)(qh + 64 + 2 * sub), x2w = *(const unsigned*)(qh + 80 + 2 * sub);
            const float c0 = COS[t * 16 + 2 * sub], c1 = COS[t * 16 + 2 * sub + 1], s0 = SIN[t * 16 + 2 * sub], s1 = SIN[t * 16 + 2 * sub + 1];
            const float x10 = bflo(x1w), x11 = bfhi(x1w), x20 = bflo(x2w), x21 = bfhi(x2w);
            *(v4u*)(qh + 8 * sub) = pack8(qn);
            *(unsigned*)(qh + 64 + 2 * sub) = pk2((x10 * c0 - x20 * s0) * QSCALE, (x11 * c1 - x21 * s1) * QSCALE);
            *(unsigned*)(qh + 80 + 2 * sub) = pk2((x20 * c0 + x10 * s0) * QSCALE, (x21 * c1 + x11 * s1) * QSCALE);
        }
    }
}

constexpr int RW_NC = 32, RW_LC = T / RW_NC;
typedef float f2v __attribute__((ext_vector_type(2)));
#define LO2(v4) (__builtin_shufflevector((v4), (v4), 0, 1))
#define HI2(v4) (__builtin_shufflevector((v4), (v4), 2, 3))
__device__ __forceinline__ float red8(float x) { x += dppf<0xB1>(x); x += dppf<0x4E>(x); x += dppf<0x141>(x); return x; }
template <int MODE>
__device__ __forceinline__ void rwkv_scan_item(const Params& P, int l, unsigned char* lds, int h, int t0, int nchunk, const float* init, float* fin) {
    const int tid = opaque_tid(), lane = tid & 63, wave = tid >> 6, rowgrp = lane >> 3, kq = lane & 7;
    const int row = wave * 8 + rowgrp;
    unsigned char* ws = opaque_ptr(P.ws);
    const bf16_t* LORA = (const bf16_t*)(ws + WS_LORA); const bf16_t* KB = (const bf16_t*)(ws + WS_KB); const bf16_t* RB = (const bf16_t*)(ws + WS_RB); const bf16_t* VB = (const bf16_t*)(ws + WS_VB);
    bf16_t* YA = (bf16_t*)(ws + WS_YA);
    constexpr int BUF = 49152;
    float* ybuf = (float*)(lds + 2 * BUF);
    const bf16_t* src[3]; int dsto[3], sstride[3];
    const int hi8 = tid >> 8, q = tid & 255, st = q >> 3, c8 = q & 7;
    {
        const int a0 = hi8, a1 = 2 + hi8, a2 = 4 + hi8;
        src[0] = (a0 == 0 ? LORA : LORA + 512) + (size_t)st * 2048 + h * 64 + c8 * 8; sstride[0] = 2048; dsto[0] = (a0 * 2048 + st * 64 + c8 * 8) * 4;
        src[1] = (a1 == 2 ? LORA + 1536 + (size_t)st * 2048 : KB + (size_t)st * 512) + h * 64 + c8 * 8; sstride[1] = (a1 == 2) ? 2048 : 512; dsto[1] = (a1 * 2048 + st * 64 + c8 * 8) * 4;
        src[2] = (a2 == 4 ? RB : VB) + (size_t)st * 512 + h * 64 + c8 * 8; sstride[2] = 512; dsto[2] = (a2 * 2048 + st * 64 + c8 * 8) * 4;
    }
    const bool ld2 = !(MODE == 2 && hi8 == 1);
    f2v S2[4];
    if (MODE == 2) {
#pragma unroll
        for (int j = 0; j < 4; ++j) S2[j] = (f2v){(8 * kq + 2 * j == row) ? 1.f : 0.f, (8 * kq + 2 * j + 1 == row) ? 1.f : 0.f};
    } else if (MODE == 0 && init != nullptr) {
        const f32x4 i0 = *(const f32x4*)(init + row * 64 + 8 * kq), i1 = *(const f32x4*)(init + row * 64 + 8 * kq + 4);
        S2[0] = LO2(i0); S2[1] = HI2(i0); S2[2] = LO2(i1); S2[3] = HI2(i1);
    } else {
#pragma unroll
        for (int j = 0; j < 4; ++j) S2[j] = (f2v){0.f, 0.f};
    }
    const int fs = tid >> 4, fv = (tid & 15) * 4;
    f32x4 rk4 = {0.f, 0.f, 0.f, 0.f}, gg4 = rk4, gb4 = rk4;
    if (MODE == 0) { rk4 = *(const f32x4*)(GPF(P.in[18]) + l * 512 + h * 64 + fv); gg4 = *(const f32x4*)(GPF(P.in[19]) + l * 512 + h * 64 + fv); gb4 = *(const f32x4*)(GPF(P.in[20]) + l * 512 + h * 64 + fv); }
    v4u regs[3];
#define RW_LOAD(tt) do { regs[0] = *(const v4u*)(src[0] + (size_t)(tt) * sstride[0]); regs[1] = *(const v4u*)(src[1] + (size_t)(tt) * sstride[1]); if (ld2) regs[2] = *(const v4u*)(src[2] + (size_t)(tt) * sstride[2]); } while (0)
#define RW_STORE(bufp) do { \
        { float f[8]; unpack8(regs[0], f); if (hi8 == 0) { _Pragma("unroll") for (int e = 0; e < 8; ++e) f[e] = __expf(-f[e]); } else { _Pragma("unroll") for (int e = 0; e < 8; ++e) f[e] = -f[e]; } \
          float* d = (float*)((bufp) + dsto[0]); *(f32x4*)d = (f32x4){f[0], f[1], f[2], f[3]}; *(f32x4*)(d + 4) = (f32x4){f[4], f[5], f[6], f[7]}; } \
        { float f[8]; unpack8(regs[1], f); float* d = (float*)((bufp) + dsto[1]); *(f32x4*)d = (f32x4){f[0], f[1], f[2], f[3]}; *(f32x4*)(d + 4) = (f32x4){f[4], f[5], f[6], f[7]}; } \
        if (ld2) { float f[8]; unpack8(regs[2], f); float* d = (float*)((bufp) + dsto[2]); *(f32x4*)d = (f32x4){f[0], f[1], f[2], f[3]}; *(f32x4*)(d + 4) = (f32x4){f[4], f[5], f[6], f[7]}; } } while (0)
    __syncthreads();
    RW_LOAD(t0);
    RW_STORE(lds);
    __syncthreads();
    for (int c = 0; c < nchunk; ++c) {
        const int tc = t0 + 32 * c;
        const bool more = (c + 1 < nchunk);
        if (more) RW_LOAD(tc + 32);
        const float* buf = (const float*)(lds + (c & 1) * BUF);
#pragma unroll 2
        for (int s = 0; s < 32; ++s) {
            const float* bs_ = buf + s * 64 + 8 * kq;
            const f32x4 nk0 = *(const f32x4*)(bs_ + 2048), nk1 = *(const f32x4*)(bs_ + 2048 + 4);
            f2v p = S2[0] * LO2(nk0); p = S2[1] * HI2(nk0) + p; p = S2[2] * LO2(nk1) + p; p = S2[3] * HI2(nk1) + p;
            float sa = p.x + p.y;
            const f32x4 dw0 = *(const f32x4*)(bs_), dw1 = *(const f32x4*)(bs_ + 4);
            const f32x4 bb0 = *(const f32x4*)(bs_ + 4096), bb1 = *(const f32x4*)(bs_ + 4096 + 4);
            f2v tq[4];
            if (MODE == 2) { tq[0] = S2[0] * LO2(dw0); tq[1] = S2[1] * HI2(dw0); tq[2] = S2[2] * LO2(dw1); tq[3] = S2[3] * HI2(dw1); }
            else {
                const f32x4 kv0 = *(const f32x4*)(bs_ + 6144), kv1 = *(const f32x4*)(bs_ + 6144 + 4);
                const float vv = buf[10240 + s * 64 + row]; const f2v vv2 = {vv, vv};
                tq[0] = S2[0] * LO2(dw0) + vv2 * LO2(kv0); tq[1] = S2[1] * HI2(dw0) + vv2 * HI2(kv0); tq[2] = S2[2] * LO2(dw1) + vv2 * LO2(kv1); tq[3] = S2[3] * HI2(dw1) + vv2 * HI2(kv1);
            }
            sa = red8(sa);
            const f2v sa2 = {sa, sa};
            S2[0] = sa2 * LO2(bb0) + tq[0]; S2[1] = sa2 * HI2(bb0) + tq[1]; S2[2] = sa2 * LO2(bb1) + tq[2]; S2[3] = sa2 * HI2(bb1) + tq[3];
            if (MODE == 0) {
                const f32x4 rv0 = *(const f32x4*)(bs_ + 8192), rv1 = *(const f32x4*)(bs_ + 8192 + 4);
                f2v py = S2[0] * LO2(rv0); py = S2[1] * HI2(rv0) + py; py = S2[2] * LO2(rv1) + py; py = S2[3] * HI2(rv1) + py;
                float y = py.x + py.y;
                y = red8(y);
                if (kq == 0) ybuf[s * 64 + row] = y;
            }
        }
        if (more) RW_STORE(lds + ((c + 1) & 1) * BUF);
        __syncthreads();
        if (MODE == 0) {
            const f32x4 y4 = *(const f32x4*)(ybuf + fs * 64 + fv);
            const f32x4 r4 = *(const f32x4*)(buf + 8192 + fs * 64 + fv), k4 = *(const f32x4*)(buf + 6144 + fs * 64 + fv), v4 = *(const f32x4*)(buf + 10240 + fs * 64 + fv);
            const v2u gw_ = *(const v2u*)(LORA + (size_t)(tc + fs) * 2048 + 1024 + h * 64 + fv);
            float sm = (y4[0] + y4[1]) + (y4[2] + y4[3]);
            float bsum = (r4[0] * k4[0] * rk4[0] + r4[1] * k4[1] * rk4[1]) + (r4[2] * k4[2] * rk4[2] + r4[3] * k4[3] * rk4[3]);
            sm = red16(sm); bsum = red16(bsum);
            const float mean = sm * (1.f / 64.f);
            const f32x4 d4 = y4 - mean;
            float qv = (d4[0] * d4[0] + d4[1] * d4[1]) + (d4[2] * d4[2] + d4[3] * d4[3]);
            qv = red16(qv);
            const float rstd = rsqrtf(qv * (1.f / 64.f) + 64e-5f);
            const f32x4 o4 = d4 * rstd * gg4 + gb4 + v4 * bsum;
            *(v2u*)(YA + (size_t)(tc + fs) * 512 + h * 64 + fv) = (v2u){pk2(o4[0] * bflo(gw_.x), o4[1] * bfhi(gw_.x)), pk2(o4[2] * bflo(gw_.y), o4[3] * bfhi(gw_.y))};
            __syncthreads();
        }
    }
#undef RW_LOAD
#undef RW_STORE
    if (MODE != 0) { *(f32x4*)(fin + row * 64 + 8 * kq) = (f32x4){S2[0].x, S2[0].y, S2[1].x, S2[1].y}; *(f32x4*)(fin + row * 64 + 8 * kq + 4) = (f32x4){S2[2].x, S2[2].y, S2[3].x, S2[3].y}; }
}
__device__ __forceinline__ void rwkv_scan_pu(const Params& P, unsigned char* lds, int h, int t0, int nchunk, float* finP, float* finU) {
    const int tid = opaque_tid(), lane = tid & 63, wave = tid >> 6, rowgrp = lane >> 3, kq = lane & 7;
    const int row = wave * 8 + rowgrp;
    unsigned char* ws = opaque_ptr(P.ws);
    const bf16_t* LORA = (const bf16_t*)(ws + WS_LORA); const bf16_t* KB = (const bf16_t*)(ws + WS_KB); const bf16_t* VB = (const bf16_t*)(ws + WS_VB);
    constexpr int BUF = 49152;
    const bf16_t* src[3]; int dsto[3], sstride[3];
    const int hi8 = tid >> 8, q = tid & 255, st = q >> 3, c8 = q & 7;
    src[0] = (hi8 == 0 ? LORA : LORA + 512) + (size_t)st * 2048 + h * 64 + c8 * 8; sstride[0] = 2048; dsto[0] = (hi8 * 2048 + st * 64 + c8 * 8) * 4;
    src[1] = (hi8 == 0 ? LORA + 1536 + (size_t)st * 2048 : KB + (size_t)st * 512) + h * 64 + c8 * 8; sstride[1] = (hi8 == 0) ? 2048 : 512; dsto[1] = ((2 + hi8) * 2048 + st * 64 + c8 * 8) * 4;
    src[2] = VB + (size_t)st * 512 + h * 64 + c8 * 8; sstride[2] = 512; dsto[2] = (5 * 2048 + st * 64 + c8 * 8) * 4;
    const bool ld2 = hi8 == 1;
    f2v SP2[4], SU2[4];
#pragma unroll
    for (int j = 0; j < 4; ++j) { SP2[j] = (f2v){(8 * kq + 2 * j == row) ? 1.f : 0.f, (8 * kq + 2 * j + 1 == row) ? 1.f : 0.f}; SU2[j] = (f2v){0.f, 0.f}; }
    v4u regs[3];
#define PU_LOAD(tt) do { regs[0] = *(const v4u*)(src[0] + (size_t)(tt) * sstride[0]); regs[1] = *(const v4u*)(src[1] + (size_t)(tt) * sstride[1]); if (ld2) regs[2] = *(const v4u*)(src[2] + (size_t)(tt) * sstride[2]); } while (0)
#define PU_STORE(bufp) do { \
        { float f[8]; unpack8(regs[0], f); if (hi8 == 0) { _Pragma("unroll") for (int e = 0; e < 8; ++e) f[e] = __expf(-f[e]); } else { _Pragma("unroll") for (int e = 0; e < 8; ++e) f[e] = -f[e]; } \
          float* d = (float*)((bufp) + dsto[0]); *(f32x4*)d = (f32x4){f[0], f[1], f[2], f[3]}; *(f32x4*)(d + 4) = (f32x4){f[4], f[5], f[6], f[7]}; } \
        { float f[8]; unpack8(regs[1], f); float* d = (float*)((bufp) + dsto[1]); *(f32x4*)d = (f32x4){f[0], f[1], f[2], f[3]}; *(f32x4*)(d + 4) = (f32x4){f[4], f[5], f[6], f[7]}; } \
        if (ld2) { float f[8]; unpack8(regs[2], f); float* d = (float*)((bufp) + dsto[2]); *(f32x4*)d = (f32x4){f[0], f[1], f[2], f[3]}; *(f32x4*)(d + 4) = (f32x4){f[4], f[5], f[6], f[7]}; } } while (0)
    __syncthreads();
    PU_LOAD(t0);
    PU_STORE(lds);
    __syncthreads();
    for (int c = 0; c < nchunk; ++c) {
        const int tc = t0 + 32 * c;
        const bool more = (c + 1 < nchunk);
        if (more) PU_LOAD(tc + 32);
        const float* buf = (const float*)(lds + (c & 1) * BUF);
#pragma unroll 2
        for (int s = 0; s < 32; ++s) {
            const float* bs_ = buf + s * 64 + 8 * kq;
            const f32x4 nk0 = *(const f32x4*)(bs_ + 2048), nk1 = *(const f32x4*)(bs_ + 2048 + 4);
            f2v pP = SP2[0] * LO2(nk0); pP = SP2[1] * HI2(nk0) + pP; pP = SP2[2] * LO2(nk1) + pP; pP = SP2[3] * HI2(nk1) + pP;
            f2v pU = SU2[0] * LO2(nk0); pU = SU2[1] * HI2(nk0) + pU; pU = SU2[2] * LO2(nk1) + pU; pU = SU2[3] * HI2(nk1) + pU;
            float saP = pP.x + pP.y, saU = pU.x + pU.y;
            const f32x4 dw0 = *(const f32x4*)(bs_), dw1 = *(const f32x4*)(bs_ + 4);
            const f32x4 bb0 = *(const f32x4*)(bs_ + 4096), bb1 = *(const f32x4*)(bs_ + 4096 + 4);
            const f32x4 kv0 = *(const f32x4*)(bs_ + 6144), kv1 = *(const f32x4*)(bs_ + 6144 + 4);
            const float vv = buf[10240 + s * 64 + row]; const f2v vv2 = {vv, vv};
            f2v tp[4], tu[4];
            tp[0] = SP2[0] * LO2(dw0); tp[1] = SP2[1] * HI2(dw0); tp[2] = SP2[2] * LO2(dw1); tp[3] = SP2[3] * HI2(dw1);
            tu[0] = SU2[0] * LO2(dw0) + vv2 * LO2(kv0); tu[1] = SU2[1] * HI2(dw0) + vv2 * HI2(kv0); tu[2] = SU2[2] * LO2(dw1) + vv2 * LO2(kv1); tu[3] = SU2[3] * HI2(dw1) + vv2 * HI2(kv1);
            saP += dppf<0xB1>(saP); saU += dppf<0xB1>(saU);
            saP += dppf<0x4E>(saP); saU += dppf<0x4E>(saU);
            saP += dppf<0x141>(saP); saU += dppf<0x141>(saU);
            const f2v sP2 = {saP, saP}, sU2 = {saU, saU};
            SP2[0] = sP2 * LO2(bb0) + tp[0]; SP2[1] = sP2 * HI2(bb0) + tp[1]; SP2[2] = sP2 * LO2(bb1) + tp[2]; SP2[3] = sP2 * HI2(bb1) + tp[3];
            SU2[0] = sU2 * LO2(bb0) + tu[0]; SU2[1] = sU2 * HI2(bb0) + tu[1]; SU2[2] = sU2 * LO2(bb1) + tu[2]; SU2[3] = sU2 * HI2(bb1) + tu[3];
        }
        if (more) PU_STORE(lds + ((c + 1) & 1) * BUF);
        __syncthreads();
    }
#undef PU_LOAD
#undef PU_STORE
    if (finP != nullptr) { *(f32x4*)(finP + row * 64 + 8 * kq) = (f32x4){SP2[0].x, SP2[0].y, SP2[1].x, SP2[1].y}; *(f32x4*)(finP + row * 64 + 8 * kq + 4) = (f32x4){SP2[2].x, SP2[2].y, SP2[3].x, SP2[3].y}; }
    *(f32x4*)(finU + row * 64 + 8 * kq) = (f32x4){SU2[0].x, SU2[0].y, SU2[1].x, SU2[1].y}; *(f32x4*)(finU + row * 64 + 8 * kq + 4) = (f32x4){SU2[2].x, SU2[2].y, SU2[3].x, SU2[3].y};
}
__device__ __forceinline__ void rwkv_pass2(const Params& P, unsigned char* lds, int h, int part) {
    const int tid = opaque_tid(), vl = tid >> 5, v = part * 16 + vl, kq = tid & 31;
    const float* PU = (const float*)(opaque_ptr(P.ws) + WS_PU) + (size_t)h * RW_NC * 8192;
    float* SI = (float*)(opaque_ptr(P.ws) + WS_SINIT) + (size_t)h * RW_NC * 4096;
    typedef float f32x2 __attribute__((ext_vector_type(2)));
    float* Ss = (float*)lds;
    float* Pl = (float*)(lds + 4352);
    const int pr = tid >> 3, pc = (tid & 7) * 8;
    __syncthreads();
    f32x2 a = *(const f32x2*)(PU + 4096 + v * 64 + 2 * kq);
    f32x4 p0, p1; f32x2 u;
    { const float* pcur = PU + (size_t)8192; p0 = *(const f32x4*)(pcur + pr * 64 + pc); p1 = *(const f32x4*)(pcur + pr * 64 + pc + 4); u = *(const f32x2*)(pcur + 4096 + v * 64 + 2 * kq); }
    for (int c = 1; c < RW_NC; ++c) {
        *(f32x2*)(SI + (size_t)c * 4096 + v * 64 + 2 * kq) = a;
        if (c + 1 == RW_NC) break;
        Ss[vl * 65 + 2 * kq] = a[0]; Ss[vl * 65 + 2 * kq + 1] = a[1];
        *(f32x4*)(Pl + pr * 64 + pc) = p0; *(f32x4*)(Pl + pr * 64 + pc + 4) = p1;
        a = u;
        if (c + 2 < RW_NC) { const float* pn = PU + (size_t)(c + 1) * 8192; p0 = *(const f32x4*)(pn + pr * 64 + pc); p1 = *(const f32x4*)(pn + pr * 64 + pc + 4); u = *(const f32x2*)(pn + 4096 + v * 64 + 2 * kq); }
        __syncthreads();
#pragma unroll 16
        for (int i = 0; i < 64; ++i) { const float s = Ss[vl * 65 + i]; const f32x2 q = *(const f32x2*)(Pl + i * 64 + 2 * kq); a += q * s; }
        __syncthreads();
    }
}
__device__ __forceinline__ int crow(int r, int hi) { return (r & 3) + 8 * (r >> 2) + 4 * hi; }
__device__ __forceinline__ void attn_qk(const unsigned char* Kb, const bf16x8 (&qr)[6], const f32x16& negm, f32x16& s0, f32x16& s1, int r32, int hi) {
    constexpr int KROW = 208;
#pragma unroll
    for (int d0 = 0; d0 < 6; ++d0) {
        const bf16x8 a0 = *(const bf16x8*)(Kb + r32 * KROW + d0 * 32 + hi * 16);
        const bf16x8 a1 = *(const bf16x8*)(Kb + (32 + r32) * KROW + d0 * 32 + hi * 16);
        s0 = __builtin_amdgcn_mfma_f32_32x32x16_bf16(a0, qr[d0], d0 == 0 ? negm : s0, 0, 0, 0);
        s1 = __builtin_amdgcn_mfma_f32_32x32x16_bf16(a1, qr[d0], d0 == 0 ? negm : s1, 0, 0, 0);
    }
}
__device__ __forceinline__ void attn_mask(f32x16& s0, f32x16& s1, int k0, int qg, int hi) {
#pragma unroll
    for (int r = 0; r < 16; ++r) { const int key = k0 + crow(r, hi); if (key > qg) s0[r] = -1e30f; if (key + 32 > qg) s1[r] = -1e30f; }
}
#define MX3(a, b, c) __builtin_fmaxf(__builtin_fmaxf((a), (b)), (c))
#define SBAR() __builtin_amdgcn_sched_barrier(0)
#define PINF(x) asm volatile("" : "+v"(x))
#define ATT_GAP(A_, B_) do { _Pragma("unroll") for (int e = (A_); e < (B_); ++e) { float x_ = (e < 16) ? c0[e & 15] : c1[e & 15]; PINF(x_); x_ = __builtin_amdgcn_exp2f(x_); PINF(x_); if (e < 16) { c0[e & 15] = x_; ps0 += x_; } else { c1[e & 15] = x_; ps1 += x_; } } \
    _Pragma("unroll") for (int p = (A_) / 2; p < (B_) / 2; ++p) { const float lo_ = (2 * p < 16) ? c0[(2 * p) & 15] : c1[(2 * p) & 15], hi_ = (2 * p + 1 < 16) ? c0[(2 * p + 1) & 15] : c1[(2 * p + 1) & 15]; unsigned w_ = pk2(lo_, hi_); PINF(w_); pw[p >> 2][p & 3] = w_; } } while (0)
__device__ __forceinline__ void attn_unit(const Params& P, unsigned char* lds, int h, int qb) {
    const int tid = opaque_tid(), lane = tid & 63, wave = __builtin_amdgcn_readfirstlane(tid >> 6), r32 = lane & 31, hi = lane >> 5;
    unsigned char* ws = opaque_ptr(P.ws);
    const bf16_t* Q = (const bf16_t*)(ws + WS_Q); const bf16_t* KN = (const bf16_t*)(ws + WS_KNOPE); const bf16_t* KR = (const bf16_t*)(ws + WS_KROPE);
    const bf16_t* VT = (const bf16_t*)(ws + WS_VT); bf16_t* YB = (bf16_t*)(ws + WS_YB);
    constexpr int KROW = 208, VROW = 136, KBUF = 64 * KROW, VBUF = 64 * VROW;
    constexpr float THR = 8.0f;
    const int q0 = qb * 256, qw0 = q0 + wave * 32, NT = (q0 + 256) >> 6, qg = qw0 + r32;
    const int ntw = (qw0 + 31) / 64 + 1;
    const int kkey = tid >> 3, kch = tid & 7, rkey = (tid & 255) >> 2, rch = tid & 3;
    const bf16_t* kn_src = KN + (size_t)kkey * 512 + h * 64 + kch * 8;
    const bf16_t* kr_src = KR + (size_t)rkey * 32 + rch * 8;
    const bf16_t* vt_src = VT + (size_t)(h * 64 + kkey) * T + kch * 8;
    const int kn_dst = kkey * KROW + kch * 16, kr_dst = rkey * KROW + 128 + rch * 16, vt_dst = 2 * KBUF + kkey * VROW + kch * 16;
    const bool has_kr = tid < 256;
    bf16x8 qr[6];
#pragma unroll
    for (int d0 = 0; d0 < 6; ++d0) qr[d0] = *(const bf16x8*)(Q + (size_t)(qw0 + r32) * 768 + h * 96 + d0 * 16 + hi * 8);
    f32x16 o0, o1, negm;
#pragma unroll
    for (int r = 0; r < 16; ++r) { o0[r] = 0.f; o1[r] = 0.f; negm[r] = 0.f; }
    float m = 0.f, lsum = 0.f;
    v4u rkn, rkr = (v4u){0u, 0u, 0u, 0u}, rvt;
#define AT_LOADK(tile) do { const int kk0_ = (tile) * 64; rkn = *(const v4u*)(kn_src + (size_t)kk0_ * 512); if (has_kr) rkr = *(const v4u*)(kr_src + (size_t)kk0_ * 32); } while (0)
#define AT_LOADV(tile) do { rvt = *(const v4u*)(vt_src + (tile) * 64); } while (0)
#define AT_STOREK(b) do { unsigned char* nb_ = lds + (b) * KBUF; *(v4u*)(nb_ + kn_dst) = rkn; if (has_kr) *(v4u*)(nb_ + kr_dst) = rkr; } while (0)
#define AT_STOREV(b) do { unsigned char* nv_ = lds + (b) * VBUF; *(v2u*)(nv_ + vt_dst) = (v2u){rvt.x, rvt.y}; *(v2u*)(nv_ + vt_dst + 8) = (v2u){rvt.z, rvt.w}; } while (0)
    __syncthreads();
    AT_LOADK(0); AT_LOADV(0); AT_STOREK(0); AT_STOREV(0);
    AT_LOADK(1); AT_STOREK(1);
    AT_LOADK(2); AT_LOADV(1);
    __syncthreads();
    f32x16 c0, c1, n0, n1;
    attn_qk(lds, qr, negm, c0, c1, r32, hi);
    if (63 > qw0) attn_mask(c0, c1, 0, qg, hi);
    __syncthreads();
    for (int t = 0; t < NT; ++t) {
        const bool act = t < ntw, actn = (t + 1) < ntw;
        if (act) {
            float mx = MX3(c0[0], c0[1], c1[0]);
            mx = MX3(mx, c1[1], c0[2]);
#pragma unroll
            for (int r = 2; r < 16; r += 2) { mx = MX3(mx, c0[r], c0[r + 1]); mx = MX3(mx, c1[r], c1[r + 1]); }
            mx = fmaxf(mx, __shfl_xor(mx, 32));
            if (t == 0 || __any(mx > THR)) {
                const float dl = (t == 0) ? mx : fmaxf(mx, 0.f), f = __builtin_amdgcn_exp2f(-dl);
                m += dl; lsum *= f;
#pragma unroll
                for (int r = 0; r < 16; ++r) { c0[r] -= dl; c1[r] -= dl; o0[r] *= f; o1[r] *= f; negm[r] = -m; }
            }
        }
        float ps0 = 0.f, ps1 = 0.f;
        v4u pw[4];
        if (act && actn) {
            const unsigned char* Kn = lds + ((t + 1) & 1) * KBUF + r32 * KROW + hi * 16;
            SBAR();
#pragma unroll
            for (int g = 0; g < 6; ++g) {
                const bf16x8 ka = *(const bf16x8*)(Kn + g * 32), kb = *(const bf16x8*)(Kn + 32 * KROW + g * 32);
                n0 = __builtin_amdgcn_mfma_f32_32x32x16_bf16(ka, qr[g], g == 0 ? negm : n0, 0, 0, 0);
                SBAR();
                ATT_GAP((32 * (2 * g)) / 12, (32 * (2 * g + 1)) / 12);
                SBAR();
                n1 = __builtin_amdgcn_mfma_f32_32x32x16_bf16(kb, qr[g], g == 0 ? negm : n1, 0, 0, 0);
                SBAR();
                ATT_GAP((32 * (2 * g + 1)) / 12, (32 * (2 * g + 2)) / 12);
                SBAR();
            }
            if ((t + 1) * 64 + 63 > qw0) attn_mask(n0, n1, (t + 1) * 64, qg, hi);
        } else if (act) {
            ATT_GAP(0, 32);
        }
        if (act) {
            lsum += ps0 + ps1;
            const unsigned char* Vb = lds + 2 * KBUF + (t & 1) * VBUF;
#pragma unroll
            for (int ks = 0; ks < 4; ++ks) {
                const bf16x8 pa = __builtin_bit_cast(bf16x8, pw[ks]);
                const unsigned char* va = Vb + r32 * VROW + (16 * ks + 4 * hi) * 2;
                const v2u l0 = *(const v2u*)va, h0 = *(const v2u*)(va + 16);
                const v2u l1 = *(const v2u*)(va + 32 * VROW), h1 = *(const v2u*)(va + 32 * VROW + 16);
                const bf16x8 vf0 = __builtin_bit_cast(bf16x8, ((v4u){l0.x, l0.y, h0.x, h0.y}));
                const bf16x8 vf1 = __builtin_bit_cast(bf16x8, ((v4u){l1.x, l1.y, h1.x, h1.y}));
                o0 = __builtin_amdgcn_mfma_f32_32x32x16_bf16(vf0, pa, o0, 0, 0, 0);
                o1 = __builtin_amdgcn_mfma_f32_32x32x16_bf16(vf1, pa, o1, 0, 0, 0);
            }
        }
        if (t + 2 < NT) AT_STOREK(t & 1);
        if (t + 1 < NT) AT_STOREV((t + 1) & 1);
        if (t + 3 < NT) AT_LOADK(t + 3);
        if (t + 2 < NT) AT_LOADV(t + 2);
        __syncthreads();
        c0 = n0; c1 = n1;
    }
#undef AT_LOADK
#undef AT_LOADV
#undef AT_STOREK
#undef AT_STOREV
    lsum += __shfl_xor(lsum, 32);
    const float inv = 1.f / lsum;
    bf16_t* yrow = YB + (size_t)(qw0 + r32) * 512 + h * 64;
#pragma unroll
    for (int g = 0; g < 4; ++g) {
        const int dv = 8 * g + 4 * hi;
        *(v2u*)(yrow + dv) = (v2u){pk2(o0[4 * g] * inv, o0[4 * g + 1] * inv), pk2(o0[4 * g + 2] * inv, o0[4 * g + 3] * inv)};
        *(v2u*)(yrow + 32 + dv) = (v2u){pk2(o1[4 * g] * inv, o1[4 * g + 1] * inv), pk2(o1[4 * g + 2] * inv, o1[4 * g + 3] * inv)};
    }
}

constexpr int RW_I1 = (RW_NC - 1) * 8;
constexpr int Q_CONV0 = RW_I1 + 512 + 1024, Q_P20 = Q_CONV0 + 66, Q_END = Q_P20 + 32, Q_SPLIT = 300;
#define GEMM_CALL1(EPI, Ap, Bp, M_, N_, K_, E) { pg8::Gemm g_{(const pg8::bf16_t*)(Ap), (const pg8::bf16_t*)(Bp), (M_), (N_), (K_)}; pg8::StaticOrder S_; S_.init((M_), (N_), G, bid); \
    pg8::gemm_phase<EPI, pg8::StaticOrder, true, true>((PG8_LAS unsigned char*)lds, g_, S_, (E)); }
#ifndef PROBE_M
#define PROBE_M 0
#endif
#ifndef PROBE_S
#define PROBE_S 0
#endif
#define GSYNC() do { XcdBarrier xb_; xb_.bar = (unsigned*)(opaque_ptr(P.ws) + WS_CTL) + 4096; xb_.x = xb_xcc_id(); xb_.st = (volatile LAS unsigned*)((LAS unsigned char*)lds + LDS_BYTES - 64); xcd_barrier(xb_); for (int s_ = 0; s_ < PROBE_S; ++s_) xcd_barrier(xb_); } while (0)
#ifndef PROBE_G
#define PROBE_G 0
#endif
#define GEMM_CALL(EPI, Ap, Bp, M_, N_, K_, E) for (int rep_ = 0; rep_ < 1 + PROBE_G; ++rep_) { pg8::Gemm g_{(const pg8::bf16_t*)(Ap), (const pg8::bf16_t*)(Bp), (M_), (N_), (K_)}; pg8::StaticOrder S_; S_.init((M_), (N_), G, bid); \
    pg8::gemm_phase<EPI, pg8::StaticOrder, true, true>((PG8_LAS unsigned char*)lds, g_, S_, (E)); }

#define WSB (opaque_ptr(P.ws))
#define HRES ((float*)(GAS1 float*)(P.out))
#define XNB ((bf16_t*)(WSB + WS_XN))
#define YB32 ((bf16_t*)(WSB + WS_Y))
#define ACTB ((bf16_t*)(WSB + WS_ACT))
#define CTLW ((unsigned*)(WSB + WS_CTL))
__global__ void __launch_bounds__(512, 2) fwd_kernel(Params P) {
    extern __shared__ __attribute__((aligned(16))) unsigned char lds[];
    cg::grid_group grid = cg::this_grid();
    const int bid = blockIdx.x, G = gridDim.x;
    volatile LAS unsigned* xst = (volatile LAS unsigned*)((LAS unsigned char*)lds + LDS_BYTES - 64);
    if (threadIdx.x < 4) xst[threadIdx.x] = 0u;
    __syncthreads();
    (void)xcd_barrier_post((unsigned*)(opaque_ptr(P.ws) + WS_CTL) + 4096, xst);
    int* qslot = (int*)(lds + LDS_BYTES - 16);

    phase_tables(P);
    if (PROBE_M & 4) conv_ffn(GPF(P.in[4]), GPF(P.in[5]), GPF(P.in[6]), WSB, lds, 0);
    conv_ffn(GPF(P.in[4]), GPF(P.in[5]), GPF(P.in[6]), WSB, lds, 0);
    phase_rowwise(nullptr, GPF(P.in[0]), HRES, 0.f, nullptr, GPF(P.in[2]), XNB);
    grid.sync();
    GSYNC();

#pragma unroll 1
    for (int l = 0; l < NL; ++l) {
#pragma unroll 1
        for (int f = 0; f < 2; ++f) {

#ifndef SKIP_G1
            { pg8::EpiSwiGLU E{ACTB, DFF}; GEMM_CALL(pg8::EpiSwiGLU, XNB, WSB + WA_GU, T, 2 * DFF, DM, E); }
#endif

            GSYNC();

#ifndef SKIP_G2
            { pg8::EpiBf16Split E{(pg8::bf16_t*)YB32, DM, 1 << 30, nullptr, 0}; GEMM_CALL(pg8::EpiBf16Split, ACTB, WSB + WA_D, T, DM, DFF, E); }
#endif

            GSYNC();
            if (f == 1) {
                const float* gpost = GPF(P.in[36]) + (size_t)l * DM;
                const float* gpre = (l + 1 < NL) ? GPF(P.in[2]) + (size_t)(l + 1) * DM : nullptr;
                if (PROBE_M & 8) phase_rowwise(YB32, HRES, (float*)ACTB, 0.5f, gpost, gpre, XNB);
                phase_rowwise(YB32, HRES, HRES, 0.5f, gpost, gpre, XNB);
                if ((PROBE_M & 4) && l + 1 < NL) conv_ffn(GPF(P.in[4]) + (size_t)(l + 1) * DM * DFF, GPF(P.in[5]) + (size_t)(l + 1) * DM * DFF, GPF(P.in[6]) + (size_t)(l + 1) * DM * DFF, WSB, lds, 0);
                if (l + 1 < NL) conv_ffn(GPF(P.in[4]) + (size_t)(l + 1) * DM * DFF, GPF(P.in[5]) + (size_t)(l + 1) * DM * DFF, GPF(P.in[6]) + (size_t)(l + 1) * DM * DFF, WSB, lds, 0);
                GSYNC();
                continue;
            }
            if (PROBE_M & 8) phase_rowwise(YB32, HRES, (float*)ACTB, 0.5f, GPF(P.in[3]) + (size_t)l * DM, GPF(P.in[7]) + (size_t)l * DM, XNB);
            phase_rowwise(YB32, HRES, HRES, 0.5f, GPF(P.in[3]) + (size_t)l * DM, GPF(P.in[7]) + (size_t)l * DM, XNB);

#ifndef SKIP_CM
            if (PROBE_M & 4) conv_mixer(P, l, lds);
            conv_mixer(P, l, lds);
#endif

            GSYNC();

#ifndef SKIP_G3
            { pg8::EpiBf16Split E{(pg8::bf16_t*)(WSB + WS_P1), NP1, NP1 / 256, (pg8::bf16_t*)(WSB + WS_P2), NP2}; GEMM_CALL(pg8::EpiBf16Split, XNB, WSB + WB_IN, T, NP1 + NP2, DM, E); }
#endif

            GSYNC();

#ifndef SKIP_PREP
            for (int rep2 = 0; rep2 < 1 + ((PROBE_M & 2) ? 1 : 0); ++rep2) {
            phase_prep(P, l);
#endif


#ifndef SKIP_HA
            for (int u = bid; u < 1024; u += G) hgrn_a_unit(P, l, u, lds);
            }
#endif

            GSYNC();

#ifndef SKIP_HB
            hgrn_b(P, lds);
#endif

            __syncthreads();
#pragma unroll 1
            for (int gi = 0; gi < 4; ++gi) {
                const unsigned char* Ap; const unsigned char* Bp; unsigned char* Op; int M_, N_, K_, ld;
                if (gi == 0) { Ap = WSB + WS_LIN; Bp = WSB + WB_LORA; Op = WSB + WS_LORA; M_ = T; N_ = 2048; K_ = 384; ld = 2048; }
                else if (gi == 1) { Ap = WSB + WS_CQN; Bp = WSB + WB_UQ; Op = WSB + WS_Q; M_ = T; N_ = 768; K_ = 384; ld = 768; }
                else if (gi == 2) { Ap = WSB + WS_CKVN; Bp = WSB + WB_UK; Op = WSB + WS_KNOPE; M_ = T; N_ = 512; K_ = 256; ld = 512; }
                else { Ap = WSB + WB_UV; Bp = WSB + WS_CKVN; Op = WSB + WS_VT; M_ = 512; N_ = T; K_ = 256; ld = T; }
                pg8::EpiBf16Split E{(pg8::bf16_t*)Op, ld, 1 << 30, nullptr, 0};

#ifndef SKIP_G4
                GEMM_CALL(pg8::EpiBf16Split, Ap, Bp, M_, N_, K_, E);
#endif

            }
            GSYNC();

#ifndef SKIP_PREP2
            phase_prep2(P, l);
#endif

            GSYNC();

#ifndef PROBE_Q
#define PROBE_Q 0
#endif
#pragma unroll 1
            for (int rep = 0; rep < 1 + (PROBE_Q ? 1 : 0); ++rep) {
            for (;;) {
                __syncthreads();
                if (threadIdx.x == 0) *qslot = (int)atomicAdd(CTLW + 64 * l + 16 * rep, 1u);
                __syncthreads();
                int item = *qslot;
                if (item >= (rep ? Q_CONV0 : Q_END)) break;
                if (!rep) {
                    const int a0_ = RW_I1 + Q_SPLIT, nx_ = Q_END - Q_CONV0;
                    if (item >= a0_ && item < a0_ + nx_) { const int x_ = item - a0_; item = (x_ < 32) ? Q_P20 + x_ : Q_CONV0 + (x_ - 32); }
                    else if (item >= a0_ + nx_) item -= nx_;
                }
                if (item < RW_I1) {
                    if (rep && !(PROBE_Q & 1)) continue;
                    const int hh = item & 7, cc = item >> 3;
                    float* fin = (float*)(WSB + WS_PU) + (size_t)(hh * RW_NC + cc) * 8192;
                    rwkv_scan_pu(P, lds, hh, cc * RW_LC, RW_LC / 32, cc > 0 ? fin : nullptr, fin + 4096);
                    if (!rep) {
                        asm volatile("s_waitcnt vmcnt(0)" ::: "memory");
                        __syncthreads();
                        if (threadIdx.x == 0) { __builtin_amdgcn_fence(__ATOMIC_RELEASE, "agent"); asm volatile("s_waitcnt vmcnt(0)" ::: "memory");
                            __hip_atomic_fetch_add(CTLW + 64 * l + 32 + hh, 1u, __ATOMIC_RELAXED, __HIP_MEMORY_SCOPE_AGENT); }
                    }
                    continue;
                }
                if (item >= Q_CONV0) {
                    if (item < Q_P20) { conv_ffn_item(GPF(P.in[37]) + (size_t)l * DM * DFF, GPF(P.in[38]) + (size_t)l * DM * DFF, GPF(P.in[39]) + (size_t)l * DM * DFF, WSB, lds, item - Q_CONV0); continue; }
                    const int hh = (item - Q_P20) >> 2, part = (item - Q_P20) & 3;
                    if (threadIdx.x == 0) { unsigned spins = 0; while (__hip_atomic_load(CTLW + 64 * l + 32 + hh, __ATOMIC_RELAXED, __HIP_MEMORY_SCOPE_AGENT) < (unsigned)(RW_NC - 1) && ++spins < 4000000u) __builtin_amdgcn_s_sleep(2); }
                    __syncthreads();
                    __builtin_amdgcn_fence(__ATOMIC_ACQUIRE, "agent"); asm volatile("s_waitcnt vmcnt(0)" ::: "memory");
                    __syncthreads();
                    rwkv_pass2(P, lds, hh, part);
                    continue;
                }
                item -= RW_I1;
                if (item < 512) { if (rep && !(PROBE_Q & 2)) continue; attn_unit(P, lds, item & 7, 63 - (item >> 3)); }
                else { if (rep && !(PROBE_Q & 4)) continue; hgrn_c_unit(P, l, item - 512, lds); }
            }
            }
            GSYNC();
            for (int rep3 = 0; rep3 < 1 + ((PROBE_M & 1) ? 1 : 0); ++rep3)
            for (int it = bid; it < 8 * RW_NC; it += G) { const int hh = it & 7, cc = it >> 3;
                rwkv_scan_item<0>(P, l, lds, hh, cc * RW_LC, RW_LC / 32, cc ? (const float*)(WSB + WS_SINIT) + (size_t)(hh * RW_NC + cc) * 4096 : nullptr, nullptr); }
            GSYNC();
            {
                pg8::Gemm g_{(const pg8::bf16_t*)(WSB + WS_YA), (const pg8::bf16_t*)(WSB + WB_OUT), 3 * T, 3 * DM, 512};
                pg8::MergeOrder S_; S_.base.init(T, DM, G, bid);
                pg8::EpiGate3 E{(const pg8::bf16_t*)(WSB + WS_P2) + C2_GATE, NP2, (pg8::bf16_t*)(WSB + WS_MERGED), DM};
                pg8::gemm_phase<pg8::EpiGate3, pg8::MergeOrder, true, true>((PG8_LAS unsigned char*)lds, g_, S_, E);
            }
            GSYNC();

#ifndef SKIP_G6
            { pg8::EpiBf16Split E{(pg8::bf16_t*)YB32, DM, 1 << 30, nullptr, 0}; GEMM_CALL(pg8::EpiBf16Split, WSB + WS_MERGED, WSB + WB_O, T, DM, DM, E); }
#endif

            GSYNC();
            if (PROBE_M & 8) phase_rowwise(YB32, HRES, (float*)ACTB, 1.0f, GPF(P.in[8]) + (size_t)l * DM, GPF(P.in[35]) + (size_t)l * DM, XNB);
            phase_rowwise(YB32, HRES, HRES, 1.0f, GPF(P.in[8]) + (size_t)l * DM, GPF(P.in[35]) + (size_t)l * DM, XNB);
            GSYNC();
        }
    }
}

extern "C" void kernel_launch(void* const* d_in, const int* in_sizes, int n_in, void* d_out, int out_size, void* d_ws, size_t ws_size, hipStream_t stream) {
    static int grid = 0;
    if (grid == 0) {
        if (n_in != 40 || out_size != T * DM || ws_size < WS_END) { fprintf(stderr, "kernel_launch: unexpected problem (n_in %d out %d ws %zu)\n", n_in, out_size, ws_size); grid = -1; return; }
        int dev = 0, cus = 0, per_cu = 0;
        hipGetDevice(&dev);
        hipDeviceGetAttribute(&cus, hipDeviceAttributeMultiprocessorCount, dev);
        hipFuncSetAttribute((const void*)fwd_kernel, hipFuncAttributeMaxDynamicSharedMemorySize, LDS_BYTES);
        hipOccupancyMaxActiveBlocksPerMultiprocessor(&per_cu, (const void*)fwd_kernel, 512, LDS_BYTES);
        (void)hipGetLastError();
        if (per_cu < 1) per_cu = 1;
        grid = cus;
        if (grid < 64) { grid = -1; return; }
    }
    if (grid < 0) return;
    hipMemsetAsync((char*)d_ws + WS_CTL, 0, 65536, stream);
    Params p{};
    for (int i = 0; i < 40; ++i) p.in[i] = d_in[i];
    p.out = (float*)d_out; p.ws = (unsigned char*)d_ws;
    void* args[] = {&p};
    hipError_t e = hipLaunchCooperativeKernel((const void*)fwd_kernel, dim3(grid), dim3(512), args, LDS_BYTES, stream);
    if (e != hipSuccess) fprintf(stderr, "cooperative launch failed: %s (grid %d)\n", hipGetErrorString(e), grid);
}
```

```cpp
#include <hip/hip_runtime.h>
#include <hip/hip_cooperative_groups.h>
#include <cstdio>
#include <cstdint>
namespace cg = cooperative_groups;
__device__ __forceinline__ int opaque_tid() { int t = threadIdx.x; asm volatile("" : "+v"(t)); return t; }
__device__ __forceinline__ unsigned char* opaque_ptr(unsigned char* p) {
    const unsigned long long v = (unsigned long long)p;
    unsigned lo = __builtin_amdgcn_readfirstlane((unsigned)v), hi = __builtin_amdgcn_readfirstlane((unsigned)(v >> 32));
    asm volatile("" : "+s"(lo), "+s"(hi));
    return (unsigned char*)(__attribute__((address_space(1))) unsigned char*)(((unsigned long long)hi << 32) | lo);
}
#define GAS1 __attribute__((address_space(1)))
#define GPF(p) ((const float*)(const GAS1 float*)(p))
#define GPI(p) ((const int*)(const GAS1 int*)(p))
#define PHASE_IDS const int tid = opaque_tid(), lane = tid & 63, wave = __builtin_amdgcn_readfirstlane(tid >> 6), bid = blockIdx.x, G = gridDim.x, gw = bid * 8 + wave, ngw = G * 8, gtid = bid * 512 + tid, gthreads = G * 512; (void)lane; (void)gw; (void)ngw; (void)gtid; (void)gthreads;
namespace pg8 {
#define PG8_LAS __attribute__((address_space(3)))
typedef unsigned short bf16_t;
typedef short bf16x8 __attribute__((ext_vector_type(8)));
typedef float f32x4 __attribute__((ext_vector_type(4)));
typedef unsigned u32x4 __attribute__((ext_vector_type(4)));
constexpr int BM = 256, BK = 64, HALF = 128, HTB = HALF * BK * 2  , STAGE_BYTES = 8 * HTB, NXCD = 8, WGM = 8;

__host__ __device__ __forceinline__ int lds_byte(int r, int c) { const int st = (r >> 4) * 2 + (c >> 5), rr = r & 15, cc = c & 31, ob = rr * 64 + cc * 2; return st * 1024 + (ob ^ (((ob >> 9) & 1) << 5)); }
__host__ __device__ __forceinline__ void stage_rc(int b, int& R, int& C) { const int st = b / 1024, sb = b % 1024, swz = sb ^ (((sb >> 9) & 1) << 5); R = (st >> 1) * 16 + swz / 64; C = (st & 1) * 32 + (swz % 64) / 2; }
__host__ __device__ __forceinline__ int perm32(int rho) { const int n = rho >> 4, i = rho & 15; return 8 * (i >> 2) + 4 * n + (i & 3); }

struct Unit { int pm, pn; };
struct Gemm { const bf16_t* A; const bf16_t* Bt; int M, N, K; };

struct StaticOrder {
    int nM, nN, nwg, G, c;
    __host__ __device__ void init(int M, int N, int G_, int c_) { nM = M / BM; nN = N / BM; nwg = nM * nN; G = G_; c = c_; }
    __host__ __device__ bool next(int i, Unit& u) const {
        const long L = (long)i * G + c; if (L >= nwg) return false;
        int wgid = (int)L; { const int q = nwg / NXCD, r = nwg % NXCD, xcd = wgid % NXCD, off = wgid / NXCD; wgid = (xcd < r ? xcd * (q + 1) : r * (q + 1) + (xcd - r) * q) + off; }
        const int nig = WGM * nN, gid = wgid / nig, fm = gid * WGM, gsz = (nM - fm) < WGM ? (nM - fm) : WGM;
        u.pm = fm + ((wgid % nig) % gsz); u.pn = (wgid % nig) / gsz; return true;
    }
    __device__ __forceinline__ void a_ready(const Unit&) const {}
    __device__ __forceinline__ void done(const Unit&) const {}
};

typedef float f32x2e __attribute__((ext_vector_type(2))); typedef __bf16 bf16x2e __attribute__((ext_vector_type(2)));
__device__ __forceinline__ unsigned cvt_pk_bf16(float lo, float hi) { f32x2e v = {lo, hi}; bf16x2e b = __builtin_convertvector(v, bf16x2e); return __builtin_bit_cast(unsigned, b); }
__device__ __forceinline__ float bflo(unsigned w) { return __uint_as_float(w << 16); }
__device__ __forceinline__ float bfhi(unsigned w) { return __uint_as_float(w & 0xffff0000u); }
__device__ __forceinline__ float sigm(float x) { return 1.0f / (1.0f + __expf(-x)); }

struct EpiBf16Split {
    static constexpr bool PERM = true, AFTER_DRAIN = false;
    bf16_t* O0; int ld0; int split_pn; bf16_t* O1; int ld1;
    __device__ __forceinline__ void operator()(const f32x4 (&acc)[2][2][4][2], const Unit& u, int wr, int wc, int fr, int fq) const {
        int pn = u.pn; bf16_t* base = O0; int ld = ld0;
        if (pn >= split_pn) { pn -= split_pn; base = O1; ld = ld1; }
        const int row0 = u.pm * BM + wr * 64 + fr, col0 = pn * BM + wc * 32 + 8 * fq;
#pragma unroll
        for (int ai = 0; ai < 2; ++ai)
#pragma unroll
            for (int m = 0; m < 4; ++m) { bf16_t* rowp = base + (size_t)(row0 + ai * HALF + m * 16) * ld + col0;
#pragma unroll
                for (int bj = 0; bj < 2; ++bj) { const f32x4 v0 = acc[ai][bj][m][0], v1 = acc[ai][bj][m][1];
                    u32x4 w; w.x = cvt_pk_bf16(v0[0], v0[1]); w.y = cvt_pk_bf16(v0[2], v0[3]); w.z = cvt_pk_bf16(v1[0], v1[1]); w.w = cvt_pk_bf16(v1[2], v1[3]);
                    *(u32x4*)(rowp + bj * HALF) = w; } }
    }
};
struct EpiF32 {
    static constexpr bool PERM = false, AFTER_DRAIN = false;
    float* O; int ldc;
    __device__ __forceinline__ void operator()(const f32x4 (&acc)[2][2][4][2], const Unit& u, int wr, int wc, int fr, int fq) const {
        const int row0 = u.pm * BM + wr * 64 + fr, col0 = u.pn * BM + wc * 32 + 4 * fq;
#pragma unroll
        for (int ai = 0; ai < 2; ++ai)
#pragma unroll
            for (int m = 0; m < 4; ++m) { float* rowp = O + (size_t)(row0 + ai * HALF + m * 16) * ldc + col0;
#pragma unroll
                for (int bj = 0; bj < 2; ++bj)
#pragma unroll
                    for (int n = 0; n < 2; ++n) *(f32x4*)(rowp + bj * HALF + n * 16) = acc[ai][bj][m][n]; }
    }
};
struct EpiSwiGLU {
    static constexpr bool PERM = false, AFTER_DRAIN = false;
    bf16_t* O; int ldo;
    __device__ __forceinline__ void operator()(const f32x4 (&acc)[2][2][4][2], const Unit& u, int wr, int wc, int fr, int fq) const {
        const int row0 = u.pm * BM + wr * 64 + fr, j0 = u.pn * 128 + wc * 16 + 4 * fq;
#pragma unroll
        for (int ai = 0; ai < 2; ++ai)
#pragma unroll
            for (int m = 0; m < 4; ++m) { bf16_t* rowp = O + (size_t)(row0 + ai * HALF + m * 16) * ldo + j0;
#pragma unroll
                for (int bj = 0; bj < 2; ++bj) { const f32x4 g = acc[ai][bj][m][0], up = acc[ai][bj][m][1];
                    float a[4];
#pragma unroll
                    for (int i = 0; i < 4; ++i) a[i] = g[i] * sigm(g[i]) * up[i];
                    unsigned long long w = (unsigned long long)cvt_pk_bf16(a[0], a[1]) | ((unsigned long long)cvt_pk_bf16(a[2], a[3]) << 32);
                    *(unsigned long long*)(rowp + bj * 64) = w; } }
    }
};
struct EpiGate {
    static constexpr bool PERM = true, AFTER_DRAIN = false;
    const bf16_t* G; int ldg; bf16_t* O; int ldo; int first;
    __device__ __forceinline__ void operator()(const f32x4 (&acc)[2][2][4][2], const Unit& u, int wr, int wc, int fr, int fq) const {
        const int row0 = u.pm * BM + wr * 64 + fr, col0 = u.pn * BM + wc * 32 + 8 * fq;
#pragma unroll
        for (int ai = 0; ai < 2; ++ai)
#pragma unroll
            for (int m = 0; m < 4; ++m) { const size_t row = (size_t)(row0 + ai * HALF + m * 16);
#pragma unroll
                for (int bj = 0; bj < 2; ++bj) { const f32x4 v0 = acc[ai][bj][m][0], v1 = acc[ai][bj][m][1];
                    const u32x4 gw = *(const u32x4*)(G + row * ldg + col0 + bj * HALF);
                    float r[8];
                    r[0] = sigm(bflo(gw.x)) * v0[0]; r[1] = sigm(bfhi(gw.x)) * v0[1]; r[2] = sigm(bflo(gw.y)) * v0[2]; r[3] = sigm(bfhi(gw.y)) * v0[3];
                    r[4] = sigm(bflo(gw.z)) * v1[0]; r[5] = sigm(bfhi(gw.z)) * v1[1]; r[6] = sigm(bflo(gw.w)) * v1[2]; r[7] = sigm(bfhi(gw.w)) * v1[3];
                    bf16_t* op = O + row * ldo + col0 + bj * HALF;
                    if (!first) { const u32x4 ow = *(const u32x4*)op;
                        r[0] += bflo(ow.x); r[1] += bfhi(ow.x); r[2] += bflo(ow.y); r[3] += bfhi(ow.y); r[4] += bflo(ow.z); r[5] += bfhi(ow.z); r[6] += bflo(ow.w); r[7] += bfhi(ow.w); }
                    u32x4 w; w.x = cvt_pk_bf16(r[0], r[1]); w.y = cvt_pk_bf16(r[2], r[3]); w.z = cvt_pk_bf16(r[4], r[5]); w.w = cvt_pk_bf16(r[6], r[7]);
                    *(u32x4*)op = w; } }
    }
};
template <class Epi, class Sched, bool ALIGN_EPI = false, bool SP2 = false>
__device__ __forceinline__ void gemm_phase(PG8_LAS unsigned char* lds, const Gemm g, const Sched& S, const Epi& E) {
    const int tid = opaque_tid(), wid = __builtin_amdgcn_readfirstlane(tid >> 6), lane = tid & 63, wr = wid >> 2, wc = wid & 3, fr = lane & 15, fq = lane >> 4;
    const int K = g.K, nt = K / BK;
    unsigned voffA[2], voffB[2];
#pragma unroll
    for (int i = 0; i < 2; ++i) { int R, C; stage_rc(tid * 16 + i * 8192, R, C); const int Rb = Epi::PERM ? ((R & ~31) + perm32(R & 31)) : R;
        voffA[i] = (unsigned)(R * K + C) * 2u; voffB[i] = (unsigned)(Rb * K + C) * 2u; }
    const size_t kstep = (size_t)(BK * 2);
    const size_t hstep = (size_t)HALF * K * 2;
    const size_t tstep = 2 * hstep;
    const unsigned ldsw = (unsigned)wid * 1024u;
    const int aoff = lds_byte(wr * 64 + fr, fq * 8), boff = lds_byte(wc * 32 + fr, fq * 8);
#define PG8_SA(b, h) (((b) * 2 + (h)) * HTB)
#define PG8_SB(b, h) ((4 + (b) * 2 + (h)) * HTB)
#define PG8_STAGE(bufoff, gbase, voff) do { _Pragma("unroll") for (int _i = 0; _i < 2; ++_i) \
        __builtin_amdgcn_global_load_lds((const unsigned*)((const char*)(gbase) + (voff)[_i]), (PG8_LAS unsigned*)(lds + (bufoff) + ldsw + _i * 8192), 16, 0, 0); } while (0)
#define PG8_LDA(dst, b, h) do { _Pragma("unroll") for (int m = 0; m < 4; ++m) _Pragma("unroll") for (int k = 0; k < 2; ++k) dst[m][k] = *(const PG8_LAS bf16x8*)(lds + PG8_SA(b, h) + aoff + m * 2048 + k * 1024); } while (0)
#define PG8_LDB(dst, b, h) do { _Pragma("unroll") for (int n = 0; n < 2; ++n) _Pragma("unroll") for (int k = 0; k < 2; ++k) dst[n][k] = *(const PG8_LAS bf16x8*)(lds + PG8_SB(b, h) + boff + n * 2048 + k * 1024); } while (0)
#define PG8_MMA(ai, bj, At, Bt) do { __builtin_amdgcn_s_setprio(1); _Pragma("unroll") for (int m = 0; m < 4; ++m) _Pragma("unroll") for (int n = 0; n < 2; ++n) _Pragma("unroll") for (int k = 0; k < 2; ++k) \
        acc[ai][bj][m][n] = __builtin_amdgcn_mfma_f32_16x16x32_bf16(Bt[n][k], At[m][k], acc[ai][bj][m][n], 0, 0, 0); __builtin_amdgcn_s_setprio(0); } while (0)
#define PG8_WAIT_V(n) asm volatile("s_waitcnt vmcnt(" #n ")" ::: "memory")
#define PG8_WAIT_L(n) asm volatile("s_waitcnt lgkmcnt(" #n ")" ::: "memory")
#define PG8_BAR __builtin_amdgcn_s_barrier()
#define PG8_SCHED __builtin_amdgcn_sched_barrier(0)
    Unit cur, nxt; int ui = 0;
    if (!S.next(0, cur)) return;
    f32x4 acc[2][2][4][2];
#pragma unroll
    for (int a = 0; a < 2; ++a)
#pragma unroll
        for (int b = 0; b < 2; ++b)
#pragma unroll
            for (int m = 0; m < 4; ++m)
#pragma unroll
                for (int n = 0; n < 2; ++n) acc[a][b][m][n] = (f32x4){0.f, 0.f, 0.f, 0.f};
    bf16x8 At[4][2], B0[2][2], B1[2][2];
    const char* cA = (const char*)g.A + (size_t)cur.pm * tstep; const char* cB = (const char*)g.Bt + (size_t)cur.pn * tstep;
    S.a_ready(cur);
    if constexpr (SP2) {
        PG8_STAGE(PG8_SB(0, 0), cB, voffB); PG8_STAGE(PG8_SB(0, 1), cB + hstep, voffB); PG8_STAGE(PG8_SA(0, 0), cA, voffA); PG8_STAGE(PG8_SA(0, 1), cA + hstep, voffA);
        if (wr == 1) PG8_BAR;
        PG8_WAIT_V(2); PG8_BAR;
        PG8_STAGE(PG8_SB(1, 0), cB + kstep, voffB); PG8_STAGE(PG8_SA(1, 0), cA + kstep, voffA); PG8_STAGE(PG8_SB(1, 1), cB + hstep + kstep, voffB);
        PG8_WAIT_V(6); PG8_BAR;
    } else {
        PG8_STAGE(PG8_SB(0, 0), cB, voffB); PG8_STAGE(PG8_SA(0, 0), cA, voffA); PG8_STAGE(PG8_SB(0, 1), cB + hstep, voffB); PG8_STAGE(PG8_SA(0, 1), cA + hstep, voffA);
        if (wr == 1) PG8_BAR;
        PG8_WAIT_V(4); PG8_BAR;
        PG8_STAGE(PG8_SB(1, 0), cB + kstep, voffB); PG8_STAGE(PG8_SA(1, 0), cA + kstep, voffA); PG8_STAGE(PG8_SB(1, 1), cB + hstep + kstep, voffB);
        PG8_WAIT_V(6); PG8_BAR;
    }
    for (;;) {
        const bool has_next = S.next(ui + 1, nxt);
        const char* nA = has_next ? (const char*)g.A + (size_t)nxt.pm * tstep : cA; const char* nB = has_next ? (const char*)g.Bt + (size_t)nxt.pn * tstep : cB;
        for (int t = 0; t < nt; t += 2) {
            const bool last = (t == nt - 2);
            const char* a1 = cA + (size_t)(t + 1) * kstep;
            const char* a2 = last ? nA : cA + (size_t)(t + 2) * kstep; const char* b2 = last ? nB : cB + (size_t)(t + 2) * kstep;
            const char* a3 = a2 + kstep; const char* b3 = b2 + kstep;
            if (last && has_next) S.a_ready(nxt);
            if constexpr (SP2) {
            PG8_LDB(B0, 0, 0); PG8_LDB(B1, 0, 1); PG8_SCHED; PG8_LDA(At, 0, 0); PG8_STAGE(PG8_SA(1, 1), a1 + hstep, voffA);
            PG8_WAIT_V(8); PG8_WAIT_L(0); PG8_BAR; PG8_MMA(0, 0, At, B0); PG8_MMA(0, 1, At, B1); PG8_BAR; PG8_SCHED;
            PG8_LDA(At, 0, 1); PG8_STAGE(PG8_SB(0, 0), b2, voffB); PG8_STAGE(PG8_SB(0, 1), b2 + hstep, voffB); PG8_STAGE(PG8_SA(0, 0), a2, voffA);
            PG8_WAIT_V(8); PG8_WAIT_L(0); PG8_BAR; PG8_MMA(1, 0, At, B0); PG8_MMA(1, 1, At, B1); PG8_BAR; PG8_SCHED;
            PG8_LDB(B0, 1, 0); PG8_LDB(B1, 1, 1); PG8_SCHED; PG8_LDA(At, 1, 0); PG8_STAGE(PG8_SA(0, 1), a2 + hstep, voffA);
            PG8_WAIT_V(8); PG8_WAIT_L(0); PG8_BAR; PG8_MMA(0, 0, At, B0); PG8_MMA(0, 1, At, B1); PG8_BAR; PG8_SCHED;
            PG8_LDA(At, 1, 1); PG8_STAGE(PG8_SB(1, 0), b3, voffB); PG8_STAGE(PG8_SB(1, 1), b3 + hstep, voffB); PG8_STAGE(PG8_SA(1, 0), a3, voffA);
            PG8_WAIT_V(8); PG8_WAIT_L(0); PG8_BAR; PG8_MMA(1, 0, At, B0); PG8_MMA(1, 1, At, B1); PG8_BAR; PG8_SCHED;
            } else {
            PG8_LDB(B0, 0, 0); PG8_SCHED; PG8_LDA(At, 0, 0); PG8_STAGE(PG8_SA(1, 1), a1 + hstep, voffA);
            PG8_WAIT_L(8); PG8_BAR; PG8_WAIT_L(0); PG8_MMA(0, 0, At, B0); PG8_BAR; PG8_SCHED;
            PG8_LDB(B1, 0, 1); PG8_STAGE(PG8_SB(0, 0), b2, voffB);
            PG8_BAR; PG8_WAIT_L(0); PG8_MMA(0, 1, At, B1); PG8_BAR;
            PG8_LDA(At, 0, 1); PG8_STAGE(PG8_SA(0, 0), a2, voffA);
            PG8_BAR; PG8_WAIT_L(0); PG8_MMA(1, 0, At, B0); PG8_BAR; PG8_SCHED;
            PG8_STAGE(PG8_SB(0, 1), b2 + hstep, voffB);
            PG8_WAIT_V(6); PG8_BAR; PG8_MMA(1, 1, At, B1); PG8_BAR;
            PG8_LDB(B0, 1, 0); PG8_SCHED; PG8_LDA(At, 1, 0); PG8_STAGE(PG8_SA(0, 1), a2 + hstep, voffA);
            PG8_WAIT_L(8); PG8_BAR; PG8_WAIT_L(0); PG8_MMA(0, 0, At, B0); PG8_BAR; PG8_SCHED;
            PG8_LDB(B1, 1, 1); PG8_STAGE(PG8_SB(1, 0), b3, voffB);
            PG8_BAR; PG8_WAIT_L(0); PG8_MMA(0, 1, At, B1); PG8_BAR;
            PG8_LDA(At, 1, 1); PG8_STAGE(PG8_SA(1, 0), a3, voffA);
            PG8_BAR; PG8_WAIT_L(0); PG8_MMA(1, 0, At, B0); PG8_BAR; PG8_SCHED;
            PG8_STAGE(PG8_SB(1, 1), b3 + hstep, voffB);
            PG8_WAIT_V(6); PG8_BAR; PG8_MMA(1, 1, At, B1); PG8_BAR;
            }
        }
        if constexpr (ALIGN_EPI) { if (wr == 0) PG8_BAR; }
        if constexpr (!Epi::AFTER_DRAIN) { E(acc, cur, wr, wc, fr, fq); S.done(cur); }
        if (!has_next) break;
#pragma unroll
        for (int a = 0; a < 2; ++a)
#pragma unroll
            for (int b = 0; b < 2; ++b)
#pragma unroll
                for (int m = 0; m < 4; ++m)
#pragma unroll
                    for (int n = 0; n < 2; ++n) acc[a][b][m][n] = (f32x4){0.f, 0.f, 0.f, 0.f};
        cur = nxt; cA = nA; cB = nB; ++ui;
        if constexpr (ALIGN_EPI) { if (wr == 1) PG8_BAR; }
    }
    PG8_WAIT_V(0);
    if constexpr (!ALIGN_EPI) { if (wr == 0) PG8_BAR; }
    PG8_BAR;
    if constexpr (Epi::AFTER_DRAIN) { E.fused(acc, cur, wr, wc, fr, fq, lds, wid, lane); S.done(cur); }
#undef PG8_SA
#undef PG8_SB
#undef PG8_STAGE
#undef PG8_LDA
#undef PG8_LDB
#undef PG8_MMA
#undef PG8_WAIT_V
#undef PG8_WAIT_L
#undef PG8_BAR
#undef PG8_SCHED
}
}
constexpr int T = 16384, DM = 1024, NL = 4, DFF = 2816;
constexpr int NP1 = 2560, NP2 = 5120;
constexpr int C1_VRES = 1792, C1_CQ = 1824, C1_CKV = 2208, C1_KR = 2464;
constexpr int C2_HQ = 0, C2_HF = 512, C2_HI = 1024, C2_HG = 1536, C2_GATE = 2048;
constexpr float NORM_EPS = 1e-6f;
constexpr float QSCALE = 0.10206207261596575f * 1.4426950408889634f;
constexpr float LOG2E = 1.4426950408889634f;

constexpr size_t MiB = 1u << 20;
constexpr size_t WS_CTL = 0;
constexpr size_t WS_COS = 1 * MiB, WS_SIN = 2 * MiB, WS_LB = 3 * MiB;
constexpr size_t WS_WA = 4 * MiB;
constexpr size_t WA_GU = WS_WA, WA_D = WS_WA + (size_t)5632 * 1024 * 2;
constexpr size_t WS_WB = 22 * MiB;
constexpr size_t WB_IN = WS_WB;
constexpr size_t WB_LORA = WB_IN + (size_t)7680 * 1024 * 2;
constexpr size_t WB_UQ = WB_LORA + (size_t)2048 * 384 * 2;
constexpr size_t WB_UK = WB_UQ + (size_t)768 * 384 * 2;
constexpr size_t WB_UV = WB_UK + (size_t)512 * 256 * 2;
constexpr size_t WB_OUT = WB_UV + (size_t)512 * 256 * 2;
constexpr size_t WB_O = WB_OUT + (size_t)3 * 1024 * 512 * 2;
static_assert(WB_O + (size_t)1024 * 1024 * 2 <= 46 * MiB, "W_B region");
static_assert(WA_D + (size_t)1024 * 2816 * 2 <= 22 * MiB, "W_A region");
constexpr size_t WS_VFIRST = 46 * MiB;
constexpr size_t WS_P1 = 62 * MiB;
constexpr size_t WS_P2 = 142 * MiB;
constexpr size_t WS_ACT = WS_P1;
constexpr size_t WS_LORA = WS_P1;
constexpr size_t WS_YA = WS_P1 + 64 * MiB;
constexpr size_t WS_MERGED = WS_P1;
constexpr size_t WS_Y = 302 * MiB;
constexpr size_t WS_XN = 366 * MiB;
constexpr size_t WS_RB = 302 * MiB, WS_KB = 318 * MiB, WS_VB = 334 * MiB;
constexpr size_t WS_Q = 350 * MiB;
constexpr size_t WS_KNOPE = 374 * MiB;
constexpr size_t WS_LIN = 398 * MiB;
constexpr size_t WS_CQN = 410 * MiB;
constexpr size_t WS_CKVN = 422 * MiB;
constexpr size_t WS_KROPE = 430 * MiB;
constexpr size_t WS_DVEC = 431 * MiB;
constexpr size_t WS_DS = 432 * MiB;
constexpr size_t WS_VT = 464 * MiB;
constexpr size_t WS_YB = 398 * MiB, WS_YC = 414 * MiB;
constexpr size_t WS_PU = 480 * MiB;
constexpr size_t WS_SINIT = 488 * MiB;
constexpr size_t WS_END = 492 * MiB;

constexpr int LDS_BYTES = 159744;

typedef unsigned short bf16_t;
typedef unsigned v4u __attribute__((ext_vector_type(4)));
typedef unsigned v2u __attribute__((ext_vector_type(2)));
typedef float f32x4 __attribute__((ext_vector_type(4)));
typedef float f32x16 __attribute__((ext_vector_type(16)));
typedef short bf16x8 __attribute__((ext_vector_type(8)));
#define LDS_WAIT() asm volatile("s_waitcnt lgkmcnt(0)" ::: "memory")
__device__ __forceinline__ unsigned f2bf(float f) { unsigned u = __float_as_uint(f); return (u + 0x7fffu + ((u >> 16) & 1u)) >> 16; }
typedef float f32x2_t __attribute__((ext_vector_type(2))); typedef __bf16 bf16x2_t __attribute__((ext_vector_type(2)));
__device__ __forceinline__ unsigned pk2(float lo, float hi) { f32x2_t v = {lo, hi}; bf16x2_t b = __builtin_convertvector(v, bf16x2_t); return __builtin_bit_cast(unsigned, b); }
__device__ __forceinline__ float bflo(unsigned w) { return __uint_as_float(w << 16); }
__device__ __forceinline__ float bfhi(unsigned w) { return __uint_as_float(w & 0xffff0000u); }
__device__ __forceinline__ float bf1(bf16_t v) { return __uint_as_float(((unsigned)v) << 16); }
__device__ __forceinline__ float sigm(float x) { return 1.0f / (1.0f + __expf(-x)); }
__device__ __forceinline__ float wave_sum(float v) {
#pragma unroll
    for (int o = 1; o < 64; o <<= 1) v += __shfl_xor(v, o);
    return v;
}
template <int CTRL> __device__ __forceinline__ float dppf(float x) { return __int_as_float(__builtin_amdgcn_update_dpp(0, __float_as_int(x), CTRL, 0xF, 0xF, true)); }
__device__ __forceinline__ float red16(float x) {
    x += dppf<0xB1>(x);
    x += dppf<0x4E>(x);
    x += dppf<0x141>(x);
    x += dppf<0x140>(x);
    return x;
}
__device__ __forceinline__ void unpack8(const v4u w, float* f) { f[0] = bflo(w.x); f[1] = bfhi(w.x); f[2] = bflo(w.y); f[3] = bfhi(w.y); f[4] = bflo(w.z); f[5] = bfhi(w.z); f[6] = bflo(w.w); f[7] = bfhi(w.w); }
__device__ __forceinline__ v4u pack8(const float* f) { v4u w; w.x = pk2(f[0], f[1]); w.y = pk2(f[2], f[3]); w.z = pk2(f[4], f[5]); w.w = pk2(f[6], f[7]); return w; }

struct Params { const void* in[40]; float* out; unsigned char* ws; };

__device__ __forceinline__ void conv_item(const float* __restrict__ W, int ldw, int k0, int n0, bf16_t* WT, int ldk, int drow0, int extra16, float* scr, int lane) {
#pragma unroll 8
    for (int i = 0; i < 32; ++i) { const int kk = 2 * i + (lane >> 5); scr[kk * 33 + (lane & 31)] = W[(size_t)(k0 + kk) * ldw + n0 + (lane & 31)]; }
    LDS_WAIT();
    const int c = lane & 7;
#pragma unroll
    for (int j = 0; j < 4; ++j) { const int n = (lane >> 3) + 8 * j; const float* s = scr + (8 * c) * 33 + n;
        v4u o; o.x = pk2(s[0 * 33], s[1 * 33]); o.y = pk2(s[2 * 33], s[3 * 33]); o.z = pk2(s[4 * 33], s[5 * 33]); o.w = pk2(s[6 * 33], s[7 * 33]);
        const int row = drow0 + n + (n >= 16 ? extra16 : 0);
        *(v4u*)(WT + (size_t)row * ldk + k0 + 8 * c) = o; }
    LDS_WAIT();
}
__device__ __forceinline__ void zero_item(bf16_t* WT, int ldk, int row0, int k0, int lane) {
    const int c = lane & 7;
#pragma unroll
    for (int j = 0; j < 4; ++j) { const int n = (lane >> 3) + 8 * j; *(v4u*)(WT + (size_t)(row0 + n) * ldk + k0 + 8 * c) = (v4u){0u, 0u, 0u, 0u}; }
}
__device__ __forceinline__ void conv_ffn(const float* wg, const float* wu, const float* wd, unsigned char* ws, unsigned char* lds, int wg0) {
    PHASE_IDS; float* scr = (float*)(lds + wave * 8448);
    if (bid < wg0) return;
    const int gw_ = (bid - wg0) * 8 + wave, ngw_ = (G - wg0) * 8;
    bf16_t* GU = (bf16_t*)(ws + WA_GU); bf16_t* Dn = (bf16_t*)(ws + WA_D);
    for (int it = gw_; it < 3 * 1408; it += ngw_) {
        int r = it;
        if (r < 1408) { const int kb = r / 88, nb = r % 88; conv_item(wg, DFF, 64 * kb, 32 * nb, GU, 1024, 64 * nb, 16, scr, lane); continue; } r -= 1408;
        if (r < 1408) { const int kb = r / 88, nb = r % 88; conv_item(wu, DFF, 64 * kb, 32 * nb, GU, 1024, 64 * nb + 16, 16, scr, lane); continue; } r -= 1408;
        { const int kb = r / 32, nb = r % 32; conv_item(wd, 1024, 64 * kb, 32 * nb, Dn, DFF, 32 * nb, 0, scr, lane); }
    }
}
__device__ __forceinline__ void conv_ffn_item(const float* wg, const float* wu, const float* wd, unsigned char* ws, unsigned char* lds, int item) {
    const int tid = opaque_tid(), lane = tid & 63, wave = __builtin_amdgcn_readfirstlane(tid >> 6); float* scr = (float*)(lds + wave * 8448);
    bf16_t* GU = (bf16_t*)(ws + WA_GU); bf16_t* Dn = (bf16_t*)(ws + WA_D);
    __syncthreads();
    for (int j = 0; j < 8; ++j) {
        int r = item * 64 + wave * 8 + j;
        if (r >= 3 * 1408) break;
        if (r < 1408) { const int kb = r / 88, nb = r % 88; conv_item(wg, DFF, 64 * kb, 32 * nb, GU, 1024, 64 * nb, 16, scr, lane); continue; } r -= 1408;
        if (r < 1408) { const int kb = r / 88, nb = r % 88; conv_item(wu, DFF, 64 * kb, 32 * nb, GU, 1024, 64 * nb + 16, 16, scr, lane); continue; } r -= 1408;
        { const int kb = r / 32, nb = r % 32; conv_item(wd, 1024, 64 * kb, 32 * nb, Dn, DFF, 32 * nb, 0, scr, lane); }
    }
}
__device__ __forceinline__ void conv_mixer(const Params& P, int l, unsigned char* lds) {
    PHASE_IDS; float* scr = (float*)(lds + wave * 8448);
    unsigned char* ws = opaque_ptr(P.ws);
    bf16_t* WIN = (bf16_t*)(ws + WB_IN); bf16_t* WLORA = (bf16_t*)(ws + WB_LORA); bf16_t* WUQ = (bf16_t*)(ws + WB_UQ); bf16_t* WUK = (bf16_t*)(ws + WB_UK);
    bf16_t* WUV = (bf16_t*)(ws + WB_UV); bf16_t* WOUT = (bf16_t*)(ws + WB_OUT); bf16_t* WO = (bf16_t*)(ws + WB_O);
    const float* w_in = GPF(P.in[9]) + (size_t)l * 1024 * 7584;
    const float* w_up = GPF(P.in[12]) + (size_t)l * 64 * 512;
    const float* a_up = GPF(P.in[14]) + (size_t)l * 64 * 512;
    const float* g_up = GPF(P.in[15]) + (size_t)l * 128 * 512;
    const float* vdown = (l > 0) ? GPF(P.in[21]) + (size_t)(l - 1) * 1024 * 32 : nullptr;
    const float* vup = (l > 0) ? GPF(P.in[23]) + (size_t)(l - 1) * 32 * 512 : nullptr;
    const float* w_uq = GPF(P.in[27]) + (size_t)l * 384 * 768;
    const float* w_ukv = GPF(P.in[29]) + (size_t)l * 256 * 1024;
    const float* w_o = GPF(P.in[34]) + (size_t)l * 1024 * 1024;
    constexpr int I_IN = 16 * 237, I_VD = 16, I_PAD = 32, I_LORA = 6 * 64, I_UQ = 6 * 24, I_UKV = 4 * 32, I_OUT = 3 * 256, I_O = 16 * 32;
    constexpr int NITEMS = I_IN + I_VD + I_PAD + I_LORA + I_UQ + I_UKV + I_OUT + I_O;
    for (int it = gw; it < NITEMS; it += ngw) {
        int r = it;
        if (r < I_IN) { const int kb = r / 237, nb = r % 237, n0 = 32 * nb; const int dr = n0 + (n0 < 1792 ? 0 : (n0 < 2464 ? 32 : 96));
            conv_item(w_in, 7584, 64 * kb, n0, WIN, 1024, dr, 0, scr, lane); continue; } r -= I_IN;
        if (r < I_VD) { if (l > 0) conv_item(vdown, 32, 64 * r, 0, WIN, 1024, C1_VRES, 0, scr, lane); else zero_item(WIN, 1024, C1_VRES, 64 * r, lane); continue; } r -= I_VD;
        if (r < I_PAD) { zero_item(WIN, 1024, 2496 + 32 * (r >> 4), 64 * (r & 15), lane); continue; } r -= I_PAD;
        if (r < I_LORA) { const int kb = r / 64, nb = r % 64; const int b = nb >> 4, nn = (32 * nb) & 511;
            const float* src = b == 0 ? w_up : (b == 1 ? a_up : (b == 2 ? g_up : vup));
            const int ks = b == 0 ? 0 : (b == 1 ? 64 : (b == 2 ? 128 : 256)), ke = b == 0 ? 64 : (b == 1 ? 128 : (b == 2 ? 256 : 288));
            const int c = lane & 7;
#pragma unroll
            for (int j = 0; j < 4; ++j) { const int n = (lane >> 3) + 8 * j; float f[8];
#pragma unroll
                for (int e = 0; e < 8; ++e) { const int k = 64 * kb + 8 * c + e; f[e] = (src != nullptr && k >= ks && k < ke) ? src[(size_t)(k - ks) * 512 + nn + n] : 0.f; }
                *(v4u*)(WLORA + (size_t)(32 * nb + n) * 384 + 64 * kb + 8 * c) = pack8(f); }
            continue; } r -= I_LORA;
        if (r < I_UQ) { const int kb = r / 24, nb = r % 24; conv_item(w_uq, 768, 64 * kb, 32 * nb, WUQ, 384, 32 * nb, 0, scr, lane); continue; } r -= I_UQ;
        if (r < I_UKV) { const int kb = r / 32, nb = r % 32, n0 = 32 * nb, h = n0 >> 7, j = n0 & 127;
            if (j < 64) conv_item(w_ukv, 1024, 64 * kb, n0, WUK, 256, h * 64 + j, 0, scr, lane); else conv_item(w_ukv, 1024, 64 * kb, n0, WUV, 256, h * 64 + j - 64, 0, scr, lane);
            continue; } r -= I_UKV;
        if (r < I_OUT) { const int br = r / 256, q = r % 256, kb = q / 32, nb = q % 32;
            const float* src = GPF(P.in[br == 0 ? 25 : (br == 1 ? 30 : 33)]) + (size_t)l * 512 * 1024;
            conv_item(src, 1024, 64 * kb, 32 * nb, WOUT + (size_t)br * 1024 * 512, 512, 32 * nb, 0, scr, lane); continue; } r -= I_OUT;
        { const int kb = r / 32, nb = r % 32; conv_item(w_o, 1024, 64 * kb, 32 * nb, WO, 1024, 32 * nb, 0, scr, lane); }
    }
}

__device__ __forceinline__ void phase_rowwise(const bf16_t* ysrc, const float* hin, float* hout, float wt, const float* g_post, const float* g_pre, bf16_t* xn) {
    PHASE_IDS;
    for (int row = gw; row < T; row += 2 * ngw) {
        const int rowb = row + ngw; const bool two = rowb < T; const int rb = two ? rowb : row;
        f32x4 ha[4], hb[4]; v2u ya[4], yb[4];
        { const f32x4* hr = (const f32x4*)(hin + (size_t)row * DM) + lane; const f32x4* hr2 = (const f32x4*)(hin + (size_t)rb * DM) + lane;
#pragma unroll
          for (int j = 0; j < 4; ++j) { ha[j] = hr[64 * j]; hb[j] = hr2[64 * j]; }
          if (ysrc) { const v2u* yr = (const v2u*)(ysrc + (size_t)row * DM) + lane; const v2u* yr2 = (const v2u*)(ysrc + (size_t)rb * DM) + lane;
#pragma unroll
            for (int j = 0; j < 4; ++j) { ya[j] = yr[64 * j]; yb[j] = yr2[64 * j]; } } }
#pragma unroll
        for (int half = 0; half < 2; ++half) {
            if (half == 1 && !two) break;
            const int r = half ? rowb : row;
            f32x4 h[4];
#pragma unroll
            for (int j = 0; j < 4; ++j) h[j] = half ? hb[j] : ha[j];
            if (ysrc) {
                f32x4 y[4]; float s = 0.f;
#pragma unroll
                for (int j = 0; j < 4; ++j) { const v2u w = half ? yb[j] : ya[j]; y[j] = (f32x4){bflo(w.x), bfhi(w.x), bflo(w.y), bfhi(w.y)}; s += (y[j].x * y[j].x + y[j].y * y[j].y) + (y[j].z * y[j].z + y[j].w * y[j].w); }
                const float rinv = wt * rsqrtf(wave_sum(s) * (1.f / DM) + NORM_EPS);
#pragma unroll
                for (int j = 0; j < 4; ++j) { const f32x4 g = *((const f32x4*)g_post + lane + 64 * j); h[j] = h[j] + y[j] * g * rinv; }
            }
            f32x4* ho = (f32x4*)(hout + (size_t)r * DM) + lane;
#pragma unroll
            for (int j = 0; j < 4; ++j) ho[64 * j] = h[j];
            if (g_pre) {
                float s = 0.f;
#pragma unroll
                for (int j = 0; j < 4; ++j) s += (h[j].x * h[j].x + h[j].y * h[j].y) + (h[j].z * h[j].z + h[j].w * h[j].w);
                const float rinv = rsqrtf(wave_sum(s) * (1.f / DM) + NORM_EPS);
                unsigned long long* o8 = (unsigned long long*)(xn + (size_t)r * DM) + lane;
#pragma unroll
                for (int j = 0; j < 4; ++j) { const f32x4 g = *((const f32x4*)g_pre + lane + 64 * j); const f32x4 v = h[j] * g * rinv;
                    o8[64 * j] = (unsigned long long)pk2(v.x, v.y) | ((unsigned long long)pk2(v.z, v.w) << 32); }
            }
        }
    }
}
#define LAS __attribute__((address_space(3)))
#define XB_TMO      128
#define XB_XCNT(j)  (256  + 64 * (j))
#define XB_XSUB(j)  (1280 + 64 * (j))
#define XB_XGEN(j)  (2304 + 64 * (j))
#define XB_TOP      3328
#define XB_TOPGEN   3392
#define XCD_BAR_WORDS 3456
#define XB_SPIN_CAP (1u << 18)

__device__ __forceinline__ unsigned xb_ld(unsigned* p)              { return __hip_atomic_load(p, __ATOMIC_RELAXED, __HIP_MEMORY_SCOPE_AGENT); }
__device__ __forceinline__ unsigned xb_add(unsigned* p, unsigned v) { return __hip_atomic_fetch_add(p, v, __ATOMIC_RELAXED, __HIP_MEMORY_SCOPE_AGENT); }
__device__ __forceinline__ unsigned xb_xcc_id() { return (unsigned)__builtin_amdgcn_s_getreg((3 << 11) | 20) & 0xFu; }
#define XB_SPIN(cond, bar) do { unsigned _sp = 0; while (cond) { __builtin_amdgcn_s_sleep(1); \
    if ((++_sp & 255u) == 0u) { if (xb_ld(&(bar)[XB_TMO])) break; if (_sp > XB_SPIN_CAP) { atomicAdd(&(bar)[XB_TMO], 1u); break; } } } } while (0)

struct XcdBarrier {
    unsigned* bar; unsigned x;
    volatile LAS unsigned* st;
};

__device__ __forceinline__ XcdBarrier xcd_barrier_post(unsigned* bar, volatile LAS unsigned* st) {
    XcdBarrier b; b.bar = bar; b.x = xb_xcc_id(); b.st = st;
    if (threadIdx.x == 0) (void)xb_add(&bar[XB_XCNT(b.x)], 1u);
    return b;
}
__device__ __forceinline__ void xcd_barrier_complete(unsigned* bar, unsigned x, unsigned& nloc, unsigned& nx) {
    const unsigned G = gridDim.x * gridDim.y * gridDim.z;
    unsigned sum, cnt, mine, sp = 0u;
    for (;;) {
        sum = 0u; cnt = 0u; mine = 0u;
#pragma unroll
        for (unsigned j = 0; j < 16; ++j) { const unsigned c = xb_ld(&bar[XB_XCNT(j)]); sum += c; cnt += (c > 0u) ? 1u : 0u; mine = (j == x) ? c : mine; }
        if (sum == G) break;
        __builtin_amdgcn_s_sleep(1);
        if ((++sp & 255u) == 0u) { if (xb_ld(&bar[XB_TMO])) break; if (sp > XB_SPIN_CAP) { atomicAdd(&bar[XB_TMO], 1u); break; } }
    }
    nloc = mine > 0u ? mine : 1u; nx = cnt > 0u ? cnt : 1u;
}

__device__ __forceinline__ void xcd_barrier(const XcdBarrier& b) {
    asm volatile("s_waitcnt vmcnt(0)" ::: "memory");
    __syncthreads();
    if (threadIdx.x == 0) {
        unsigned* bar = b.bar;
        __builtin_amdgcn_s_waitcnt(0);
        unsigned nloc = b.st[0], nx = b.st[1];
        if (nloc == 0u) { xcd_barrier_complete(bar, b.x, nloc, nx); b.st[0] = nloc; b.st[1] = nx; }
        const unsigned old = xb_add(&bar[XB_XSUB(b.x)], 1u);
        const unsigned gen = old / nloc;
        if (old + 1u == (gen + 1u) * nloc) {
            __builtin_amdgcn_fence(__ATOMIC_RELEASE, "agent");
            asm volatile("s_waitcnt vmcnt(0)" ::: "memory");
            const unsigned og = xb_add(&bar[XB_TOP], 1u);
            const unsigned tg = og / nx;
            if (og + 1u == (tg + 1u) * nx) xb_add(&bar[XB_TOPGEN], 1u);
            else XB_SPIN(xb_ld(&bar[XB_TOPGEN]) == tg, bar);
            __builtin_amdgcn_fence(__ATOMIC_ACQUIRE, "agent");
            xb_add(&bar[XB_XGEN(b.x)], 1u);
            asm volatile("s_waitcnt vmcnt(0)" ::: "memory");
        } else {
            XB_SPIN(xb_ld(&bar[XB_XGEN(b.x)]) == gen, bar);
            __builtin_amdgcn_fence(__ATOMIC_ACQUIRE, "agent");
            asm volatile("s_waitcnt vmcnt(0)" ::: "memory");
        }
    }
    __syncthreads();
}
__device__ __forceinline__ void phase_tables(const Params& P) {
    PHASE_IDS;
    float* COS = (float*)(opaque_ptr(P.ws) + WS_COS); float* SIN = (float*)(opaque_ptr(P.ws) + WS_SIN); float* LB = (float*)(opaque_ptr(P.ws) + WS_LB);
    const int* pos = GPI(P.in[1]);
    for (int e = gtid; e < T * 16; e += gthreads) {
        const int t = e >> 4, i = e & 15;
        const double inv_freq = exp(-(double)i * (9.210340371976184 / 16.0));
        double rev = (double)pos[t] * inv_freq * 0.15915494309189535;
        rev -= floor(rev);
        const float x = (float)rev;
        COS[e] = __builtin_amdgcn_cosf(x); SIN[e] = __builtin_amdgcn_sinf(x);
    }
    if (gtid < 512) {
        const float* lbw = GPF(P.in[31]);
        float v[NL], mx = -1e30f, s = 0.f;
#pragma unroll
        for (int l = 0; l < NL; ++l) { v[l] = lbw[l * 512 + gtid]; mx = fmaxf(mx, v[l]); }
#pragma unroll
        for (int l = 0; l < NL; ++l) { v[l] = __expf(v[l] - mx); s += v[l]; }
        float c = 0.f; const float p0 = v[0] / s;
#pragma unroll
        for (int l = 0; l < NL; ++l) { c += v[l] / s; LB[l * 512 + gtid] = c - p0; }
    }
}

__device__ __forceinline__ void phase_prep(const Params& P, int l) {
    PHASE_IDS;
    unsigned char* ws = opaque_ptr(P.ws);
    const bf16_t* P1 = (const bf16_t*)(ws + WS_P1);
    bf16_t* RB = (bf16_t*)(ws + WS_RB); bf16_t* KB = (bf16_t*)(ws + WS_KB); bf16_t* VB = (bf16_t*)(ws + WS_VB); bf16_t* VF = (bf16_t*)(ws + WS_VFIRST);
    bf16_t* LIN = (bf16_t*)(ws + WS_LIN); bf16_t* CQN = (bf16_t*)(ws + WS_CQN); bf16_t* CKVN = (bf16_t*)(ws + WS_CKVN); bf16_t* KROPE = (bf16_t*)(ws + WS_KROPE);
    const float* COS = (const float*)(ws + WS_COS); const float* SIN = (const float*)(ws + WS_SIN);
    const float* mu = GPF(P.in[10]) + (size_t)l * 1792;
    const float* vmu = (l > 0) ? GPF(P.in[22]) + (size_t)(l - 1) * 32 : nullptr;
    const float* qg = GPF(P.in[26]) + (size_t)l * 384;
    const float* kvg = GPF(P.in[28]) + (size_t)l * 256;
    for (int t = gw; t < T; t += ngw) {
        const unsigned* cur = (const unsigned*)(P1 + (size_t)t * NP1);
        const unsigned* prv = (const unsigned*)(P1 + (size_t)(t > 0 ? t - 1 : 0) * NP1);
        const bool hasp = t > 0;
#pragma unroll
        for (int i = 0; i < 14; ++i) {
            const int j = lane + 64 * i, col = 2 * j;
            const unsigned cw = cur[j], pw = hasp ? prv[j] : 0u;
            const float c0 = bflo(cw), c1 = bfhi(cw), p0 = bflo(pw), p1 = bfhi(pw);
            float m0 = c0 + (p0 - c0) * mu[col], m1 = c1 + (p1 - c1) * mu[col + 1];
            if (i < 4) { *(unsigned*)(RB + (size_t)t * 512 + col) = pk2(m0, m1); }
            else if (i < 8) { *(unsigned*)(KB + (size_t)t * 512 + col - 512) = pk2(m0, m1); }
            else if (i < 12) { const unsigned w = pk2(m0, m1); *(unsigned*)(VB + (size_t)t * 512 + col - 1024) = w; if (l == 0) *(unsigned*)(VF + (size_t)t * 512 + col - 1024) = w; }
            else {
                if (col < 1600) { m0 = tanhf(m0); m1 = tanhf(m1); } else if (col >= 1664) { m0 = sigm(m0); m1 = sigm(m1); }
                *(unsigned*)(LIN + (size_t)t * 384 + col - 1536) = pk2(m0, m1);
            }
        }
        if (lane < 16) {
            unsigned w = 0u;
            if (l > 0) { const int j = (C1_VRES >> 1) + lane; const unsigned cw = cur[j], pw = hasp ? prv[j] : 0u;
                const float c0 = bflo(cw), c1 = bfhi(cw), p0 = bflo(pw), p1 = bfhi(pw);
                w = pk2(c0 + (p0 - c0) * vmu[2 * lane], c1 + (p1 - c1) * vmu[2 * lane + 1]); }
            *(unsigned*)(LIN + (size_t)t * 384 + 256 + 2 * lane) = w;
        } else {
            *(unsigned*)(LIN + (size_t)t * 384 + 288 + 2 * (lane - 16)) = 0u;
        }
        {
            float c[6]; float s = 0.f;
#pragma unroll
            for (int i = 0; i < 3; ++i) { const unsigned w = cur[(C1_CQ >> 1) + lane + 64 * i]; c[2 * i] = bflo(w); c[2 * i + 1] = bfhi(w); s += c[2 * i] * c[2 * i] + c[2 * i + 1] * c[2 * i + 1]; }
            const float rinv = rsqrtf(wave_sum(s) * (1.f / 384.f) + NORM_EPS);
#pragma unroll
            for (int i = 0; i < 3; ++i) { const int cc = 2 * (lane + 64 * i); *(unsigned*)(CQN + (size_t)t * 384 + cc) = pk2(c[2 * i] * rinv * qg[cc], c[2 * i + 1] * rinv * qg[cc + 1]); }
        }
        {
            float c[4]; float s = 0.f;
#pragma unroll
            for (int i = 0; i < 2; ++i) { const unsigned w = cur[(C1_CKV >> 1) + lane + 64 * i]; c[2 * i] = bflo(w); c[2 * i + 1] = bfhi(w); s += c[2 * i] * c[2 * i] + c[2 * i + 1] * c[2 * i + 1]; }
            const float rinv = rsqrtf(wave_sum(s) * (1.f / 256.f) + NORM_EPS);
#pragma unroll
            for (int i = 0; i < 2; ++i) { const int cc = 2 * (lane + 64 * i); *(unsigned*)(CKVN + (size_t)t * 256 + cc) = pk2(c[2 * i] * rinv * kvg[cc], c[2 * i + 1] * rinv * kvg[cc + 1]); }
        }
        if (lane < 16) {
            const bf16_t* row = P1 + (size_t)t * NP1 + C1_KR;
            const float x1 = bf1(row[lane]), x2 = bf1(row[16 + lane]);
            const float cs = COS[t * 16 + lane], sn = SIN[t * 16 + lane];
            KROPE[(size_t)t * 32 + lane] = (bf16_t)f2bf(x1 * cs - x2 * sn);
            KROPE[(size_t)t * 32 + 16 + lane] = (bf16_t)f2bf(x2 * cs + x1 * sn);
        }
    }
}

__device__ __forceinline__ void hgrn_a_unit(const Params& P, int l, int unit, unsigned char* lds) {
    const int tid = opaque_tid();
    const int c = unit >> 2, h = unit & 3, t0 = c * 64;
    const bf16_t* P2 = (const bf16_t*)(opaque_ptr(P.ws) + WS_P2);
    const float* LB = (const float*)(opaque_ptr(P.ws) + WS_LB) + l * 512 + h * 128;
    float* kd = (float*)lds;
    float* kg = (float*)(lds + 32768);
    bf16_t* vT = (bf16_t*)(lds + 65536);
    bf16_t* kdT = (bf16_t*)(lds + 102400);
    float* bl = (float*)(lds + 98304);
    __syncthreads();
#pragma unroll
    for (int i = 0; i < 8; ++i) {
        const int e = tid + 512 * i, s = e >> 6, k2 = (e & 63) * 2;
        const unsigned fw = *(const unsigned*)(P2 + (size_t)(t0 + s) * NP2 + C2_HF + h * 128 + k2);
        const unsigned iw = *(const unsigned*)(P2 + (size_t)(t0 + s) * NP2 + C2_HI + h * 128 + k2);
        const float lb0 = LB[k2], lb1 = LB[k2 + 1];
        const float z0 = bflo(fw), z1 = bfhi(fw);
        const float f0 = lb0 + (1.f - lb0) * sigm(z0), f1 = lb1 + (1.f - lb1) * sigm(z1);
        kd[s * 128 + k2] = __logf(fmaxf(f0, 1e-6f)); kd[s * 128 + k2 + 1] = __logf(fmaxf(f1, 1e-6f));
        kg[s * 128 + k2] = (1.f - lb0) * sigm(-z0); kg[s * 128 + k2 + 1] = (1.f - lb1) * sigm(-z1);
        vT[k2 * 72 + s] = (bf16_t)(iw & 0xffffu); vT[(k2 + 1) * 72 + s] = (bf16_t)(iw >> 16);
    }
    __syncthreads();
    {
        float* tot = bl + 128;
        const int k = tid & 127, seg = tid >> 7; float b = 0.f;
#pragma unroll 4
        for (int s = 16 * seg; s < 16 * seg + 16; ++s) { b += kd[s * 128 + k]; kd[s * 128 + k] = b; }
        tot[seg * 128 + k] = b;
        __syncthreads();
        float off = 0.f;
        if (seg > 0) off += tot[k]; if (seg > 1) off += tot[128 + k]; if (seg > 2) off += tot[256 + k];
#pragma unroll 4
        for (int s = 16 * seg; s < 16 * seg + 16; ++s) kd[s * 128 + k] += off;
        if (seg == 3) { const float bt_ = b + off; bl[k] = bt_; ((float*)(opaque_ptr(P.ws) + WS_DVEC))[(size_t)unit * 128 + k] = __expf(bt_); }
    }
    __syncthreads();
#pragma unroll
    for (int i = 0; i < 16; ++i) { const int e = tid + 512 * i, k = e & 127, s = e >> 7; kdT[k * 72 + s] = (bf16_t)f2bf(kg[e] * __expf(bl[k] - kd[e])); }
    __syncthreads();
    {
        const int lane = tid & 63, w = __builtin_amdgcn_readfirstlane(tid >> 6), lr = lane & 15, kgp = lane >> 4;
        const bf16x8 B0 = *(const bf16x8*)(vT + (16 * w + lr) * 72 + 8 * kgp), B1 = *(const bf16x8*)(vT + (16 * w + lr) * 72 + 32 + 8 * kgp);
        bf16_t* DS = (bf16_t*)(opaque_ptr(P.ws) + WS_DS) + (size_t)unit * 16384;
#pragma unroll
        for (int kt_ = 0; kt_ < 8; ++kt_) {
            const bf16x8 A0 = *(const bf16x8*)(kdT + (16 * kt_ + lr) * 72 + 8 * kgp), A1 = *(const bf16x8*)(kdT + (16 * kt_ + lr) * 72 + 32 + 8 * kgp);
            f32x4 a4 = (f32x4){0.f, 0.f, 0.f, 0.f};
            a4 = __builtin_amdgcn_mfma_f32_16x16x32_bf16(A0, B0, a4, 0, 0, 0);
            a4 = __builtin_amdgcn_mfma_f32_16x16x32_bf16(A1, B1, a4, 0, 0, 0);
            *(v2u*)(DS + (16 * w + lr) * 128 + 16 * kt_ + 4 * kgp) = (v2u){pk2(a4[0], a4[1]), pk2(a4[2], a4[3])};
        }
    }
}
__device__ __forceinline__ void hgrn_b(const Params& P, unsigned char* lds) {
    const int tid = opaque_tid(), el = tid & 127, qtr = __builtin_amdgcn_readfirstlane(tid >> 7);
    float* xd = (float*)lds;
    float* xs = xd + 512;
    for (int it = blockIdx.x; it < 512; it += gridDim.x) {
        const int h = it >> 7, kvb = (it & 127) * 128;
        bf16_t* dsb = (bf16_t*)(opaque_ptr(P.ws) + WS_DS) + ((size_t)(64 * qtr) * 4 + h) * 16384 + kvb;
        const float* dvb = (const float*)(opaque_ptr(P.ws) + WS_DVEC) + ((size_t)(64 * qtr) * 4 + h) * 128;
        float ds[64], dv[64];
#pragma unroll
        for (int i = 0; i < 64; ++i) { ds[i] = bf1(dsb[(size_t)i * 65536 + el]); dv[i] = dvb[(size_t)i * 512 + el]; }
        float D = 1.f, S = 0.f;
#pragma unroll
        for (int i = 0; i < 64; ++i) { S = dv[i] * S + ds[i]; D *= dv[i]; }
        __syncthreads();
        xd[qtr * 128 + el] = D; xs[qtr * 128 + el] = S;
        __syncthreads();
        S = 0.f;
        for (int j = 0; j < qtr; ++j) S = xd[j * 128 + el] * S + xs[j * 128 + el];
#pragma unroll
        for (int i = 0; i < 64; ++i) { dsb[(size_t)i * 65536 + el] = (bf16_t)f2bf(S); S = dv[i] * S + ds[i]; }
    }
}
__device__ __forceinline__ void hgrn_c_unit(const Params& P, int l, int unit, unsigned char* lds) {
    const int tid = opaque_tid();
    const int c = unit >> 2, h = unit & 3, t0 = c * 64;
    const bf16_t* P2 = (const bf16_t*)(opaque_ptr(P.ws) + WS_P2);
    const float* LB = (const float*)(opaque_ptr(P.ws) + WS_LB) + l * 512 + h * 128;
    constexpr int RS = 132;
    float* qs = (float*)lds;
    float* bs = (float*)(lds + 33792);
    float* ks = (float*)(lds + 67584);
    float* kt = (float*)(lds + 101376);
    float* at = (float*)(lds + 135168);
    float* bl = (float*)(lds + 152576);
    __syncthreads();
#pragma unroll
    for (int i = 0; i < 9; ++i) { const int e = tid + 512 * i; if (e < 64 * 68) at[e] = 0.f; }
#pragma unroll
    for (int i = 0; i < 8; ++i) {
        const int e = tid + 512 * i, s = e >> 6, k2 = (e & 63) * 2;
        const unsigned qw = *(const unsigned*)(P2 + (size_t)(t0 + s) * NP2 + C2_HQ + h * 128 + k2);
        const unsigned fw = *(const unsigned*)(P2 + (size_t)(t0 + s) * NP2 + C2_HF + h * 128 + k2);
        const float lb0 = LB[k2], lb1 = LB[k2 + 1];
        const float z0 = bflo(fw), z1 = bfhi(fw), q0 = bflo(qw), q1 = bfhi(qw);
        const float f0 = lb0 + (1.f - lb0) * sigm(z0), f1 = lb1 + (1.f - lb1) * sigm(z1);
        bs[s * RS + k2] = __logf(fmaxf(f0, 1e-6f)) * LOG2E; bs[s * RS + k2 + 1] = __logf(fmaxf(f1, 1e-6f)) * LOG2E;
        ks[s * RS + k2] = (1.f - lb0) * sigm(-z0); ks[s * RS + k2 + 1] = (1.f - lb1) * sigm(-z1);
        qs[s * RS + k2] = q0 * sigm(q0); qs[s * RS + k2 + 1] = q1 * sigm(q1);
    }
    __syncthreads();
    {
        float* tot = bl + 1024;
        const int k = tid & 127, seg = tid >> 7; float b = 0.f;
#pragma unroll 4
        for (int s = 16 * seg; s < 16 * seg + 16; ++s) { b += bs[s * RS + k]; bs[s * RS + k] = b; }
        tot[seg * 128 + k] = b;
        __syncthreads();
        float off = 0.f;
        if (seg > 0) off += tot[k]; if (seg > 1) off += tot[128 + k]; if (seg > 2) off += tot[256 + k];
#pragma unroll 4
        for (int s = 16 * seg; s < 16 * seg + 16; ++s) { const float v_ = bs[s * RS + k] + off; bs[s * RS + k] = v_; if ((s & 7) == 7) bl[(s >> 3) * 128 + k] = v_; }
    }
    __syncthreads();
    {
        bf16_t* k16 = (bf16_t*)kt;
#pragma unroll 1
        for (int pass = 0; pass < 2; ++pass) {
            const int p = tid + 512 * pass;
            if (p < 544) {
                int t, s;
                if (p < 288) { const int blk = p / 36, idx = p - 36 * blk; int tl = 0; while (((tl + 1) * (tl + 2) >> 1) <= idx) ++tl; t = 8 * blk + tl; s = 8 * blk + idx - (tl * (tl + 1) >> 1); }
                else { const int q_ = p - 288, m = q_ >> 6; t = 16 * m + 8 + ((q_ >> 3) & 7); s = 16 * m + (q_ & 7); }
                float a = 0.f;
                for (int k4 = 0; k4 < 128; k4 += 4) {
                    const f32x4 q4 = *(const f32x4*)(qs + t * RS + k4), bt = *(const f32x4*)(bs + t * RS + k4), k4v = *(const f32x4*)(ks + s * RS + k4), b4 = *(const f32x4*)(bs + s * RS + k4);
                    a += (q4[0] * k4v[0] * __builtin_amdgcn_exp2f(bt[0] - b4[0]) + q4[1] * k4v[1] * __builtin_amdgcn_exp2f(bt[1] - b4[1]))
                       + (q4[2] * k4v[2] * __builtin_amdgcn_exp2f(bt[2] - b4[2]) + q4[3] * k4v[3] * __builtin_amdgcn_exp2f(bt[3] - b4[3])); }
                at[t * 68 + s] = a;
            }
        }
#pragma unroll
        for (int i = 0; i < 4; ++i) { const int e = tid + 512 * i, s = e >> 5, k4 = (e & 31) * 4;
            const f32x4 kg4 = *(const f32x4*)(ks + s * RS + k4), b4 = *(const f32x4*)(bs + s * RS + k4), bj = *(const f32x4*)(bl + (2 * (s >> 4) + 1) * 128 + k4);
            *(v2u*)(k16 + s * 136 + k4) = (v2u){pk2(kg4[0] * __builtin_amdgcn_exp2f(bj[0] - b4[0]), kg4[1] * __builtin_amdgcn_exp2f(bj[1] - b4[1])),
                                               pk2(kg4[2] * __builtin_amdgcn_exp2f(bj[2] - b4[2]), kg4[3] * __builtin_amdgcn_exp2f(bj[3] - b4[3]))}; }
        __syncthreads();
        {
            const int lane = tid & 63, w = __builtin_amdgcn_readfirstlane(tid >> 6), lr = lane & 15, kgp = lane >> 4;
            if (w < 6) {
                const int m = (w == 0) ? 1 : (w < 3 ? 2 : 3), n = (w == 0) ? 0 : (w < 3 ? w - 1 : w - 3);
                const int trow = 16 * m + lr, srow = 16 * n + lr;
                f32x4 a4 = (f32x4){0.f, 0.f, 0.f, 0.f};
#pragma unroll
                for (int kstep = 0; kstep < 4; ++kstep) {
                    const int k0 = 32 * kstep + 8 * kgp;
                    const f32x4 q0 = *(const f32x4*)(qs + trow * RS + k0), q1 = *(const f32x4*)(qs + trow * RS + k0 + 4);
                    const f32x4 t0_ = *(const f32x4*)(bs + trow * RS + k0), t1_ = *(const f32x4*)(bs + trow * RS + k0 + 4);
                    const f32x4 j0 = *(const f32x4*)(bl + (2 * n + 1) * 128 + k0), j1 = *(const f32x4*)(bl + (2 * n + 1) * 128 + k0 + 4);
                    const bf16x8 A = __builtin_bit_cast(bf16x8, ((v4u){
                        pk2(q0[0] * __builtin_amdgcn_exp2f(t0_[0] - j0[0]), q0[1] * __builtin_amdgcn_exp2f(t0_[1] - j0[1])), pk2(q0[2] * __builtin_amdgcn_exp2f(t0_[2] - j0[2]), q0[3] * __builtin_amdgcn_exp2f(t0_[3] - j0[3])),
                        pk2(q1[0] * __builtin_amdgcn_exp2f(t1_[0] - j1[0]), q1[1] * __builtin_amdgcn_exp2f(t1_[1] - j1[1])), pk2(q1[2] * __builtin_amdgcn_exp2f(t1_[2] - j1[2]), q1[3] * __builtin_amdgcn_exp2f(t1_[3] - j1[3]))}));
                    const bf16x8 B = *(const bf16x8*)(k16 + srow * 136 + k0);
                    a4 = __builtin_amdgcn_mfma_f32_16x16x32_bf16(A, B, a4, 0, 0, 0);
                }
#pragma unroll
                for (int r = 0; r < 4; ++r) at[(16 * m + 4 * kgp + r) * 68 + 16 * n + lr] = a4[r];
            }
        }
    }
    __syncthreads();
#pragma unroll
    for (int i = 0; i < 16; ++i) { const int e = tid + 512 * i, s = e >> 7, k = e & 127; qs[s * RS + k] *= __builtin_amdgcn_exp2f(bs[s * RS + k]); }
    __syncthreads();
    bf16_t* S0T = (bf16_t*)(lds + 33792);
    bf16_t* vT = (bf16_t*)(lds + 68608);
    float* os = kt;
    {
        const bf16_t* DS = (const bf16_t*)(opaque_ptr(P.ws) + WS_DS) + (size_t)unit * 16384;
#pragma unroll
        for (int i = 0; i < 4; ++i) { const int e = tid + 512 * i, v = e >> 4, c8 = (e & 15) * 8; *(v4u*)(S0T + v * 136 + c8) = *(const v4u*)(DS + v * 128 + c8); }
#pragma unroll
        for (int i = 0; i < 8; ++i) { const int e = tid + 512 * i, s = e >> 6, k2 = (e & 63) * 2;
            const unsigned iw = *(const unsigned*)(P2 + (size_t)(t0 + s) * NP2 + C2_HI + h * 128 + k2);
            vT[k2 * 72 + s] = (bf16_t)(iw & 0xffffu); vT[(k2 + 1) * 72 + s] = (bf16_t)(iw >> 16); }
    }
    __syncthreads();
    {
        const int lane = tid & 63, w = __builtin_amdgcn_readfirstlane(tid >> 6), tb = w & 3, vh = w >> 2, lr = lane & 15, kg = lane >> 4;
        const int trow = 16 * tb + lr;
        f32x4 acc4[4];
#pragma unroll
        for (int n = 0; n < 4; ++n) acc4[n] = (f32x4){0.f, 0.f, 0.f, 0.f};
#pragma unroll
        for (int kstep = 0; kstep < 6; ++kstep) {
            const float* src = (kstep < 2) ? (at + trow * 68 + 32 * kstep + 8 * kg) : (qs + trow * RS + 32 * (kstep - 2) + 8 * kg);
            const f32x4 x0 = *(const f32x4*)src, x1 = *(const f32x4*)(src + 4);
            const bf16x8 A = __builtin_bit_cast(bf16x8, ((v4u){pk2(x0[0], x0[1]), pk2(x0[2], x0[3]), pk2(x1[0], x1[1]), pk2(x1[2], x1[3])}));
#pragma unroll
            for (int n = 0; n < 4; ++n) { const int col = 64 * vh + 16 * n + lr;
                const bf16x8 B = (kstep < 2) ? *(const bf16x8*)(vT + col * 72 + 32 * kstep + 8 * kg) : *(const bf16x8*)(S0T + col * 136 + 32 * (kstep - 2) + 8 * kg);
                acc4[n] = __builtin_amdgcn_mfma_f32_16x16x32_bf16(A, B, acc4[n], 0, 0, 0); }
        }
#pragma unroll
        for (int n = 0; n < 4; ++n)
#pragma unroll
            for (int r = 0; r < 4; ++r) os[(16 * tb + 4 * kg + r) * RS + 64 * vh + 16 * n + lr] = acc4[n][r];
    }
    __syncthreads();
    {
        const int t = tid >> 3, vg = tid & 7;
        float o[16];
#pragma unroll
        for (int j = 0; j < 4; ++j) { const f32x4 o4 = *(const f32x4*)(os + t * RS + vg * 16 + 4 * j); o[4 * j] = o4[0]; o[4 * j + 1] = o4[1]; o[4 * j + 2] = o4[2]; o[4 * j + 3] = o4[3]; }
        float ss = 0.f;
#pragma unroll
        for (int j = 0; j < 16; ++j) ss += o[j] * o[j];
        ss += __shfl_xor(ss, 1); ss += __shfl_xor(ss, 2); ss += __shfl_xor(ss, 4);
        const float rinv = rsqrtf(ss * (1.f / 128.f) + NORM_EPS);
        const float* ng = GPF(P.in[32]) + (size_t)l * 128 + vg * 16;
        const bf16_t* cg = P2 + (size_t)(t0 + t) * NP2 + C2_HG + h * 128 + vg * 16;
        const v4u g0 = *(const v4u*)cg, g1 = *(const v4u*)(cg + 8);
        float g[16]; unpack8(g0, g); unpack8(g1, g + 8);
        float r[16];
#pragma unroll
        for (int j = 0; j < 16; ++j) r[j] = o[j] * rinv * ng[j] * (g[j] * sigm(g[j]));
        bf16_t* yc = (bf16_t*)(opaque_ptr(P.ws) + WS_YC) + (size_t)(t0 + t) * 512 + h * 128 + vg * 16;
        *(v4u*)yc = pack8(r); *(v4u*)(yc + 8) = pack8(r + 8);
    }
}
__device__ __forceinline__ void phase_prep2(const Params& P, int l) {
    PHASE_IDS;
    unsigned char* ws = opaque_ptr(P.ws);
    bf16_t* LORA = (bf16_t*)(ws + WS_LORA); bf16_t* KB = (bf16_t*)(ws + WS_KB); bf16_t* VB = (bf16_t*)(ws + WS_VB); const bf16_t* VF = (const bf16_t*)(ws + WS_VFIRST);
    bf16_t* Q = (bf16_t*)(ws + WS_Q);
    const float* COS = (const float*)(ws + WS_COS); const float* SIN = (const float*)(ws + WS_SIN);
    const int ch = lane * 8;
    float w0[8], a0[8], kkw[8], kaw[8], v0[8];
#pragma unroll
    for (int e = 0; e < 8; ++e) {
        w0[e] = (GPF(P.in[11]))[l * 512 + ch + e]; a0[e] = (GPF(P.in[13]))[l * 512 + ch + e];
        kkw[e] = (GPF(P.in[16]))[l * 512 + ch + e]; kaw[e] = (GPF(P.in[17]))[l * 512 + ch + e];
        v0[e] = (l > 0) ? (GPF(P.in[24]))[(l - 1) * 512 + ch + e] : 0.f;
    }
    for (int t = gw; t < T; t += ngw) {
        bf16_t* lr = LORA + (size_t)t * 2048 + ch;
        float lw[8], la[8], lv[8], k[8];
        unpack8(*(const v4u*)lr, lw); unpack8(*(const v4u*)(lr + 512), la); unpack8(*(const v4u*)(lr + 1536), lv);
        unpack8(*(const v4u*)(KB + (size_t)t * 512 + ch), k);
        float ew[8], kk[8], bb[8], km[8]; float ss = 0.f;
#pragma unroll
        for (int e = 0; e < 8; ++e) {
            const float x = -(w0[e] + lw[e]);
            const float sp = fmaxf(x, 0.f) + __logf(1.f + __expf(-fabsf(x)));
            ew[e] = __expf(-sp - 0.5f);
            kk[e] = k[e] * kkw[e]; ss += kk[e] * kk[e];
        }
        ss += __shfl_xor(ss, 1); ss += __shfl_xor(ss, 2); ss += __shfl_xor(ss, 4);
        const float kinv = 1.f / fmaxf(sqrtf(ss), 1e-12f);
#pragma unroll
        for (int e = 0; e < 8; ++e) {
            const float a = sigm(a0[e] + la[e]);
            kk[e] *= kinv; bb[e] = kk[e] * a; km[e] = k[e] * (1.f + (a - 1.f) * kaw[e]);
        }
        *(v4u*)lr = pack8(ew); *(v4u*)(lr + 512) = pack8(kk); *(v4u*)(lr + 1536) = pack8(bb);
        *(v4u*)(KB + (size_t)t * 512 + ch) = pack8(km);
        if (l > 0) {
            float v[8], vf[8];
            unpack8(*(const v4u*)(VB + (size_t)t * 512 + ch), v); unpack8(*(const v4u*)(VF + (size_t)t * 512 + ch), vf);
#pragma unroll
            for (int e = 0; e < 8; ++e) v[e] = v[e] + (vf[e] - v[e]) * sigm(v0[e] + lv[e]);
            *(v4u*)(VB + (size_t)t * 512 + ch) = pack8(v);
        }
        {
            const int h = lane >> 3, sub = lane & 7;
            bf16_t* qh = Q + (size_t)t * 768 + h * 96;
            float qn[8]; unpack8(*(const v4u*)(qh + 8 * sub), qn);
#pragma unroll
            for (int e = 0; e < 8; ++e) qn[e] *= QSCALE;
            const unsigned x1w = *(const unsigned*)(qh + 64 + 2 * sub), x2w = *(const unsigned*)(qh + 80 + 2 * sub);
            const float c0 = COS[t * 16 + 2 * sub], c1 = COS[t * 16 + 2 * sub + 1], s0 = SIN[t * 16 + 2 * sub], s1 = SIN[t * 16 + 2 * sub + 1];
            const float x10 = bflo(x1w), x11 = bfhi(x1w), x20 = bflo(x2w), x21 = bfhi(x2w);
            *(v4u*)(qh + 8 * sub) = pack8(qn);
            *(unsigned*)(qh + 64 + 2 * sub) = pk2((x10 * c0 - x20 * s0) * QSCALE, (x11 * c1 - x21 * s1) * QSCALE);
            *(unsigned*)(qh + 80 + 2 * sub) = pk2((x20 * c0 + x10 * s0) * QSCALE, (x21 * c1 + x11 * s1) * QSCALE);
        }
    }
}

constexpr int RW_NC = 32, RW_LC = T / RW_NC;
typedef float f2v __attribute__((ext_vector_type(2)));
#define LO2(v4) (__builtin_shufflevector((v4), (v4), 0, 1))
#define HI2(v4) (__builtin_shufflevector((v4), (v4), 2, 3))
__device__ __forceinline__ float red8(float x) { x += dppf<0xB1>(x); x += dppf<0x4E>(x); x += dppf<0x141>(x); return x; }
template <int MODE>
__device__ __forceinline__ void rwkv_scan_item(const Params& P, int l, unsigned char* lds, int h, int t0, int nchunk, const float* init, float* fin) {
    const int tid = opaque_tid(), lane = tid & 63, wave = tid >> 6, rowgrp = lane >> 3, kq = lane & 7;
    const int row = wave * 8 + rowgrp;
    unsigned char* ws = opaque_ptr(P.ws);
    const bf16_t* LORA = (const bf16_t*)(ws + WS_LORA); const bf16_t* KB = (const bf16_t*)(ws + WS_KB); const bf16_t* RB = (const bf16_t*)(ws + WS_RB); const bf16_t* VB = (const bf16_t*)(ws + WS_VB);
    bf16_t* YA = (bf16_t*)(ws + WS_YA);
    constexpr int BUF = 49152;
    float* ybuf = (float*)(lds + 2 * BUF);
    const bf16_t* src[3]; int dsto[3], sstride[3];
    const int hi8 = tid >> 8, q = tid & 255, st = q >> 3, c8 = q & 7;
    {
        const int a0 = hi8, a1 = 2 + hi8, a2 = 4 + hi8;
        src[0] = (a0 == 0 ? LORA : LORA + 512) + (size_t)st * 2048 + h * 64 + c8 * 8; sstride[0] = 2048; dsto[0] = (a0 * 2048 + st * 64 + c8 * 8) * 4;
        src[1] = (a1 == 2 ? LORA + 1536 + (size_t)st * 2048 : KB + (size_t)st * 512) + h * 64 + c8 * 8; sstride[1] = (a1 == 2) ? 2048 : 512; dsto[1] = (a1 * 2048 + st * 64 + c8 * 8) * 4;
        src[2] = (a2 == 4 ? RB : VB) + (size_t)st * 512 + h * 64 + c8 * 8; sstride[2] = 512; dsto[2] = (a2 * 2048 + st * 64 + c8 * 8) * 4;
    }
    const bool ld2 = !(MODE == 2 && hi8 == 1);
    f2v S2[4];
    if (MODE == 2) {
#pragma unroll
        for (int j = 0; j < 4; ++j) S2[j] = (f2v){(8 * kq + 2 * j == row) ? 1.f : 0.f, (8 * kq + 2 * j + 1 == row) ? 1.f : 0.f};
    } else if (MODE == 0 && init != nullptr) {
        const f32x4 i0 = *(const f32x4*)(init + row * 64 + 8 * kq), i1 = *(const f32x4*)(init + row * 64 + 8 * kq + 4);
        S2[0] = LO2(i0); S2[1] = HI2(i0); S2[2] = LO2(i1); S2[3] = HI2(i1);
    } else {
#pragma unroll
        for (int j = 0; j < 4; ++j) S2[j] = (f2v){0.f, 0.f};
    }
    const int fs = tid >> 4, fv = (tid & 15) * 4;
    f32x4 rk4 = {0.f, 0.f, 0.f, 0.f}, gg4 = rk4, gb4 = rk4;
    if (MODE == 0) { rk4 = *(const f32x4*)(GPF(P.in[18]) + l * 512 + h * 64 + fv); gg4 = *(const f32x4*)(GPF(P.in[19]) + l * 512 + h * 64 + fv); gb4 = *(const f32x4*)(GPF(P.in[20]) + l * 512 + h * 64 + fv); }
    v4u regs[3];
#define RW_LOAD(tt) do { regs[0] = *(const v4u*)(src[0] + (size_t)(tt) * sstride[0]); regs[1] = *(const v4u*)(src[1] + (size_t)(tt) * sstride[1]); if (ld2) regs[2] = *(const v4u*)(src[2] + (size_t)(tt) * sstride[2]); } while (0)
#define RW_STORE(bufp) do { \
        { float f[8]; unpack8(regs[0], f); if (hi8 == 0) { _Pragma("unroll") for (int e = 0; e < 8; ++e) f[e] = __expf(-f[e]); } else { _Pragma("unroll") for (int e = 0; e < 8; ++e) f[e] = -f[e]; } \
          float* d = (float*)((bufp) + dsto[0]); *(f32x4*)d = (f32x4){f[0], f[1], f[2], f[3]}; *(f32x4*)(d + 4) = (f32x4){f[4], f[5], f[6], f[7]}; } \
        { float f[8]; unpack8(regs[1], f); float* d = (float*)((bufp) + dsto[1]); *(f32x4*)d = (f32x4){f[0], f[1], f[2], f[3]}; *(f32x4*)(d + 4) = (f32x4){f[4], f[5], f[6], f[7]}; } \
        if (ld2) { float f[8]; unpack8(regs[2], f); float* d = (float*)((bufp) + dsto[2]); *(f32x4*)d = (f32x4){f[0], f[1], f[2], f[3]}; *(f32x4*)(d + 4) = (f32x4){f[4], f[5], f[6], f[7]}; } } while (0)
    __syncthreads();
    RW_LOAD(t0);
    RW_STORE(lds);
    __syncthreads();
    for (int c = 0; c < nchunk; ++c) {
        const int tc = t0 + 32 * c;
        const bool more = (c + 1 < nchunk);
        if (more) RW_LOAD(tc + 32);
        const float* buf = (const float*)(lds + (c & 1) * BUF);
#pragma unroll 2
        for (int s = 0; s < 32; ++s) {
            const float* bs_ = buf + s * 64 + 8 * kq;
            const f32x4 nk0 = *(const f32x4*)(bs_ + 2048), nk1 = *(const f32x4*)(bs_ + 2048 + 4);
            f2v p = S2[0] * LO2(nk0); p = S2[1] * HI2(nk0) + p; p = S2[2] * LO2(nk1) + p; p = S2[3] * HI2(nk1) + p;
            float sa = p.x + p.y;
            const f32x4 dw0 = *(const f32x4*)(bs_), dw1 = *(const f32x4*)(bs_ + 4);
            const f32x4 bb0 = *(const f32x4*)(bs_ + 4096), bb1 = *(const f32x4*)(bs_ + 4096 + 4);
            f2v tq[4];
            if (MODE == 2) { tq[0] = S2[0] * LO2(dw0); tq[1] = S2[1] * HI2(dw0); tq[2] = S2[2] * LO2(dw1); tq[3] = S2[3] * HI2(dw1); }
            else {
                const f32x4 kv0 = *(const f32x4*)(bs_ + 6144), kv1 = *(const f32x4*)(bs_ + 6144 + 4);
                const float vv = buf[10240 + s * 64 + row]; const f2v vv2 = {vv, vv};
                tq[0] = S2[0] * LO2(dw0) + vv2 * LO2(kv0); tq[1] = S2[1] * HI2(dw0) + vv2 * HI2(kv0); tq[2] = S2[2] * LO2(dw1) + vv2 * LO2(kv1); tq[3] = S2[3] * HI2(dw1) + vv2 * HI2(kv1);
            }
            sa = red8(sa);
            const f2v sa2 = {sa, sa};
            S2[0] = sa2 * LO2(bb0) + tq[0]; S2[1] = sa2 * HI2(bb0) + tq[1]; S2[2] = sa2 * LO2(bb1) + tq[2]; S2[3] = sa2 * HI2(bb1) + tq[3];
            if (MODE == 0) {
                const f32x4 rv0 = *(const f32x4*)(bs_ + 8192), rv1 = *(const f32x4*)(bs_ + 8192 + 4);
                f2v py = S2[0] * LO2(rv0); py = S2[1] * HI2(rv0) + py; py = S2[2] * LO2(rv1) + py; py = S2[3] * HI2(rv1) + py;
                float y = py.x + py.y;
                y = red8(y);
                if (kq == 0) ybuf[s * 64 + row] = y;
            }
        }
        if (more) RW_STORE(lds + ((c + 1) & 1) * BUF);
        __syncthreads();
        if (MODE == 0) {
            const f32x4 y4 = *(const f32x4*)(ybuf + fs * 64 + fv);
            const f32x4 r4 = *(const f32x4*)(buf + 8192 + fs * 64 + fv), k4 = *(const f32x4*)(buf + 6144 + fs * 64 + fv), v4 = *(const f32x4*)(buf + 10240 + fs * 64 + fv);
            const v2u gw_ = *(const v2u*)(LORA + (size_t)(tc + fs) * 2048 + 1024 + h * 64 + fv);
            float sm = (y4[0] + y4[1]) + (y4[2] + y4[3]);
            float bsum = (r4[0] * k4[0] * rk4[0] + r4[1] * k4[1] * rk4[1]) + (r4[2] * k4[2] * rk4[2] + r4[3] * k4[3] * rk4[3]);
            sm = red16(sm); bsum = red16(bsum);
            const float mean = sm * (1.f / 64.f);
            const f32x4 d4 = y4 - mean;
            float qv = (d4[0] * d4[0] + d4[1] * d4[1]) + (d4[2] * d4[2] + d4[3] * d4[3]);
            qv = red16(qv);
            const float rstd = rsqrtf(qv * (1.f / 64.f) + 64e-5f);
            const f32x4 o4 = d4 * rstd * gg4 + gb4 + v4 * bsum;
            *(v2u*)(YA + (size_t)(tc + fs) * 512 + h * 64 + fv) = (v2u){pk2(o4[0] * bflo(gw_.x), o4[1] * bfhi(gw_.x)), pk2(o4[2] * bflo(gw_.y), o4[3] * bfhi(gw_.y))};
            __syncthreads();
        }
    }
#undef RW_LOAD
#undef RW_STORE
    if (MODE != 0) { *(f32x4*)(fin + row * 64 + 8 * kq) = (f32x4){S2[0].x, S2[0].y, S2[1].x, S2[1].y}; *(f32x4*)(fin + row * 64 + 8 * kq + 4) = (f32x4){S2[2].x, S2[2].y, S2[3].x, S2[3].y}; }
}
__device__ __forceinline__ void rwkv_scan_pu(const Params& P, unsigned char* lds, int h, int t0, int nchunk, float* finP, float* finU) {
    const int tid = opaque_tid(), lane = tid & 63, wave = tid >> 6, rowgrp = lane >> 3, kq = lane & 7;
    const int row = wave * 8 + rowgrp;
    unsigned char* ws = opaque_ptr(P.ws);
    const bf16_t* LORA = (const bf16_t*)(ws + WS_LORA); const bf16_t* KB = (const bf16_t*)(ws + WS_KB); const bf16_t* VB = (const bf16_t*)(ws + WS_VB);
    constexpr int BUF = 49152;
    const bf16_t* src[3]; int dsto[3], sstride[3];
    const int hi8 = tid >> 8, q = tid & 255, st = q >> 3, c8 = q & 7;
    src[0] = (hi8 == 0 ? LORA : LORA + 512) + (size_t)st * 2048 + h * 64 + c8 * 8; sstride[0] = 2048; dsto[0] = (hi8 * 2048 + st * 64 + c8 * 8) * 4;
    src[1] = (hi8 == 0 ? LORA + 1536 + (size_t)st * 2048 : KB + (size_t)st * 512) + h * 64 + c8 * 8; sstride[1] = (hi8 == 0) ? 2048 : 512; dsto[1] = ((2 + hi8) * 2048 + st * 64 + c8 * 8) * 4;
    src[2] = VB + (size_t)st * 512 + h * 64 + c8 * 8; sstride[2] = 512; dsto[2] = (5 * 2048 + st * 64 + c8 * 8) * 4;
    const bool ld2 = hi8 == 1;
    f2v SP2[4], SU2[4];
#pragma unroll
    for (int j = 0; j < 4; ++j) { SP2[j] = (f2v){(8 * kq + 2 * j == row) ? 1.f : 0.f, (8 * kq + 2 * j + 1 == row) ? 1.f : 0.f}; SU2[j] = (f2v){0.f, 0.f}; }
    v4u regs[3];
#define PU_LOAD(tt) do { regs[0] = *(const v4u*)(src[0] + (size_t)(tt) * sstride[0]); regs[1] = *(const v4u*)(src[1] + (size_t)(tt) * sstride[1]); if (ld2) regs[2] = *(const v4u*)(src[2] + (size_t)(tt) * sstride[2]); } while (0)
#define PU_STORE(bufp) do { \
        { float f[8]; unpack8(regs[0], f); if (hi8 == 0) { _Pragma("unroll") for (int e = 0; e < 8; ++e) f[e] = __expf(-f[e]); } else { _Pragma("unroll") for (int e = 0; e < 8; ++e) f[e] = -f[e]; } \
          float* d = (float*)((bufp) + dsto[0]); *(f32x4*)d = (f32x4){f[0], f[1], f[2], f[3]}; *(f32x4*)(d + 4) = (f32x4){f[4], f[5], f[6], f[7]}; } \
        { float f[8]; unpack8(regs[1], f); float* d = (float*)((bufp) + dsto[1]); *(f32x4*)d = (f32x4){f[0], f[1], f[2], f[3]}; *(f32x4*)(d + 4) = (f32x4){f[4], f[5], f[6], f[7]}; } \
        if (ld2) { float f[8]; unpack8(regs[2], f); float* d = (float*)((bufp) + dsto[2]); *(f32x4*)d = (f32x4){f[0], f[1], f[2], f[3]}; *(f32x4*)(d + 4) = (f32x4){f[4], f[5], f[6], f[7]}; } } while (0)
    __syncthreads();
    PU_LOAD(t0);
    PU_STORE(lds);
    __syncthreads();
    for (int c = 0; c < nchunk; ++c) {
        const int tc = t0 + 32 * c;
        const bool more = (c + 1 < nchunk);
        if (more) PU_LOAD(tc + 32);
        const float* buf = (const float*)(lds + (c & 1) * BUF);
#pragma unroll 2
        for (int s = 0; s < 32; ++s) {
            const float* bs_ = buf + s * 64 + 8 * kq;
            const f32x4 nk0 = *(const f32x4*)(bs_ + 2048), nk1 = *(const f32x4*)(bs_ + 2048 + 4);
            f2v pP = SP2[0] * LO2(nk0); pP = SP2[1] * HI2(nk0) + pP; pP = SP2[2] * LO2(nk1) + pP; pP = SP2[3] * HI2(nk1) + pP;
            f2v pU = SU2[0] * LO2(nk0); pU = SU2[1] * HI2(nk0) + pU; pU = SU2[2] * LO2(nk1) + pU; pU = SU2[3] * HI2(nk1) + pU;
            float saP = pP.x + pP.y, saU = pU.x + pU.y;
            const f32x4 dw0 = *(const f32x4*)(bs_), dw1 = *(const f32x4*)(bs_ + 4);
            const f32x4 bb0 = *(const f32x4*)(bs_ + 4096), bb1 = *(const f32x4*)(bs_ + 4096 + 4);
            const f32x4 kv0 = *(const f32x4*)(bs_ + 6144), kv1 = *(const f32x4*)(bs_ + 6144 + 4);
            const float vv = buf[10240 + s * 64 + row]; const f2v vv2 = {vv, vv};
            f2v tp[4], tu[4];
            tp[0] = SP2[0] * LO2(dw0); tp[1] = SP2[1] * HI2(dw0); tp[2] = SP2[2] * LO2(dw1); tp[3] = SP2[3] * HI2(dw1);
            tu[0] = SU2[0] * LO2(dw0) + vv2 * LO2(kv0); tu[1] = SU2[1] * HI2(dw0) + vv2 * HI2(kv0); tu[2] = SU2[2] * LO2(dw1) + vv2 * LO2(kv1); tu[3] = SU2[3] * HI2(dw1) + vv2 * HI2(kv1);
            saP += dppf<0xB1>(saP); saU += dppf<0xB1>(saU);
            saP += dppf<0x4E>(saP); saU += dppf<0x4E>(saU);
            saP += dppf<0x141>(saP); saU += dppf<0x141>(saU);
            const f2v sP2 = {saP, saP}, sU2 = {saU, saU};
            SP2[0] = sP2 * LO2(bb0) + tp[0]; SP2[1] = sP2 * HI2(bb0) + tp[1]; SP2[2] = sP2 * LO2(bb1) + tp[2]; SP2[3] = sP2 * HI2(bb1) + tp[3];
            SU2[0] = sU2 * LO2(bb0) + tu[0]; SU2[1] = sU2 * HI2(bb0) + tu[1]; SU2[2] = sU2 * LO2(bb1) + tu[2]; SU2[3] = sU2 * HI2(bb1) + tu[3];
        }
        if (more) PU_STORE(lds + ((c + 1) & 1) * BUF);
        __syncthreads();
    }
#undef PU_LOAD
#undef PU_STORE
    if (finP != nullptr) { *(f32x4*)(finP + row * 64 + 8 * kq) = (f32x4){SP2[0].x, SP2[0].y, SP2[1].x, SP2[1].y}; *(f32x4*)(finP + row * 64 + 8 * kq + 4) = (f32x4){SP2[2].x, SP2[2].y, SP2[3].x, SP2[3].y}; }
    *(f32x4*)(finU + row * 64 + 8 * kq) = (f32x4){SU2[0].x, SU2[0].y, SU2[1].x, SU2[1].y}; *(f32x4*)(finU + row * 64 + 8 * kq + 4) = (f32x4){SU2[2].x, SU2[2].y, SU2[3].x, SU2[3].y};
}
__device__ __forceinline__ void rwkv_pass2(const Params& P, unsigned char* lds, int h, int part) {
    const int tid = opaque_tid(), vl = tid >> 5, v = part * 16 + vl, kq = tid & 31;
    const float* PU = (const float*)(opaque_ptr(P.ws) + WS_PU) + (size_t)h * RW_NC * 8192;
    float* SI = (float*)(opaque_ptr(P.ws) + WS_SINIT) + (size_t)h * RW_NC * 4096;
    typedef float f32x2 __attribute__((ext_vector_type(2)));
    float* Ss = (float*)lds;
    float* Pl = (float*)(lds + 4352);
    const int pr = tid >> 3, pc = (tid & 7) * 8;
    __syncthreads();
    f32x2 a = *(const f32x2*)(PU + 4096 + v * 64 + 2 * kq);
    f32x4 p0, p1; f32x2 u;
    { const float* pcur = PU + (size_t)8192; p0 = *(const f32x4*)(pcur + pr * 64 + pc); p1 = *(const f32x4*)(pcur + pr * 64 + pc + 4); u = *(const f32x2*)(pcur + 4096 + v * 64 + 2 * kq); }
    for (int c = 1; c < RW_NC; ++c) {
        *(f32x2*)(SI + (size_t)c * 4096 + v * 64 + 2 * kq) = a;
        if (c + 1 == RW_NC) break;
        Ss[vl * 65 + 2 * kq] = a[0]; Ss[vl * 65 + 2 * kq + 1] = a[1];
        *(f32x4*)(Pl + pr * 64 + pc) = p0; *(f32x4*)(Pl + pr * 64 + pc + 4) = p1;
        a = u;
        if (c + 2 < RW_NC) { const float* pn = PU + (size_t)(c + 1) * 8192; p0 = *(const f32x4*)(pn + pr * 64 + pc); p1 = *(const f32x4*)(pn + pr * 64 + pc + 4); u = *(const f32x2*)(pn + 4096 + v * 64 + 2 * kq); }
        __syncthreads();
#pragma unroll 16
        for (int i = 0; i < 64; ++i) { const float s = Ss[vl * 65 + i]; const f32x2 q = *(const f32x2*)(Pl + i * 64 + 2 * kq); a += q * s; }
        __syncthreads();
    }
}
__device__ __forceinline__ int crow(int r, int hi) { return (r & 3) + 8 * (r >> 2) + 4 * hi; }
__device__ __forceinline__ void attn_qk(const unsigned char* Kb, const bf16x8 (&qr)[6], const f32x16& negm, f32x16& s0, f32x16& s1, int r32, int hi) {
    constexpr int KROW = 208;
#pragma unroll
    for (int d0 = 0; d0 < 6; ++d0) {
        const bf16x8 a0 = *(const bf16x8*)(Kb + r32 * KROW + d0 * 32 + hi * 16);
        const bf16x8 a1 = *(const bf16x8*)(Kb + (32 + r32) * KROW + d0 * 32 + hi * 16);
        s0 = __builtin_amdgcn_mfma_f32_32x32x16_bf16(a0, qr[d0], d0 == 0 ? negm : s0, 0, 0, 0);
        s1 = __builtin_amdgcn_mfma_f32_32x32x16_bf16(a1, qr[d0], d0 == 0 ? negm : s1, 0, 0, 0);
    }
}
__device__ __forceinline__ void attn_mask(f32x16& s0, f32x16& s1, int k0, int qg, int hi) {
#pragma unroll
    for (int r = 0; r < 16; ++r) { const int key = k0 + crow(r, hi); if (key > qg) s0[r] = -1e30f; if (key + 32 > qg) s1[r] = -1e30f; }
}
#define MX3(a, b, c) __builtin_fmaxf(__builtin_fmaxf((a), (b)), (c))
#define SBAR() __builtin_amdgcn_sched_barrier(0)
#define PINF(x) asm volatile("" : "+v"(x))
#define ATT_GAP(A_, B_) do { _Pragma("unroll") for (int e = (A_); e < (B_); ++e) { float x_ = (e < 16) ? c0[e & 15] : c1[e & 15]; PINF(x_); x_ = __builtin_amdgcn_exp2f(x_); PINF(x_); if (e < 16) { c0[e & 15] = x_; ps0 += x_; } else { c1[e & 15] = x_; ps1 += x_; } } \
    _Pragma("unroll") for (int p = (A_) / 2; p < (B_) / 2; ++p) { const float lo_ = (2 * p < 16) ? c0[(2 * p) & 15] : c1[(2 * p) & 15], hi_ = (2 * p + 1 < 16) ? c0[(2 * p + 1) & 15] : c1[(2 * p + 1) & 15]; unsigned w_ = pk2(lo_, hi_); PINF(w_); pw[p >> 2][p & 3] = w_; } } while (0)
__device__ __forceinline__ void attn_unit(const Params& P, unsigned char* lds, int h, int qb) {
    const int tid = opaque_tid(), lane = tid & 63, wave = __builtin_amdgcn_readfirstlane(tid >> 6), r32 = lane & 31, hi = lane >> 5;
    unsigned char* ws = opaque_ptr(P.ws);
    const bf16_t* Q = (const bf16_t*)(ws + WS_Q); const bf16_t* KN = (const bf16_t*)(ws + WS_KNOPE); const bf16_t* KR = (const bf16_t*)(ws + WS_KROPE);
    const bf16_t* VT = (const bf16_t*)(ws + WS_VT); bf16_t* YB = (bf16_t*)(ws + WS_YB);
    constexpr int KROW = 208, VROW = 136, KBUF = 64 * KROW, VBUF = 64 * VROW;
    constexpr float THR = 8.0f;
    const int q0 = qb * 256, qw0 = q0 + wave * 32, NT = (q0 + 256) >> 6, qg = qw0 + r32;
    const int ntw = (qw0 + 31) / 64 + 1;
    const int kkey = tid >> 3, kch = tid & 7, rkey = (tid & 255) >> 2, rch = tid & 3;
    const bf16_t* kn_src = KN + (size_t)kkey * 512 + h * 64 + kch * 8;
    const bf16_t* kr_src = KR + (size_t)rkey * 32 + rch * 8;
    const bf16_t* vt_src = VT + (size_t)(h * 64 + kkey) * T + kch * 8;
    const int kn_dst = kkey * KROW + kch * 16, kr_dst = rkey * KROW + 128 + rch * 16, vt_dst = 2 * KBUF + kkey * VROW + kch * 16;
    const bool has_kr = tid < 256;
    bf16x8 qr[6];
#pragma unroll
    for (int d0 = 0; d0 < 6; ++d0) qr[d0] = *(const bf16x8*)(Q + (size_t)(qw0 + r32) * 768 + h * 96 + d0 * 16 + hi * 8);
    f32x16 o0, o1, negm;
#pragma unroll
    for (int r = 0; r < 16; ++r) { o0[r] = 0.f; o1[r] = 0.f; negm[r] = 0.f; }
    float m = 0.f, lsum = 0.f;
    v4u rkn, rkr = (v4u){0u, 0u, 0u, 0u}, rvt;
#define AT_LOADK(tile) do { const int kk0_ = (tile) * 64; rkn = *(const v4u*)(kn_src + (size_t)kk0_ * 512); if (has_kr) rkr = *(const v4u*)(kr_src + (size_t)kk0_ * 32); } while (0)
#define AT_LOADV(tile) do { rvt = *(const v4u*)(vt_src + (tile) * 64); } while (0)
#define AT_STOREK(b) do { unsigned char* nb_ = lds + (b) * KBUF; *(v4u*)(nb_ + kn_dst) = rkn; if (has_kr) *(v4u*)(nb_ + kr_dst) = rkr; } while (0)
#define AT_STOREV(b) do { unsigned char* nv_ = lds + (b) * VBUF; *(v2u*)(nv_ + vt_dst) = (v2u){rvt.x, rvt.y}; *(v2u*)(nv_ + vt_dst + 8) = (v2u){rvt.z, rvt.w}; } while (0)
    __syncthreads();
    AT_LOADK(0); AT_LOADV(0); AT_STOREK(0); AT_STOREV(0);
    AT_LOADK(1); AT_STOREK(1);
    AT_LOADK(2); AT_LOADV(1);
    __syncthreads();
    f32x16 c0, c1, n0, n1;
    attn_qk(lds, qr, negm, c0, c1, r32, hi);
    if (63 > qw0) attn_mask(c0, c1, 0, qg, hi);
    __syncthreads();
    for (int t = 0; t < NT; ++t) {
        const bool act = t < ntw, actn = (t + 1) < ntw;
        if (act) {
            float mx = MX3(c0[0], c0[1], c1[0]);
            mx = MX3(mx, c1[1], c0[2]);
#pragma unroll
            for (int r = 2; r < 16; r += 2) { mx = MX3(mx, c0[r], c0[r + 1]); mx = MX3(mx, c1[r], c1[r + 1]); }
            mx = fmaxf(mx, __shfl_xor(mx, 32));
            if (t == 0 || __any(mx > THR)) {
                const float dl = (t == 0) ? mx : fmaxf(mx, 0.f), f = __builtin_amdgcn_exp2f(-dl);
                m += dl; lsum *= f;
#pragma unroll
                for (int r = 0; r < 16; ++r) { c0[r] -= dl; c1[r] -= dl; o0[r] *= f; o1[r] *= f; negm[r] = -m; }
            }
        }
        float ps0 = 0.f, ps1 = 0.f;
        v4u pw[4];
        if (act && actn) {
            const unsigned char* Kn = lds + ((t + 1) & 1) * KBUF + r32 * KROW + hi * 16;
            SBAR();
#pragma unroll
            for (int g = 0; g < 6; ++g) {
                const bf16x8 ka = *(const bf16x8*)(Kn + g * 32), kb = *(const bf16x8*)(Kn + 32 * KROW + g * 32);
                n0 = __builtin_amdgcn_mfma_f32_32x32x16_bf16(ka, qr[g], g == 0 ? negm : n0, 0, 0, 0);
                SBAR();
                ATT_GAP((32 * (2 * g)) / 12, (32 * (2 * g + 1)) / 12);
                SBAR();
                n1 = __builtin_amdgcn_mfma_f32_32x32x16_bf16(kb, qr[g], g == 0 ? negm : n1, 0, 0, 0);
                SBAR();
                ATT_GAP((32 * (2 * g + 1)) / 12, (32 * (2 * g + 2)) / 12);
                SBAR();
            }
            if ((t + 1) * 64 + 63 > qw0) attn_mask(n0, n1, (t + 1) * 64, qg, hi);
        } else if (act) {
            ATT_GAP(0, 32);
        }
        if (act) {
            lsum += ps0 + ps1;
            const unsigned char* Vb = lds + 2 * KBUF + (t & 1) * VBUF;
#pragma unroll
            for (int ks = 0; ks < 4; ++ks) {
                const bf16x8 pa = __builtin_bit_cast(bf16x8, pw[ks]);
                const unsigned char* va = Vb + r32 * VROW + (16 * ks + 4 * hi) * 2;
                const v2u l0 = *(const v2u*)va, h0 = *(const v2u*)(va + 16);
                const v2u l1 = *(const v2u*)(va + 32 * VROW), h1 = *(const v2u*)(va + 32 * VROW + 16);
                const bf16x8 vf0 = __builtin_bit_cast(bf16x8, ((v4u){l0.x, l0.y, h0.x, h0.y}));
                const bf16x8 vf1 = __builtin_bit_cast(bf16x8, ((v4u){l1.x, l1.y, h1.x, h1.y}));
                o0 = __builtin_amdgcn_mfma_f32_32x32x16_bf16(vf0, pa, o0, 0, 0, 0);
                o1 = __builtin_amdgcn_mfma_f32_32x32x16_bf16(vf1, pa, o1, 0, 0, 0);
            }
        }
        if (t + 2 < NT) AT_STOREK(t & 1);
        if (t + 1 < NT) AT_STOREV((t + 1) & 1);
        if (t + 3 < NT) AT_LOADK(t + 3);
        if (t + 2 < NT) AT_LOADV(t + 2);
        __syncthreads();
        c0 = n0; c1 = n1;
    }
#undef AT_LOADK
#undef AT_LOADV
#undef AT_STOREK
#undef AT_STOREV
    lsum += __shfl_xor(lsum, 32);
    const float inv = 1.f / lsum;
    bf16_t* yrow = YB + (size_t)(qw0 + r32) * 512 + h * 64;
#pragma unroll
    for (int g = 0; g < 4; ++g) {
        const int dv = 8 * g + 4 * hi;
        *(v2u*)(yrow + dv) = (v2u){pk2(o0[4 * g] * inv, o0[4 * g + 1] * inv), pk2(o0[4 * g + 2] * inv, o0[4 * g + 3] * inv)};
        *(v2u*)(yrow + 32 + dv) = (v2u){pk2(o1[4 * g] * inv, o1[4 * g + 1] * inv), pk2(o1[4 * g + 2] * inv, o1[4 * g + 3] * inv)};
    }
}

constexpr int RW_I1 = (RW_NC - 1) * 8;
constexpr int Q_CONV0 = RW_I1 + 512 + 1024, Q_P20 = Q_CONV0 + 66, Q_END = Q_P20 + 32, Q_SPLIT = 300;
#define GEMM_CALL1(EPI, Ap, Bp, M_, N_, K_, E) { pg8::Gemm g_{(const pg8::bf16_t*)(Ap), (const pg8::bf16_t*)(Bp), (M_), (N_), (K_)}; pg8::StaticOrder S_; S_.init((M_), (N_), G, bid); \
    pg8::gemm_phase<EPI, pg8::StaticOrder, true, true>((PG8_LAS unsigned char*)lds, g_, S_, (E)); }
#ifndef PROBE_M
#define PROBE_M 0
#endif
#ifndef PROBE_S
#define PROBE_S 0
#endif
#define GSYNC() do { XcdBarrier xb_; xb_.bar = (unsigned*)(opaque_ptr(P.ws) + WS_CTL) + 4096; xb_.x = xb_xcc_id(); xb_.st = (volatile LAS unsigned*)((LAS unsigned char*)lds + LDS_BYTES - 64); xcd_barrier(xb_); for (int s_ = 0; s_ < PROBE_S; ++s_) xcd_barrier(xb_); } while (0)
#ifndef PROBE_G
#define PROBE_G 0
#endif
#define GEMM_CALL(EPI, Ap, Bp, M_, N_, K_, E) for (int rep_ = 0; rep_ < 1 + PROBE_G; ++rep_) { pg8::Gemm g_{(const pg8::bf16_t*)(Ap), (const pg8::bf16_t*)(Bp), (M_), (N_), (K_)}; pg8::StaticOrder S_; S_.init((M_), (N_), G, bid); \
    pg8::gemm_phase<EPI, pg8::StaticOrder, true, true>((PG8_LAS unsigned char*)lds, g_, S_, (E)); }

#define WSB (opaque_ptr(P.ws))
#define HRES ((float*)(GAS1 float*)(P.out))
#define XNB ((bf16_t*)(WSB + WS_XN))
#define YB32 ((bf16_t*)(WSB + WS_Y))
#define ACTB ((bf16_t*)(WSB + WS_ACT))
#define CTLW ((unsigned*)(WSB + WS_CTL))
__global__ void __launch_bounds__(512, 2) fwd_kernel(Params P) {
    extern __shared__ __attribute__((aligned(16))) unsigned char lds[];
    cg::grid_group grid = cg::this_grid();
    const int bid = blockIdx.x, G = gridDim.x;
    volatile LAS unsigned* xst = (volatile LAS unsigned*)((LAS unsigned char*)lds + LDS_BYTES - 64);
    if (threadIdx.x < 4) xst[threadIdx.x] = 0u;
    __syncthreads();
    (void)xcd_barrier_post((unsigned*)(opaque_ptr(P.ws) + WS_CTL) + 4096, xst);
    int* qslot = (int*)(lds + LDS_BYTES - 16);

    phase_tables(P);
    if (PROBE_M & 4) conv_ffn(GPF(P.in[4]), GPF(P.in[5]), GPF(P.in[6]), WSB, lds, 0);
    conv_ffn(GPF(P.in[4]), GPF(P.in[5]), GPF(P.in[6]), WSB, lds, 0);
    phase_rowwise(nullptr, GPF(P.in[0]), HRES, 0.f, nullptr, GPF(P.in[2]), XNB);
    grid.sync();
    GSYNC();

#pragma unroll 1
    for (int l = 0; l < NL; ++l) {
#pragma unroll 1
        for (int f = 0; f < 2; ++f) {

#ifndef SKIP_G1
            { pg8::EpiSwiGLU E{ACTB, DFF}; GEMM_CALL(pg8::EpiSwiGLU, XNB, WSB + WA_GU, T, 2 * DFF, DM, E); }
#endif

            GSYNC();

#ifndef SKIP_G2
            { pg8::EpiBf16Split E{(pg8::bf16_t*)YB32, DM, 1 << 30, nullptr, 0}; GEMM_CALL(pg8::EpiBf16Split, ACTB, WSB + WA_D, T, DM, DFF, E); }
#endif

            GSYNC();
            if (f == 1) {
                const float* gpost = GPF(P.in[36]) + (size_t)l * DM;
                const float* gpre = (l + 1 < NL) ? GPF(P.in[2]) + (size_t)(l + 1) * DM : nullptr;
                if (PROBE_M & 8) phase_rowwise(YB32, HRES, (float*)ACTB, 0.5f, gpost, gpre, XNB);
                phase_rowwise(YB32, HRES, HRES, 0.5f, gpost, gpre, XNB);
                if ((PROBE_M & 4) && l + 1 < NL) conv_ffn(GPF(P.in[4]) + (size_t)(l + 1) * DM * DFF, GPF(P.in[5]) + (size_t)(l + 1) * DM * DFF, GPF(P.in[6]) + (size_t)(l + 1) * DM * DFF, WSB, lds, 0);
                if (l + 1 < NL) conv_ffn(GPF(P.in[4]) + (size_t)(l + 1) * DM * DFF, GPF(P.in[5]) + (size_t)(l + 1) * DM * DFF, GPF(P.in[6]) + (size_t)(l + 1) * DM * DFF, WSB, lds, 0);
                GSYNC();
                continue;
            }
            if (PROBE_M & 8) phase_rowwise(YB32, HRES, (float*)ACTB, 0.5f, GPF(P.in[3]) + (size_t)l * DM, GPF(P.in[7]) + (size_t)l * DM, XNB);
            phase_rowwise(YB32, HRES, HRES, 0.5f, GPF(P.in[3]) + (size_t)l * DM, GPF(P.in[7]) + (size_t)l * DM, XNB);

#ifndef SKIP_CM
            if (PROBE_M & 4) conv_mixer(P, l, lds);
            conv_mixer(P, l, lds);
#endif

            GSYNC();

#ifndef SKIP_G3
            { pg8::EpiBf16Split E{(pg8::bf16_t*)(WSB + WS_P1), NP1, NP1 / 256, (pg8::bf16_t*)(WSB + WS_P2), NP2}; GEMM_CALL(pg8::EpiBf16Split, XNB, WSB + WB_IN, T, NP1 + NP2, DM, E); }
#endif

            GSYNC();

#ifndef SKIP_PREP
            for (int rep2 = 0; rep2 < 1 + ((PROBE_M & 2) ? 1 : 0); ++rep2) {
            phase_prep(P, l);
#endif


#ifndef SKIP_HA
            for (int u = bid; u < 1024; u += G) hgrn_a_unit(P, l, u, lds);
            }
#endif

            GSYNC();

#ifndef SKIP_HB
            hgrn_b(P, lds);
#endif

            __syncthreads();
#pragma unroll 1
            for (int gi = 0; gi < 4; ++gi) {
                const unsigned char* Ap; const unsigned char* Bp; unsigned char* Op; int M_, N_, K_, ld;
                if (gi == 0) { Ap = WSB + WS_LIN; Bp = WSB + WB_LORA; Op = WSB + WS_LORA; M_ = T; N_ = 2048; K_ = 384; ld = 2048; }
                else if (gi == 1) { Ap = WSB + WS_CQN; Bp = WSB + WB_UQ; Op = WSB + WS_Q; M_ = T; N_ = 768; K_ = 384; ld = 768; }
                else if (gi == 2) { Ap = WSB + WS_CKVN; Bp = WSB + WB_UK; Op = WSB + WS_KNOPE; M_ = T; N_ = 512; K_ = 256; ld = 512; }
                else { Ap = WSB + WB_UV; Bp = WSB + WS_CKVN; Op = WSB + WS_VT; M_ = 512; N_ = T; K_ = 256; ld = T; }
                pg8::EpiBf16Split E{(pg8::bf16_t*)Op, ld, 1 << 30, nullptr, 0};

#ifndef SKIP_G4
                GEMM_CALL(pg8::EpiBf16Split, Ap, Bp, M_, N_, K_, E);
#endif

            }
            GSYNC();

#ifndef SKIP_PREP2
            phase_prep2(P, l);
#endif

            GSYNC();

#ifndef PROBE_Q
#define PROBE_Q 0
#endif
            const int xq_ = (int)(xb_xcc_id() & 7u);
#pragma unroll 1
            for (int jq = 0; jq < 8; ++jq) {
            const int q_ = (xq_ + jq) & 7; const int rep = 0;
            for (;;) {
                __syncthreads();
                if (threadIdx.x == 0) *qslot = (int)atomicAdd(CTLW + 64 * l + q_, 1u);
                __syncthreads();
                const int li = *qslot;
                if (li >= 236) break;
                int item;
                if (li < 31) item = li * 8 + q_;
                else if (li < 69) item = RW_I1 + (li - 31) * 8 + q_;
                else if (li < 73) item = Q_P20 + q_ * 4 + (li - 69);
                else if (li < 82) { const int ci = q_ * 9 + (li - 73); if (ci >= 66) continue; item = Q_CONV0 + ci; }
                else if (li < 108) item = RW_I1 + (38 + li - 82) * 8 + q_;
                else item = RW_I1 + 512 + (li - 108) * 8 + q_;
                if (item < RW_I1) {
                    if (rep && !(PROBE_Q & 1)) continue;
                    const int hh = item & 7, cc = item >> 3;
                    float* fin = (float*)(WSB + WS_PU) + (size_t)(hh * RW_NC + cc) * 8192;
                    rwkv_scan_pu(P, lds, hh, cc * RW_LC, RW_LC / 32, cc > 0 ? fin : nullptr, fin + 4096);
                    if (!rep) {
                        asm volatile("s_waitcnt vmcnt(0)" ::: "memory");
                        __syncthreads();
                        if (threadIdx.x == 0) { __builtin_amdgcn_fence(__ATOMIC_RELEASE, "agent"); asm volatile("s_waitcnt vmcnt(0)" ::: "memory");
                            __hip_atomic_fetch_add(CTLW + 64 * l + 32 + hh, 1u, __ATOMIC_RELAXED, __HIP_MEMORY_SCOPE_AGENT); }
                    }
                    continue;
                }
                if (item >= Q_CONV0) {
                    if (item < Q_P20) { conv_ffn_item(GPF(P.in[37]) + (size_t)l * DM * DFF, GPF(P.in[38]) + (size_t)l * DM * DFF, GPF(P.in[39]) + (size_t)l * DM * DFF, WSB, lds, item - Q_CONV0); continue; }
                    const int hh = (item - Q_P20) >> 2, part = (item - Q_P20) & 3;
                    if (threadIdx.x == 0) { unsigned spins = 0; while (__hip_atomic_load(CTLW + 64 * l + 32 + hh, __ATOMIC_RELAXED, __HIP_MEMORY_SCOPE_AGENT) < (unsigned)(RW_NC - 1) && ++spins < 4000000u) __builtin_amdgcn_s_sleep(2); }
                    __syncthreads();
                    __builtin_amdgcn_fence(__ATOMIC_ACQUIRE, "agent"); asm volatile("s_waitcnt vmcnt(0)" ::: "memory");
                    __syncthreads();
                    rwkv_pass2(P, lds, hh, part);
                    continue;
                }
                item -= RW_I1;
                if (item < 512) { if (rep && !(PROBE_Q & 2)) continue; attn_unit(P, lds, item & 7, 63 - (item >> 3)); }
                else { if (rep && !(PROBE_Q & 4)) continue; hgrn_c_unit(P, l, item - 512, lds); }
            }
            }
            GSYNC();
            for (int rep3 = 0; rep3 < 1 + ((PROBE_M & 1) ? 1 : 0); ++rep3)
            for (int it = bid; it < 8 * RW_NC; it += G) { const int hh = it & 7, cc = it >> 3;
                rwkv_scan_item<0>(P, l, lds, hh, cc * RW_LC, RW_LC / 32, cc ? (const float*)(WSB + WS_SINIT) + (size_t)(hh * RW_NC + cc) * 4096 : nullptr, nullptr); }
            GSYNC();
#pragma unroll 1
            for (int br = 0; br < 3; ++br) {
                const unsigned char* Ap = br == 0 ? WSB + WS_YA : (br == 1 ? WSB + WS_YB : WSB + WS_YC);
                pg8::EpiGate E{(const pg8::bf16_t*)(WSB + WS_P2) + C2_GATE + br * 1024, NP2, (pg8::bf16_t*)(WSB + WS_MERGED), DM, br == 0 ? 1 : 0};

#ifndef SKIP_G5
                GEMM_CALL1(pg8::EpiGate, Ap, WSB + WB_OUT + (size_t)br * 1024 * 512 * 2, T, DM, 512, E);
#endif

            }
            GSYNC();

#ifndef SKIP_G6
            { pg8::EpiBf16Split E{(pg8::bf16_t*)YB32, DM, 1 << 30, nullptr, 0}; GEMM_CALL(pg8::EpiBf16Split, WSB + WS_MERGED, WSB + WB_O, T, DM, DM, E); }
#endif

            GSYNC();
            if (PROBE_M & 8) phase_rowwise(YB32, HRES, (float*)ACTB, 1.0f, GPF(P.in[8]) + (size_t)l * DM, GPF(P.in[35]) + (size_t)l * DM, XNB);
            phase_rowwise(YB32, HRES, HRES, 1.0f, GPF(P.in[8]) + (size_t)l * DM, GPF(P.in[35]) + (size_t)l * DM, XNB);
            GSYNC();
        }
    }
}

extern "C" void kernel_launch(void* const* d_in, const int* in_sizes, int n_in, void* d_out, int out_size, void* d_ws, size_t ws_size, hipStream_t stream) {
    static int grid = 0;
    if (grid == 0) {
        if (n_in != 40 || out_size != T * DM || ws_size < WS_END) { fprintf(stderr, "kernel_launch: unexpected problem (n_in %d out %d ws %zu)\n", n_in, out_size, ws_size); grid = -1; return; }
        int dev = 0, cus = 0, per_cu = 0;
        hipGetDevice(&dev);
        hipDeviceGetAttribute(&cus, hipDeviceAttributeMultiprocessorCount, dev);
        hipFuncSetAttribute((const void*)fwd_kernel, hipFuncAttributeMaxDynamicSharedMemorySize, LDS_BYTES);
        hipOccupancyMaxActiveBlocksPerMultiprocessor(&per_cu, (const void*)fwd_kernel, 512, LDS_BYTES);
        (void)hipGetLastError();
        if (per_cu < 1) per_cu = 1;
        grid = cus;
        if (grid < 64) { grid = -1; return; }
    }
    if (grid < 0) return;
    hipMemsetAsync((char*)d_ws + WS_CTL, 0, 65536, stream);
    Params p{};
    for (int i = 0; i < 40; ++i) p.in[i] = d_in[i];
    p.out = (float*)d_out; p.ws = (unsigned char*)d_ws;
    void* args[] = {&p};
    hipError_t e = hipLaunchCooperativeKernel((const void*)fwd_kernel, dim3(grid), dim3(512), args, LDS_BYTES, stream);
    if (e != hipSuccess) fprintf(stderr, "cooperative launch failed: %s (grid %d)\n", hipGetErrorString(e), grid);
}
```

```cpp
#include <hip/hip_runtime.h>
#include <hip/hip_cooperative_groups.h>
#include <cstdio>
#include <cstdint>
namespace cg = cooperative_groups;
__device__ __forceinline__ int opaque_tid() { int t = threadIdx.x; asm volatile("" : "+v"(t)); return t; }
__device__ __forceinline__ unsigned char* opaque_ptr(unsigned char* p) {
    const unsigned long long v = (unsigned long long)p;
    unsigned lo = __builtin_amdgcn_readfirstlane((unsigned)v), hi = __builtin_amdgcn_readfirstlane((unsigned)(v >> 32));
    asm volatile("" : "+s"(lo), "+s"(hi));
    return (unsigned char*)(__attribute__((address_space(1))) unsigned char*)(((unsigned long long)hi << 32) | lo);
}
#define GAS1 __attribute__((address_space(1)))
#define GPF(p) ((const float*)(const GAS1 float*)(p))
#define GPI(p) ((const int*)(const GAS1 int*)(p))
#define PHASE_IDS const int tid = opaque_tid(), lane = tid & 63, wave = __builtin_amdgcn_readfirstlane(tid >> 6), bid = blockIdx.x, G = gridDim.x, gw = bid * 8 + wave, ngw = G * 8, gtid = bid * 512 + tid, gthreads = G * 512; (void)lane; (void)gw; (void)ngw; (void)gtid; (void)gthreads;
namespace pg8 {
#define PG8_LAS __attribute__((address_space(3)))
typedef unsigned short bf16_t;
typedef short bf16x8 __attribute__((ext_vector_type(8)));
typedef float f32x4 __attribute__((ext_vector_type(4)));
typedef unsigned u32x4 __attribute__((ext_vector_type(4)));
constexpr int BM = 256, BK = 64, HALF = 128, HTB = HALF * BK * 2  , STAGE_BYTES = 8 * HTB, NXCD = 8, WGM = 8;

__host__ __device__ __forceinline__ int lds_byte(int r, int c) { const int st = (r >> 4) * 2 + (c >> 5), rr = r & 15, cc = c & 31, ob = rr * 64 + cc * 2; return st * 1024 + (ob ^ (((ob >> 9) & 1) << 5)); }
__host__ __device__ __forceinline__ void stage_rc(int b, int& R, int& C) { const int st = b / 1024, sb = b % 1024, swz = sb ^ (((sb >> 9) & 1) << 5); R = (st >> 1) * 16 + swz / 64; C = (st & 1) * 32 + (swz % 64) / 2; }
__host__ __device__ __forceinline__ int perm32(int rho) { const int n = rho >> 4, i = rho & 15; return 8 * (i >> 2) + 4 * n + (i & 3); }

struct Unit { int pm, pn; };
struct Gemm { const bf16_t* A; const bf16_t* Bt; int M, N, K; };

struct StaticOrder {
    int nM, nN, nwg, G, c;
    __host__ __device__ void init(int M, int N, int G_, int c_) { nM = M / BM; nN = N / BM; nwg = nM * nN; G = G_; c = c_; }
    __host__ __device__ bool next(int i, Unit& u) const {
        const long L = (long)i * G + c; if (L >= nwg) return false;
        int wgid = (int)L; { const int q = nwg / NXCD, r = nwg % NXCD, xcd = wgid % NXCD, off = wgid / NXCD; wgid = (xcd < r ? xcd * (q + 1) : r * (q + 1) + (xcd - r) * q) + off; }
        const int nig = WGM * nN, gid = wgid / nig, fm = gid * WGM, gsz = (nM - fm) < WGM ? (nM - fm) : WGM;
        u.pm = fm + ((wgid % nig) % gsz); u.pn = (wgid % nig) / gsz; return true;
    }
    __device__ __forceinline__ void a_ready(const Unit&) const {}
    __device__ __forceinline__ void done(const Unit&) const {}
};

typedef float f32x2e __attribute__((ext_vector_type(2))); typedef __bf16 bf16x2e __attribute__((ext_vector_type(2)));
__device__ __forceinline__ unsigned cvt_pk_bf16(float lo, float hi) { f32x2e v = {lo, hi}; bf16x2e b = __builtin_convertvector(v, bf16x2e); return __builtin_bit_cast(unsigned, b); }
__device__ __forceinline__ float bflo(unsigned w) { return __uint_as_float(w << 16); }
__device__ __forceinline__ float bfhi(unsigned w) { return __uint_as_float(w & 0xffff0000u); }
__device__ __forceinline__ float sigm(float x) { return 1.0f / (1.0f + __expf(-x)); }

struct EpiBf16Split {
    static constexpr bool PERM = true, AFTER_DRAIN = false;
    bf16_t* O0; int ld0; int split_pn; bf16_t* O1; int ld1;
    __device__ __forceinline__ void operator()(const f32x4 (&acc)[2][2][4][2], const Unit& u, int wr, int wc, int fr, int fq) const {
        int pn = u.pn; bf16_t* base = O0; int ld = ld0;
        if (pn >= split_pn) { pn -= split_pn; base = O1; ld = ld1; }
        const int row0 = u.pm * BM + wr * 64 + fr, col0 = pn * BM + wc * 32 + 8 * fq;
#pragma unroll
        for (int ai = 0; ai < 2; ++ai)
#pragma unroll
            for (int m = 0; m < 4; ++m) { bf16_t* rowp = base + (size_t)(row0 + ai * HALF + m * 16) * ld + col0;
#pragma unroll
                for (int bj = 0; bj < 2; ++bj) { const f32x4 v0 = acc[ai][bj][m][0], v1 = acc[ai][bj][m][1];
                    u32x4 w; w.x = cvt_pk_bf16(v0[0], v0[1]); w.y = cvt_pk_bf16(v0[2], v0[3]); w.z = cvt_pk_bf16(v1[0], v1[1]); w.w = cvt_pk_bf16(v1[2], v1[3]);
                    *(u32x4*)(rowp + bj * HALF) = w; } }
    }
};
struct EpiF32 {
    static constexpr bool PERM = false, AFTER_DRAIN = false;
    float* O; int ldc;
    __device__ __forceinline__ void operator()(const f32x4 (&acc)[2][2][4][2], const Unit& u, int wr, int wc, int fr, int fq) const {
        const int row0 = u.pm * BM + wr * 64 + fr, col0 = u.pn * BM + wc * 32 + 4 * fq;
#pragma unroll
        for (int ai = 0; ai < 2; ++ai)
#pragma unroll
            for (int m = 0; m < 4; ++m) { float* rowp = O + (size_t)(row0 + ai * HALF + m * 16) * ldc + col0;
#pragma unroll
                for (int bj = 0; bj < 2; ++bj)
#pragma unroll
                    for (int n = 0; n < 2; ++n) *(f32x4*)(rowp + bj * HALF + n * 16) = acc[ai][bj][m][n]; }
    }
};
struct EpiSwiGLU {
    static constexpr bool PERM = false, AFTER_DRAIN = false;
    bf16_t* O; int ldo;
    __device__ __forceinline__ void operator()(const f32x4 (&acc)[2][2][4][2], const Unit& u, int wr, int wc, int fr, int fq) const {
        const int row0 = u.pm * BM + wr * 64 + fr, j0 = u.pn * 128 + wc * 16 + 4 * fq;
#pragma unroll
        for (int ai = 0; ai < 2; ++ai)
#pragma unroll
            for (int m = 0; m < 4; ++m) { bf16_t* rowp = O + (size_t)(row0 + ai * HALF + m * 16) * ldo + j0;
#pragma unroll
                for (int bj = 0; bj < 2; ++bj) { const f32x4 g = acc[ai][bj][m][0], up = acc[ai][bj][m][1];
                    float a[4];
#pragma unroll
                    for (int i = 0; i < 4; ++i) a[i] = g[i] * sigm(g[i]) * up[i];
                    unsigned long long w = (unsigned long long)cvt_pk_bf16(a[0], a[1]) | ((unsigned long long)cvt_pk_bf16(a[2], a[3]) << 32);
                    *(unsigned long long*)(rowp + bj * 64) = w; } }
    }
};
struct EpiGate {
    static constexpr bool PERM = true, AFTER_DRAIN = false;
    const bf16_t* G; int ldg; bf16_t* O; int ldo; int first;
    __device__ __forceinline__ void operator()(const f32x4 (&acc)[2][2][4][2], const Unit& u, int wr, int wc, int fr, int fq) const {
        const int row0 = u.pm * BM + wr * 64 + fr, col0 = u.pn * BM + wc * 32 + 8 * fq;
#pragma unroll
        for (int ai = 0; ai < 2; ++ai)
#pragma unroll
            for (int m = 0; m < 4; ++m) { const size_t row = (size_t)(row0 + ai * HALF + m * 16);
#pragma unroll
                for (int bj = 0; bj < 2; ++bj) { const f32x4 v0 = acc[ai][bj][m][0], v1 = acc[ai][bj][m][1];
                    const u32x4 gw = *(const u32x4*)(G + row * ldg + col0 + bj * HALF);
                    float r[8];
                    r[0] = sigm(bflo(gw.x)) * v0[0]; r[1] = sigm(bfhi(gw.x)) * v0[1]; r[2] = sigm(bflo(gw.y)) * v0[2]; r[3] = sigm(bfhi(gw.y)) * v0[3];
                    r[4] = sigm(bflo(gw.z)) * v1[0]; r[5] = sigm(bfhi(gw.z)) * v1[1]; r[6] = sigm(bflo(gw.w)) * v1[2]; r[7] = sigm(bfhi(gw.w)) * v1[3];
                    bf16_t* op = O + row * ldo + col0 + bj * HALF;
                    if (!first) { const u32x4 ow = *(const u32x4*)op;
                        r[0] += bflo(ow.x); r[1] += bfhi(ow.x); r[2] += bflo(ow.y); r[3] += bfhi(ow.y); r[4] += bflo(ow.z); r[5] += bfhi(ow.z); r[6] += bflo(ow.w); r[7] += bfhi(ow.w); }
                    u32x4 w; w.x = cvt_pk_bf16(r[0], r[1]); w.y = cvt_pk_bf16(r[2], r[3]); w.z = cvt_pk_bf16(r[4], r[5]); w.w = cvt_pk_bf16(r[6], r[7]);
                    *(u32x4*)op = w; } }
    }
};
template <class Epi, class Sched, bool ALIGN_EPI = false, bool SP2 = false>
__device__ __forceinline__ void gemm_phase(PG8_LAS unsigned char* lds, const Gemm g, const Sched& S, const Epi& E) {
    const int tid = opaque_tid(), wid = __builtin_amdgcn_readfirstlane(tid >> 6), lane = tid & 63, wr = wid >> 2, wc = wid & 3, fr = lane & 15, fq = lane >> 4;
    const int K = g.K, nt = K / BK;
    unsigned voffA[2], voffB[2];
#pragma unroll
    for (int i = 0; i < 2; ++i) { int R, C; stage_rc(tid * 16 + i * 8192, R, C); const int Rb = Epi::PERM ? ((R & ~31) + perm32(R & 31)) : R;
        voffA[i] = (unsigned)(R * K + C) * 2u; voffB[i] = (unsigned)(Rb * K + C) * 2u; }
    const size_t kstep = (size_t)(BK * 2);
    const size_t hstep = (size_t)HALF * K * 2;
    const size_t tstep = 2 * hstep;
    const unsigned ldsw = (unsigned)wid * 1024u;
    const int aoff = lds_byte(wr * 64 + fr, fq * 8), boff = lds_byte(wc * 32 + fr, fq * 8);
#define PG8_SA(b, h) (((b) * 2 + (h)) * HTB)
#define PG8_SB(b, h) ((4 + (b) * 2 + (h)) * HTB)
#define PG8_STAGE(bufoff, gbase, voff) do { _Pragma("unroll") for (int _i = 0; _i < 2; ++_i) \
        __builtin_amdgcn_global_load_lds((const unsigned*)((const char*)(gbase) + (voff)[_i]), (PG8_LAS unsigned*)(lds + (bufoff) + ldsw + _i * 8192), 16, 0, 0); } while (0)
#define PG8_LDA(dst, b, h) do { _Pragma("unroll") for (int m = 0; m < 4; ++m) _Pragma("unroll") for (int k = 0; k < 2; ++k) dst[m][k] = *(const PG8_LAS bf16x8*)(lds + PG8_SA(b, h) + aoff + m * 2048 + k * 1024); } while (0)
#define PG8_LDB(dst, b, h) do { _Pragma("unroll") for (int n = 0; n < 2; ++n) _Pragma("unroll") for (int k = 0; k < 2; ++k) dst[n][k] = *(const PG8_LAS bf16x8*)(lds + PG8_SB(b, h) + boff + n * 2048 + k * 1024); } while (0)
#define PG8_MMA(ai, bj, At, Bt) do { __builtin_amdgcn_s_setprio(1); _Pragma("unroll") for (int m = 0; m < 4; ++m) _Pragma("unroll") for (int n = 0; n < 2; ++n) _Pragma("unroll") for (int k = 0; k < 2; ++k) \
        acc[ai][bj][m][n] = __builtin_amdgcn_mfma_f32_16x16x32_bf16(Bt[n][k], At[m][k], acc[ai][bj][m][n], 0, 0, 0); __builtin_amdgcn_s_setprio(0); } while (0)
#define PG8_WAIT_V(n) asm volatile("s_waitcnt vmcnt(" #n ")" ::: "memory")
#define PG8_WAIT_L(n) asm volatile("s_waitcnt lgkmcnt(" #n ")" ::: "memory")
#define PG8_BAR __builtin_amdgcn_s_barrier()
#define PG8_SCHED __builtin_amdgcn_sched_barrier(0)
    Unit cur, nxt; int ui = 0;
    if (!S.next(0, cur)) return;
    f32x4 acc[2][2][4][2];
#pragma unroll
    for (int a = 0; a < 2; ++a)
#pragma unroll
        for (int b = 0; b < 2; ++b)
#pragma unroll
            for (int m = 0; m < 4; ++m)
#pragma unroll
                for (int n = 0; n < 2; ++n) acc[a][b][m][n] = (f32x4){0.f, 0.f, 0.f, 0.f};
    bf16x8 At[4][2], B0[2][2], B1[2][2];
    const char* cA = (const char*)g.A + (size_t)cur.pm * tstep; const char* cB = (const char*)g.Bt + (size_t)cur.pn * tstep;
    S.a_ready(cur);
    if constexpr (SP2) {
        PG8_STAGE(PG8_SB(0, 0), cB, voffB); PG8_STAGE(PG8_SB(0, 1), cB + hstep, voffB); PG8_STAGE(PG8_SA(0, 0), cA, voffA); PG8_STAGE(PG8_SA(0, 1), cA + hstep, voffA);
        if (wr == 1) PG8_BAR;
        PG8_WAIT_V(2); PG8_BAR;
        PG8_STAGE(PG8_SB(1, 0), cB + kstep, voffB); PG8_STAGE(PG8_SA(1, 0), cA + kstep, voffA); PG8_STAGE(PG8_SB(1, 1), cB + hstep + kstep, voffB);
        PG8_WAIT_V(6); PG8_BAR;
    } else {
        PG8_STAGE(PG8_SB(0, 0), cB, voffB); PG8_STAGE(PG8_SA(0, 0), cA, voffA); PG8_STAGE(PG8_SB(0, 1), cB + hstep, voffB); PG8_STAGE(PG8_SA(0, 1), cA + hstep, voffA);
        if (wr == 1) PG8_BAR;
        PG8_WAIT_V(4); PG8_BAR;
        PG8_STAGE(PG8_SB(1, 0), cB + kstep, voffB); PG8_STAGE(PG8_SA(1, 0), cA + kstep, voffA); PG8_STAGE(PG8_SB(1, 1), cB + hstep + kstep, voffB);
        PG8_WAIT_V(6); PG8_BAR;
    }
    for (;;) {
        const bool has_next = S.next(ui + 1, nxt);
        const char* nA = has_next ? (const char*)g.A + (size_t)nxt.pm * tstep : cA; const char* nB = has_next ? (const char*)g.Bt + (size_t)nxt.pn * tstep : cB;
        for (int t = 0; t < nt; t += 2) {
            const bool last = (t == nt - 2);
            const char* a1 = cA + (size_t)(t + 1) * kstep;
            const char* a2 = last ? nA : cA + (size_t)(t + 2) * kstep; const char* b2 = last ? nB : cB + (size_t)(t + 2) * kstep;
            const char* a3 = a2 + kstep; const char* b3 = b2 + kstep;
            if (last && has_next) S.a_ready(nxt);
            if constexpr (SP2) {
            PG8_LDB(B0, 0, 0); PG8_LDB(B1, 0, 1); PG8_SCHED; PG8_LDA(At, 0, 0); PG8_STAGE(PG8_SA(1, 1), a1 + hstep, voffA);
            PG8_WAIT_V(8); PG8_WAIT_L(0); PG8_BAR; PG8_MMA(0, 0, At, B0); PG8_MMA(0, 1, At, B1); PG8_BAR; PG8_SCHED;
            PG8_LDA(At, 0, 1); PG8_STAGE(PG8_SB(0, 0), b2, voffB); PG8_STAGE(PG8_SB(0, 1), b2 + hstep, voffB); PG8_STAGE(PG8_SA(0, 0), a2, voffA);
            PG8_WAIT_V(8); PG8_WAIT_L(0); PG8_BAR; PG8_MMA(1, 0, At, B0); PG8_MMA(1, 1, At, B1); PG8_BAR; PG8_SCHED;
            PG8_LDB(B0, 1, 0); PG8_LDB(B1, 1, 1); PG8_SCHED; PG8_LDA(At, 1, 0); PG8_STAGE(PG8_SA(0, 1), a2 + hstep, voffA);
            PG8_WAIT_V(8); PG8_WAIT_L(0); PG8_BAR; PG8_MMA(0, 0, At, B0); PG8_MMA(0, 1, At, B1); PG8_BAR; PG8_SCHED;
            PG8_LDA(At, 1, 1); PG8_STAGE(PG8_SB(1, 0), b3, voffB); PG8_STAGE(PG8_SB(1, 1), b3 + hstep, voffB); PG8_STAGE(PG8_SA(1, 0), a3, voffA);
            PG8_WAIT_V(8); PG8_WAIT_L(0); PG8_BAR; PG8_MMA(1, 0, At, B0); PG8_MMA(1, 1, At, B1); PG8_BAR; PG8_SCHED;
            } else {
            PG8_LDB(B0, 0, 0); PG8_SCHED; PG8_LDA(At, 0, 0); PG8_STAGE(PG8_SA(1, 1), a1 + hstep, voffA);
            PG8_WAIT_L(8); PG8_BAR; PG8_WAIT_L(0); PG8_MMA(0, 0, At, B0); PG8_BAR; PG8_SCHED;
            PG8_LDB(B1, 0, 1); PG8_STAGE(PG8_SB(0, 0), b2, voffB);
            PG8_BAR; PG8_WAIT_L(0); PG8_MMA(0, 1, At, B1); PG8_BAR;
            PG8_LDA(At, 0, 1); PG8_STAGE(PG8_SA(0, 0), a2, voffA);
            PG8_BAR; PG8_WAIT_L(0); PG8_MMA(1, 0, At, B0); PG8_BAR; PG8_SCHED;
            PG8_STAGE(PG8_SB(0, 1), b2 + hstep, voffB);
            PG8_WAIT_V(6); PG8_BAR; PG8_MMA(1, 1, At, B1); PG8_BAR;
            PG8_LDB(B0, 1, 0); PG8_SCHED; PG8_LDA(At, 1, 0); PG8_STAGE(PG8_SA(0, 1), a2 + hstep, voffA);
            PG8_WAIT_L(8); PG8_BAR; PG8_WAIT_L(0); PG8_MMA(0, 0, At, B0); PG8_BAR; PG8_SCHED;
            PG8_LDB(B1, 1, 1); PG8_STAGE(PG8_SB(1, 0), b3, voffB);
            PG8_BAR; PG8_WAIT_L(0); PG8_MMA(0, 1, At, B1); PG8_BAR;
            PG8_LDA(At, 1, 1); PG8_STAGE(PG8_SA(1, 0), a3, voffA);
            PG8_BAR; PG8_WAIT_L(0); PG8_MMA(1, 0, At, B0); PG8_BAR; PG8_SCHED;
            PG8_STAGE(PG8_SB(1, 1), b3 + hstep, voffB);
            PG8_WAIT_V(6); PG8_BAR; PG8_MMA(1, 1, At, B1); PG8_BAR;
            }
        }
        if constexpr (ALIGN_EPI) { if (wr == 0) PG8_BAR; }
        if constexpr (!Epi::AFTER_DRAIN) { E(acc, cur, wr, wc, fr, fq); S.done(cur); }
        if (!has_next) break;
#pragma unroll
        for (int a = 0; a < 2; ++a)
#pragma unroll
            for (int b = 0; b < 2; ++b)
#pragma unroll
                for (int m = 0; m < 4; ++m)
#pragma unroll
                    for (int n = 0; n < 2; ++n) acc[a][b][m][n] = (f32x4){0.f, 0.f, 0.f, 0.f};
        cur = nxt; cA = nA; cB = nB; ++ui;
        if constexpr (ALIGN_EPI) { if (wr == 1) PG8_BAR; }
    }
    PG8_WAIT_V(0);
    if constexpr (!ALIGN_EPI) { if (wr == 0) PG8_BAR; }
    PG8_BAR;
    if constexpr (Epi::AFTER_DRAIN) { E.fused(acc, cur, wr, wc, fr, fq, lds, wid, lane); S.done(cur); }
#undef PG8_SA
#undef PG8_SB
#undef PG8_STAGE
#undef PG8_LDA
#undef PG8_LDB
#undef PG8_MMA
#undef PG8_WAIT_V
#undef PG8_WAIT_L
#undef PG8_BAR
#undef PG8_SCHED
}
}
constexpr int T = 16384, DM = 1024, NL = 4, DFF = 2816;
constexpr int NP1 = 2560, NP2 = 5120;
constexpr int C1_VRES = 1792, C1_CQ = 1824, C1_CKV = 2208, C1_KR = 2464;
constexpr int C2_HQ = 0, C2_HF = 512, C2_HI = 1024, C2_HG = 1536, C2_GATE = 2048;
constexpr float NORM_EPS = 1e-6f;
constexpr float QSCALE = 0.10206207261596575f * 1.4426950408889634f;
constexpr float LOG2E = 1.4426950408889634f;

constexpr size_t MiB = 1u << 20;
constexpr size_t WS_CTL = 0;
constexpr size_t WS_COS = 1 * MiB, WS_SIN = 2 * MiB, WS_LB = 3 * MiB;
constexpr size_t WS_WA = 4 * MiB;
constexpr size_t WA_GU = WS_WA, WA_D = WS_WA + (size_t)5632 * 1024 * 2;
constexpr size_t WS_WB = 22 * MiB;
constexpr size_t WB_IN = WS_WB;
constexpr size_t WB_LORA = WB_IN + (size_t)7680 * 1024 * 2;
constexpr size_t WB_UQ = WB_LORA + (size_t)2048 * 384 * 2;
constexpr size_t WB_UK = WB_UQ + (size_t)768 * 384 * 2;
constexpr size_t WB_UV = WB_UK + (size_t)512 * 256 * 2;
constexpr size_t WB_OUT = WB_UV + (size_t)512 * 256 * 2;
constexpr size_t WB_O = WB_OUT + (size_t)3 * 1024 * 512 * 2;
static_assert(WB_O + (size_t)1024 * 1024 * 2 <= 46 * MiB, "W_B region");
static_assert(WA_D + (size_t)1024 * 2816 * 2 <= 22 * MiB, "W_A region");
constexpr size_t WS_VFIRST = 46 * MiB;
constexpr size_t WS_P1 = 62 * MiB;
constexpr size_t WS_P2 = 142 * MiB;
constexpr size_t WS_ACT = WS_P1;
constexpr size_t WS_LORA = WS_P1;
constexpr size_t WS_YA = WS_P1 + 64 * MiB;
constexpr size_t WS_MERGED = WS_P1;
constexpr size_t WS_Y = 302 * MiB;
constexpr size_t WS_XN = 366 * MiB;
constexpr size_t WS_RB = 302 * MiB, WS_KB = 318 * MiB, WS_VB = 334 * MiB;
constexpr size_t WS_Q = 350 * MiB;
constexpr size_t WS_KNOPE = 374 * MiB;
constexpr size_t WS_LIN = 398 * MiB;
constexpr size_t WS_CQN = 410 * MiB;
constexpr size_t WS_CKVN = 422 * MiB;
constexpr size_t WS_KROPE = 430 * MiB;
constexpr size_t WS_DVEC = 431 * MiB;
constexpr size_t WS_DS = 432 * MiB;
constexpr size_t WS_VT = 464 * MiB;
constexpr size_t WS_YB = 398 * MiB, WS_YC = 414 * MiB;
constexpr size_t WS_PU = 480 * MiB;
constexpr size_t WS_SINIT = 488 * MiB;
constexpr size_t WS_END = 492 * MiB;

constexpr int LDS_BYTES = 159744;

typedef unsigned short bf16_t;
typedef unsigned v4u __attribute__((ext_vector_type(4)));
typedef unsigned v2u __attribute__((ext_vector_type(2)));
typedef float f32x4 __attribute__((ext_vector_type(4)));
typedef float f32x16 __attribute__((ext_vector_type(16)));
typedef short bf16x8 __attribute__((ext_vector_type(8)));
#define LDS_WAIT() asm volatile("s_waitcnt lgkmcnt(0)" ::: "memory")
__device__ __forceinline__ unsigned f2bf(float f) { unsigned u = __float_as_uint(f); return (u + 0x7fffu + ((u >> 16) & 1u)) >> 16; }
typedef float f32x2_t __attribute__((ext_vector_type(2))); typedef __bf16 bf16x2_t __attribute__((ext_vector_type(2)));
__device__ __forceinline__ unsigned pk2(float lo, float hi) { f32x2_t v = {lo, hi}; bf16x2_t b = __builtin_convertvector(v, bf16x2_t); return __builtin_bit_cast(unsigned, b); }
__device__ __forceinline__ float bflo(unsigned w) { return __uint_as_float(w << 16); }
__device__ __forceinline__ float bfhi(unsigned w) { return __uint_as_float(w & 0xffff0000u); }
__device__ __forceinline__ float bf1(bf16_t v) { return __uint_as_float(((unsigned)v) << 16); }
__device__ __forceinline__ float sigm(float x) { return 1.0f / (1.0f + __expf(-x)); }
__device__ __forceinline__ float wave_sum(float v) {
#pragma unroll
    for (int o = 1; o < 64; o <<= 1) v += __shfl_xor(v, o);
    return v;
}
template <int CTRL> __device__ __forceinline__ float dppf(float x) { return __int_as_float(__builtin_amdgcn_update_dpp(0, __float_as_int(x), CTRL, 0xF, 0xF, true)); }
__device__ __forceinline__ float red16(float x) {
    x += dppf<0xB1>(x);
    x += dppf<0x4E>(x);
    x += dppf<0x141>(x);
    x += dppf<0x140>(x);
    return x;
}
__device__ __forceinline__ void unpack8(const v4u w, float* f) { f[0] = bflo(w.x); f[1] = bfhi(w.x); f[2] = bflo(w.y); f[3] = bfhi(w.y); f[4] = bflo(w.z); f[5] = bfhi(w.z); f[6] = bflo(w.w); f[7] = bfhi(w.w); }
__device__ __forceinline__ v4u pack8(const float* f) { v4u w; w.x = pk2(f[0], f[1]); w.y = pk2(f[2], f[3]); w.z = pk2(f[4], f[5]); w.w = pk2(f[6], f[7]); return w; }

struct Params { const void* in[40]; float* out; unsigned char* ws; };

__device__ __forceinline__ void conv_item(const float* __restrict__ W, int ldw, int k0, int n0, bf16_t* WT, int ldk, int drow0, int extra16, float* scr, int lane) {
    float wv_[32];
#pragma unroll
    for (int i = 0; i < 32; ++i) wv_[i] = W[(size_t)(k0 + 2 * i + (lane >> 5)) * ldw + n0 + (lane & 31)];
#pragma unroll
    for (int i = 0; i < 32; ++i) scr[(2 * i + (lane >> 5)) * 33 + (lane & 31)] = wv_[i];
    LDS_WAIT();
    const int c = lane & 7;
#pragma unroll
    for (int j = 0; j < 4; ++j) { const int n = (lane >> 3) + 8 * j; const float* s = scr + (8 * c) * 33 + n;
        v4u o; o.x = pk2(s[0 * 33], s[1 * 33]); o.y = pk2(s[2 * 33], s[3 * 33]); o.z = pk2(s[4 * 33], s[5 * 33]); o.w = pk2(s[6 * 33], s[7 * 33]);
        const int row = drow0 + n + (n >= 16 ? extra16 : 0);
        *(v4u*)(WT + (size_t)row * ldk + k0 + 8 * c) = o; }
    LDS_WAIT();
}
__device__ __forceinline__ void zero_item(bf16_t* WT, int ldk, int row0, int k0, int lane) {
    const int c = lane & 7;
#pragma unroll
    for (int j = 0; j < 4; ++j) { const int n = (lane >> 3) + 8 * j; *(v4u*)(WT + (size_t)(row0 + n) * ldk + k0 + 8 * c) = (v4u){0u, 0u, 0u, 0u}; }
}
__device__ __forceinline__ void conv_ffn(const float* wg, const float* wu, const float* wd, unsigned char* ws, unsigned char* lds, int wg0) {
    PHASE_IDS; float* scr = (float*)(lds + wave * 8448);
    if (bid < wg0) return;
    const int gw_ = (bid - wg0) * 8 + wave, ngw_ = (G - wg0) * 8;
    bf16_t* GU = (bf16_t*)(ws + WA_GU); bf16_t* Dn = (bf16_t*)(ws + WA_D);
    for (int it = gw_; it < 3 * 1408; it += ngw_) {
        int r = it;
        if (r < 1408) { const int kb = r / 88, nb = r % 88; conv_item(wg, DFF, 64 * kb, 32 * nb, GU, 1024, 64 * nb, 16, scr, lane); continue; } r -= 1408;
        if (r < 1408) { const int kb = r / 88, nb = r % 88; conv_item(wu, DFF, 64 * kb, 32 * nb, GU, 1024, 64 * nb + 16, 16, scr, lane); continue; } r -= 1408;
        { const int kb = r / 32, nb = r % 32; conv_item(wd, 1024, 64 * kb, 32 * nb, Dn, DFF, 32 * nb, 0, scr, lane); }
    }
}
__device__ __forceinline__ void conv_ffn_item(const float* wg, const float* wu, const float* wd, unsigned char* ws, unsigned char* lds, int item) {
    const int tid = opaque_tid(), lane = tid & 63, wave = __builtin_amdgcn_readfirstlane(tid >> 6); float* scr = (float*)(lds + wave * 8448);
    bf16_t* GU = (bf16_t*)(ws + WA_GU); bf16_t* Dn = (bf16_t*)(ws + WA_D);
    __syncthreads();
    for (int j = 0; j < 8; ++j) {
        int r = item * 64 + wave * 8 + j;
        if (r >= 3 * 1408) break;
        if (r < 1408) { const int kb = r / 88, nb = r % 88; conv_item(wg, DFF, 64 * kb, 32 * nb, GU, 1024, 64 * nb, 16, scr, lane); continue; } r -= 1408;
        if (r < 1408) { const int kb = r / 88, nb = r % 88; conv_item(wu, DFF, 64 * kb, 32 * nb, GU, 1024, 64 * nb + 16, 16, scr, lane); continue; } r -= 1408;
        { const int kb = r / 32, nb = r % 32; conv_item(wd, 1024, 64 * kb, 32 * nb, Dn, DFF, 32 * nb, 0, scr, lane); }
    }
}
__device__ __forceinline__ void conv_mixer(const Params& P, int l, unsigned char* lds) {
    PHASE_IDS; float* scr = (float*)(lds + wave * 8448);
    unsigned char* ws = opaque_ptr(P.ws);
    bf16_t* WIN = (bf16_t*)(ws + WB_IN); bf16_t* WLORA = (bf16_t*)(ws + WB_LORA); bf16_t* WUQ = (bf16_t*)(ws + WB_UQ); bf16_t* WUK = (bf16_t*)(ws + WB_UK);
    bf16_t* WUV = (bf16_t*)(ws + WB_UV); bf16_t* WOUT = (bf16_t*)(ws + WB_OUT); bf16_t* WO = (bf16_t*)(ws + WB_O);
    const float* w_in = GPF(P.in[9]) + (size_t)l * 1024 * 7584;
    const float* w_up = GPF(P.in[12]) + (size_t)l * 64 * 512;
    const float* a_up = GPF(P.in[14]) + (size_t)l * 64 * 512;
    const float* g_up = GPF(P.in[15]) + (size_t)l * 128 * 512;
    const float* vdown = (l > 0) ? GPF(P.in[21]) + (size_t)(l - 1) * 1024 * 32 : nullptr;
    const float* vup = (l > 0) ? GPF(P.in[23]) + (size_t)(l - 1) * 32 * 512 : nullptr;
    const float* w_uq = GPF(P.in[27]) + (size_t)l * 384 * 768;
    const float* w_ukv = GPF(P.in[29]) + (size_t)l * 256 * 1024;
    const float* w_o = GPF(P.in[34]) + (size_t)l * 1024 * 1024;
    constexpr int I_IN = 16 * 237, I_VD = 16, I_PAD = 32, I_LORA = 6 * 64, I_UQ = 6 * 24, I_UKV = 4 * 32, I_OUT = 3 * 256, I_O = 16 * 32;
    constexpr int NITEMS = I_IN + I_VD + I_PAD + I_LORA + I_UQ + I_UKV + I_OUT + I_O;
    for (int it = gw; it < NITEMS; it += ngw) {
        int r = it;
        if (r < I_IN) { const int kb = r / 237, nb = r % 237, n0 = 32 * nb; const int dr = n0 + (n0 < 1792 ? 0 : (n0 < 2464 ? 32 : 96));
            conv_item(w_in, 7584, 64 * kb, n0, WIN, 1024, dr, 0, scr, lane); continue; } r -= I_IN;
        if (r < I_VD) { if (l > 0) conv_item(vdown, 32, 64 * r, 0, WIN, 1024, C1_VRES, 0, scr, lane); else zero_item(WIN, 1024, C1_VRES, 64 * r, lane); continue; } r -= I_VD;
        if (r < I_PAD) { zero_item(WIN, 1024, 2496 + 32 * (r >> 4), 64 * (r & 15), lane); continue; } r -= I_PAD;
        if (r < I_LORA) { const int kb = r / 64, nb = r % 64; const int b = nb >> 4, nn = (32 * nb) & 511;
            const float* src = b == 0 ? w_up : (b == 1 ? a_up : (b == 2 ? g_up : vup));
            const int ks = b == 0 ? 0 : (b == 1 ? 64 : (b == 2 ? 128 : 256)), ke = b == 0 ? 64 : (b == 1 ? 128 : (b == 2 ? 256 : 288));
            const int c = lane & 7;
#pragma unroll
            for (int j = 0; j < 4; ++j) { const int n = (lane >> 3) + 8 * j; float f[8];
#pragma unroll
                for (int e = 0; e < 8; ++e) { const int k = 64 * kb + 8 * c + e; f[e] = (src != nullptr && k >= ks && k < ke) ? src[(size_t)(k - ks) * 512 + nn + n] : 0.f; }
                *(v4u*)(WLORA + (size_t)(32 * nb + n) * 384 + 64 * kb + 8 * c) = pack8(f); }
            continue; } r -= I_LORA;
        if (r < I_UQ) { const int kb = r / 24, nb = r % 24; conv_item(w_uq, 768, 64 * kb, 32 * nb, WUQ, 384, 32 * nb, 0, scr, lane); continue; } r -= I_UQ;
        if (r < I_UKV) { const int kb = r / 32, nb = r % 32, n0 = 32 * nb, h = n0 >> 7, j = n0 & 127;
            if (j < 64) conv_item(w_ukv, 1024, 64 * kb, n0, WUK, 256, h * 64 + j, 0, scr, lane); else conv_item(w_ukv, 1024, 64 * kb, n0, WUV, 256, h * 64 + j - 64, 0, scr, lane);
            continue; } r -= I_UKV;
        if (r < I_OUT) { const int br = r / 256, q = r % 256, kb = q / 32, nb = q % 32;
            const float* src = GPF(P.in[br == 0 ? 25 : (br == 1 ? 30 : 33)]) + (size_t)l * 512 * 1024;
            conv_item(src, 1024, 64 * kb, 32 * nb, WOUT + (size_t)br * 1024 * 512, 512, 32 * nb, 0, scr, lane); continue; } r -= I_OUT;
        { const int kb = r / 32, nb = r % 32; conv_item(w_o, 1024, 64 * kb, 32 * nb, WO, 1024, 32 * nb, 0, scr, lane); }
    }
}

__device__ __forceinline__ void phase_rowwise(const bf16_t* ysrc, const float* hin, float* hout, float wt, const float* g_post, const float* g_pre, bf16_t* xn) {
    PHASE_IDS;
    for (int row = gw; row < T; row += 2 * ngw) {
        const int rowb = row + ngw; const bool two = rowb < T; const int rb = two ? rowb : row;
        f32x4 ha[4], hb[4]; v2u ya[4], yb[4];
        { const f32x4* hr = (const f32x4*)(hin + (size_t)row * DM) + lane; const f32x4* hr2 = (const f32x4*)(hin + (size_t)rb * DM) + lane;
#pragma unroll
          for (int j = 0; j < 4; ++j) { ha[j] = hr[64 * j]; hb[j] = hr2[64 * j]; }
          if (ysrc) { const v2u* yr = (const v2u*)(ysrc + (size_t)row * DM) + lane; const v2u* yr2 = (const v2u*)(ysrc + (size_t)rb * DM) + lane;
#pragma unroll
            for (int j = 0; j < 4; ++j) { ya[j] = yr[64 * j]; yb[j] = yr2[64 * j]; } } }
#pragma unroll
        for (int half = 0; half < 2; ++half) {
            if (half == 1 && !two) break;
            const int r = half ? rowb : row;
            f32x4 h[4];
#pragma unroll
            for (int j = 0; j < 4; ++j) h[j] = half ? hb[j] : ha[j];
            if (ysrc) {
                f32x4 y[4]; float s = 0.f;
#pragma unroll
                for (int j = 0; j < 4; ++j) { const v2u w = half ? yb[j] : ya[j]; y[j] = (f32x4){bflo(w.x), bfhi(w.x), bflo(w.y), bfhi(w.y)}; s += (y[j].x * y[j].x + y[j].y * y[j].y) + (y[j].z * y[j].z + y[j].w * y[j].w); }
                const float rinv = wt * rsqrtf(wave_sum(s) * (1.f / DM) + NORM_EPS);
#pragma unroll
                for (int j = 0; j < 4; ++j) { const f32x4 g = *((const f32x4*)g_post + lane + 64 * j); h[j] = h[j] + y[j] * g * rinv; }
            }
            f32x4* ho = (f32x4*)(hout + (size_t)r * DM) + lane;
#pragma unroll
            for (int j = 0; j < 4; ++j) ho[64 * j] = h[j];
            if (g_pre) {
                float s = 0.f;
#pragma unroll
                for (int j = 0; j < 4; ++j) s += (h[j].x * h[j].x + h[j].y * h[j].y) + (h[j].z * h[j].z + h[j].w * h[j].w);
                const float rinv = rsqrtf(wave_sum(s) * (1.f / DM) + NORM_EPS);
                unsigned long long* o8 = (unsigned long long*)(xn + (size_t)r * DM) + lane;
#pragma unroll
                for (int j = 0; j < 4; ++j) { const f32x4 g = *((const f32x4*)g_pre + lane + 64 * j); const f32x4 v = h[j] * g * rinv;
                    o8[64 * j] = (unsigned long long)pk2(v.x, v.y) | ((unsigned long long)pk2(v.z, v.w) << 32); }
            }
        }
    }
}
#define LAS __attribute__((address_space(3)))
#define XB_TMO      128
#define XB_XCNT(j)  (256  + 64 * (j))
#define XB_XSUB(j)  (1280 + 64 * (j))
#define XB_XGEN(j)  (2304 + 64 * (j))
#define XB_TOP      3328
#define XB_TOPGEN   3392
#define XCD_BAR_WORDS 3456
#define XB_SPIN_CAP (1u << 18)

__device__ __forceinline__ unsigned xb_ld(unsigned* p)              { return __hip_atomic_load(p, __ATOMIC_RELAXED, __HIP_MEMORY_SCOPE_AGENT); }
__device__ __forceinline__ unsigned xb_add(unsigned* p, unsigned v) { return __hip_atomic_fetch_add(p, v, __ATOMIC_RELAXED, __HIP_MEMORY_SCOPE_AGENT); }
__device__ __forceinline__ unsigned xb_xcc_id() { return (unsigned)__builtin_amdgcn_s_getreg((3 << 11) | 20) & 0xFu; }
#define XB_SPIN(cond, bar) do { unsigned _sp = 0; while (cond) { __builtin_amdgcn_s_sleep(1); \
    if ((++_sp & 255u) == 0u) { if (xb_ld(&(bar)[XB_TMO])) break; if (_sp > XB_SPIN_CAP) { atomicAdd(&(bar)[XB_TMO], 1u); break; } } } } while (0)

struct XcdBarrier {
    unsigned* bar; unsigned x;
    volatile LAS unsigned* st;
};

__device__ __forceinline__ XcdBarrier xcd_barrier_post(unsigned* bar, volatile LAS unsigned* st) {
    XcdBarrier b; b.bar = bar; b.x = xb_xcc_id(); b.st = st;
    if (threadIdx.x == 0) (void)xb_add(&bar[XB_XCNT(b.x)], 1u);
    return b;
}
__device__ __forceinline__ void xcd_barrier_complete(unsigned* bar, unsigned x, unsigned& nloc, unsigned& nx) {
    const unsigned G = gridDim.x * gridDim.y * gridDim.z;
    unsigned sum, cnt, mine, sp = 0u;
    for (;;) {
        sum = 0u; cnt = 0u; mine = 0u;
#pragma unroll
        for (unsigned j = 0; j < 16; ++j) { const unsigned c = xb_ld(&bar[XB_XCNT(j)]); sum += c; cnt += (c > 0u) ? 1u : 0u; mine = (j == x) ? c : mine; }
        if (sum == G) break;
        __builtin_amdgcn_s_sleep(1);
        if ((++sp & 255u) == 0u) { if (xb_ld(&bar[XB_TMO])) break; if (sp > XB_SPIN_CAP) { atomicAdd(&bar[XB_TMO], 1u); break; } }
    }
    nloc = mine > 0u ? mine : 1u; nx = cnt > 0u ? cnt : 1u;
}

__device__ __forceinline__ void xcd_barrier(const XcdBarrier& b) {
    asm volatile("s_waitcnt vmcnt(0)" ::: "memory");
    __syncthreads();
    if (threadIdx.x == 0) {
        unsigned* bar = b.bar;
        __builtin_amdgcn_s_waitcnt(0);
        unsigned nloc = b.st[0], nx = b.st[1];
        if (nloc == 0u) { xcd_barrier_complete(bar, b.x, nloc, nx); b.st[0] = nloc; b.st[1] = nx; }
        const unsigned old = xb_add(&bar[XB_XSUB(b.x)], 1u);
        const unsigned gen = old / nloc;
        if (old + 1u == (gen + 1u) * nloc) {
            __builtin_amdgcn_fence(__ATOMIC_RELEASE, "agent");
            asm volatile("s_waitcnt vmcnt(0)" ::: "memory");
            const unsigned og = xb_add(&bar[XB_TOP], 1u);
            const unsigned tg = og / nx;
            if (og + 1u == (tg + 1u) * nx) xb_add(&bar[XB_TOPGEN], 1u);
            else XB_SPIN(xb_ld(&bar[XB_TOPGEN]) == tg, bar);
            __builtin_amdgcn_fence(__ATOMIC_ACQUIRE, "agent");
            xb_add(&bar[XB_XGEN(b.x)], 1u);
            asm volatile("s_waitcnt vmcnt(0)" ::: "memory");
        } else {
            XB_SPIN(xb_ld(&bar[XB_XGEN(b.x)]) == gen, bar);
            __builtin_amdgcn_fence(__ATOMIC_ACQUIRE, "agent");
            asm volatile("s_waitcnt vmcnt(0)" ::: "memory");
        }
    }
    __syncthreads();
}
__device__ __forceinline__ void phase_tables(const Params& P) {
    PHASE_IDS;
    float* COS = (float*)(opaque_ptr(P.ws) + WS_COS); float* SIN = (float*)(opaque_ptr(P.ws) + WS_SIN); float* LB = (float*)(opaque_ptr(P.ws) + WS_LB);
    const int* pos = GPI(P.in[1]);
    for (int e = gtid; e < T * 16; e += gthreads) {
        const int t = e >> 4, i = e & 15;
        const double inv_freq = exp(-(double)i * (9.210340371976184 / 16.0));
        double rev = (double)pos[t] * inv_freq * 0.15915494309189535;
        rev -= floor(rev);
        const float x = (float)rev;
        COS[e] = __builtin_amdgcn_cosf(x); SIN[e] = __builtin_amdgcn_sinf(x);
    }
    if (gtid < 512) {
        const float* lbw = GPF(P.in[31]);
        float v[NL], mx = -1e30f, s = 0.f;
#pragma unroll
        for (int l = 0; l < NL; ++l) { v[l] = lbw[l * 512 + gtid]; mx = fmaxf(mx, v[l]); }
#pragma unroll
        for (int l = 0; l < NL; ++l) { v[l] = __expf(v[l] - mx); s += v[l]; }
        float c = 0.f; const float p0 = v[0] / s;
#pragma unroll
        for (int l = 0; l < NL; ++l) { c += v[l] / s; LB[l * 512 + gtid] = c - p0; }
    }
}

__device__ __forceinline__ void phase_prep(const Params& P, int l) {
    PHASE_IDS;
    unsigned char* ws = opaque_ptr(P.ws);
    const bf16_t* P1 = (const bf16_t*)(ws + WS_P1);
    bf16_t* RB = (bf16_t*)(ws + WS_RB); bf16_t* KB = (bf16_t*)(ws + WS_KB); bf16_t* VB = (bf16_t*)(ws + WS_VB); bf16_t* VF = (bf16_t*)(ws + WS_VFIRST);
    bf16_t* LIN = (bf16_t*)(ws + WS_LIN); bf16_t* CQN = (bf16_t*)(ws + WS_CQN); bf16_t* CKVN = (bf16_t*)(ws + WS_CKVN); bf16_t* KROPE = (bf16_t*)(ws + WS_KROPE);
    const float* COS = (const float*)(ws + WS_COS); const float* SIN = (const float*)(ws + WS_SIN);
    const float* mu = GPF(P.in[10]) + (size_t)l * 1792;
    const float* vmu = (l > 0) ? GPF(P.in[22]) + (size_t)(l - 1) * 32 : nullptr;
    const float* qg = GPF(P.in[26]) + (size_t)l * 384;
    const float* kvg = GPF(P.in[28]) + (size_t)l * 256;
    for (int t = gw; t < T; t += ngw) {
        const unsigned* cur = (const unsigned*)(P1 + (size_t)t * NP1);
        const unsigned* prv = (const unsigned*)(P1 + (size_t)(t > 0 ? t - 1 : 0) * NP1);
        const bool hasp = t > 0;
#pragma unroll
        for (int i = 0; i < 14; ++i) {
            const int j = lane + 64 * i, col = 2 * j;
            const unsigned cw = cur[j], pw = hasp ? prv[j] : 0u;
            const float c0 = bflo(cw), c1 = bfhi(cw), p0 = bflo(pw), p1 = bfhi(pw);
            float m0 = c0 + (p0 - c0) * mu[col], m1 = c1 + (p1 - c1) * mu[col + 1];
            if (i < 4) { *(unsigned*)(RB + (size_t)t * 512 + col) = pk2(m0, m1); }
            else if (i < 8) { *(unsigned*)(KB + (size_t)t * 512 + col - 512) = pk2(m0, m1); }
            else if (i < 12) { const unsigned w = pk2(m0, m1); *(unsigned*)(VB + (size_t)t * 512 + col - 1024) = w; if (l == 0) *(unsigned*)(VF + (size_t)t * 512 + col - 1024) = w; }
            else {
                if (col < 1600) { m0 = tanhf(m0); m1 = tanhf(m1); } else if (col >= 1664) { m0 = sigm(m0); m1 = sigm(m1); }
                *(unsigned*)(LIN + (size_t)t * 384 + col - 1536) = pk2(m0, m1);
            }
        }
        if (lane < 16) {
            unsigned w = 0u;
            if (l > 0) { const int j = (C1_VRES >> 1) + lane; const unsigned cw = cur[j], pw = hasp ? prv[j] : 0u;
                const float c0 = bflo(cw), c1 = bfhi(cw), p0 = bflo(pw), p1 = bfhi(pw);
                w = pk2(c0 + (p0 - c0) * vmu[2 * lane], c1 + (p1 - c1) * vmu[2 * lane + 1]); }
            *(unsigned*)(LIN + (size_t)t * 384 + 256 + 2 * lane) = w;
        } else {
            *(unsigned*)(LIN + (size_t)t * 384 + 288 + 2 * (lane - 16)) = 0u;
        }
        {
            float c[6]; float s = 0.f;
#pragma unroll
            for (int i = 0; i < 3; ++i) { const unsigned w = cur[(C1_CQ >> 1) + lane + 64 * i]; c[2 * i] = bflo(w); c[2 * i + 1] = bfhi(w); s += c[2 * i] * c[2 * i] + c[2 * i + 1] * c[2 * i + 1]; }
            const float rinv = rsqrtf(wave_sum(s) * (1.f / 384.f) + NORM_EPS);
#pragma unroll
            for (int i = 0; i < 3; ++i) { const int cc = 2 * (lane + 64 * i); *(unsigned*)(CQN + (size_t)t * 384 + cc) = pk2(c[2 * i] * rinv * qg[cc], c[2 * i + 1] * rinv * qg[cc + 1]); }
        }
        {
            float c[4]; float s = 0.f;
#pragma unroll
            for (int i = 0; i < 2; ++i) { const unsigned w = cur[(C1_CKV >> 1) + lane + 64 * i]; c[2 * i] = bflo(w); c[2 * i + 1] = bfhi(w); s += c[2 * i] * c[2 * i] + c[2 * i + 1] * c[2 * i + 1]; }
            const float rinv = rsqrtf(wave_sum(s) * (1.f / 256.f) + NORM_EPS);
#pragma unroll
            for (int i = 0; i < 2; ++i) { const int cc = 2 * (lane + 64 * i); *(unsigned*)(CKVN + (size_t)t * 256 + cc) = pk2(c[2 * i] * rinv * kvg[cc], c[2 * i + 1] * rinv * kvg[cc + 1]); }
        }
        if (lane < 16) {
            const bf16_t* row = P1 + (size_t)t * NP1 + C1_KR;
            const float x1 = bf1(row[lane]), x2 = bf1(row[16 + lane]);
            const float cs = COS[t * 16 + lane], sn = SIN[t * 16 + lane];
            KROPE[(size_t)t * 32 + lane] = (bf16_t)f2bf(x1 * cs - x2 * sn);
            KROPE[(size_t)t * 32 + 16 + lane] = (bf16_t)f2bf(x2 * cs + x1 * sn);
        }
    }
}

__device__ __forceinline__ void hgrn_a_unit(const Params& P, int l, int unit, unsigned char* lds) {
    const int tid = opaque_tid();
    const int c = unit >> 2, h = unit & 3, t0 = c * 64;
    const bf16_t* P2 = (const bf16_t*)(opaque_ptr(P.ws) + WS_P2);
    const float* LB = (const float*)(opaque_ptr(P.ws) + WS_LB) + l * 512 + h * 128;
    float* kd = (float*)lds;
    float* kg = (float*)(lds + 32768);
    bf16_t* vT = (bf16_t*)(lds + 65536);
    bf16_t* kdT = (bf16_t*)(lds + 102400);
    float* bl = (float*)(lds + 98304);
    __syncthreads();
#pragma unroll
    for (int i = 0; i < 8; ++i) {
        const int e = tid + 512 * i, s = e >> 6, k2 = (e & 63) * 2;
        const unsigned fw = *(const unsigned*)(P2 + (size_t)(t0 + s) * NP2 + C2_HF + h * 128 + k2);
        const unsigned iw = *(const unsigned*)(P2 + (size_t)(t0 + s) * NP2 + C2_HI + h * 128 + k2);
        const float lb0 = LB[k2], lb1 = LB[k2 + 1];
        const float z0 = bflo(fw), z1 = bfhi(fw);
        const float f0 = lb0 + (1.f - lb0) * sigm(z0), f1 = lb1 + (1.f - lb1) * sigm(z1);
        kd[s * 128 + k2] = __logf(fmaxf(f0, 1e-6f)); kd[s * 128 + k2 + 1] = __logf(fmaxf(f1, 1e-6f));
        kg[s * 128 + k2] = (1.f - lb0) * sigm(-z0); kg[s * 128 + k2 + 1] = (1.f - lb1) * sigm(-z1);
        vT[k2 * 72 + s] = (bf16_t)(iw & 0xffffu); vT[(k2 + 1) * 72 + s] = (bf16_t)(iw >> 16);
    }
    __syncthreads();
    {
        float* tot = bl + 128;
        const int k = tid & 127, seg = tid >> 7; float b = 0.f;
#pragma unroll 4
        for (int s = 16 * seg; s < 16 * seg + 16; ++s) { b += kd[s * 128 + k]; kd[s * 128 + k] = b; }
        tot[seg * 128 + k] = b;
        __syncthreads();
        float off = 0.f;
        if (seg > 0) off += tot[k]; if (seg > 1) off += tot[128 + k]; if (seg > 2) off += tot[256 + k];
#pragma unroll 4
        for (int s = 16 * seg; s < 16 * seg + 16; ++s) kd[s * 128 + k] += off;
        if (seg == 3) { const float bt_ = b + off; bl[k] = bt_; ((float*)(opaque_ptr(P.ws) + WS_DVEC))[(size_t)unit * 128 + k] = __expf(bt_); }
    }
    __syncthreads();
#pragma unroll
    for (int i = 0; i < 16; ++i) { const int e = tid + 512 * i, k = e & 127, s = e >> 7; kdT[k * 72 + s] = (bf16_t)f2bf(kg[e] * __expf(bl[k] - kd[e])); }
    __syncthreads();
    {
        const int lane = tid & 63, w = __builtin_amdgcn_readfirstlane(tid >> 6), lr = lane & 15, kgp = lane >> 4;
        const bf16x8 B0 = *(const bf16x8*)(vT + (16 * w + lr) * 72 + 8 * kgp), B1 = *(const bf16x8*)(vT + (16 * w + lr) * 72 + 32 + 8 * kgp);
        bf16_t* DS = (bf16_t*)(opaque_ptr(P.ws) + WS_DS) + (size_t)unit * 16384;
#pragma unroll
        for (int kt_ = 0; kt_ < 8; ++kt_) {
            const bf16x8 A0 = *(const bf16x8*)(kdT + (16 * kt_ + lr) * 72 + 8 * kgp), A1 = *(const bf16x8*)(kdT + (16 * kt_ + lr) * 72 + 32 + 8 * kgp);
            f32x4 a4 = (f32x4){0.f, 0.f, 0.f, 0.f};
            a4 = __builtin_amdgcn_mfma_f32_16x16x32_bf16(A0, B0, a4, 0, 0, 0);
            a4 = __builtin_amdgcn_mfma_f32_16x16x32_bf16(A1, B1, a4, 0, 0, 0);
            *(v2u*)(DS + (16 * w + lr) * 128 + 16 * kt_ + 4 * kgp) = (v2u){pk2(a4[0], a4[1]), pk2(a4[2], a4[3])};
        }
    }
}
__device__ __forceinline__ void hgrn_b(const Params& P, unsigned char* lds) {
    const int tid = opaque_tid(), el = tid & 127, qtr = __builtin_amdgcn_readfirstlane(tid >> 7);
    float* xd = (float*)lds;
    float* xs = xd + 512;
    for (int it = blockIdx.x; it < 512; it += gridDim.x) {
        const int h = it >> 7, kvb = (it & 127) * 128;
        bf16_t* dsb = (bf16_t*)(opaque_ptr(P.ws) + WS_DS) + ((size_t)(64 * qtr) * 4 + h) * 16384 + kvb;
        const float* dvb = (const float*)(opaque_ptr(P.ws) + WS_DVEC) + ((size_t)(64 * qtr) * 4 + h) * 128;
        float ds[64], dv[64];
#pragma unroll
        for (int i = 0; i < 64; ++i) { ds[i] = bf1(dsb[(size_t)i * 65536 + el]); dv[i] = dvb[(size_t)i * 512 + el]; }
        float D = 1.f, S = 0.f;
#pragma unroll
        for (int i = 0; i < 64; ++i) { S = dv[i] * S + ds[i]; D *= dv[i]; }
        __syncthreads();
        xd[qtr * 128 + el] = D; xs[qtr * 128 + el] = S;
        __syncthreads();
        S = 0.f;
        for (int j = 0; j < qtr; ++j) S = xd[j * 128 + el] * S + xs[j * 128 + el];
#pragma unroll
        for (int i = 0; i < 64; ++i) { dsb[(size_t)i * 65536 + el] = (bf16_t)f2bf(S); S = dv[i] * S + ds[i]; }
    }
}
__device__ __forceinline__ void hgrn_c_unit(const Params& P, int l, int unit, unsigned char* lds) {
    const int tid = opaque_tid();
    const int c = unit >> 2, h = unit & 3, t0 = c * 64;
    const bf16_t* P2 = (const bf16_t*)(opaque_ptr(P.ws) + WS_P2);
    const float* LB = (const float*)(opaque_ptr(P.ws) + WS_LB) + l * 512 + h * 128;
    constexpr int RS = 132;
    float* qs = (float*)lds;
    float* bs = (float*)(lds + 33792);
    float* ks = (float*)(lds + 67584);
    float* kt = (float*)(lds + 101376);
    float* at = (float*)(lds + 135168);
    float* bl = (float*)(lds + 152576);
    __syncthreads();
#pragma unroll
    for (int i = 0; i < 9; ++i) { const int e = tid + 512 * i; if (e < 64 * 68) at[e] = 0.f; }
#pragma unroll
    for (int i = 0; i < 8; ++i) {
        const int e = tid + 512 * i, s = e >> 6, k2 = (e & 63) * 2;
        const unsigned qw = *(const unsigned*)(P2 + (size_t)(t0 + s) * NP2 + C2_HQ + h * 128 + k2);
        const unsigned fw = *(const unsigned*)(P2 + (size_t)(t0 + s) * NP2 + C2_HF + h * 128 + k2);
        const float lb0 = LB[k2], lb1 = LB[k2 + 1];
        const float z0 = bflo(fw), z1 = bfhi(fw), q0 = bflo(qw), q1 = bfhi(qw);
        const float f0 = lb0 + (1.f - lb0) * sigm(z0), f1 = lb1 + (1.f - lb1) * sigm(z1);
        bs[s * RS + k2] = __logf(fmaxf(f0, 1e-6f)) * LOG2E; bs[s * RS + k2 + 1] = __logf(fmaxf(f1, 1e-6f)) * LOG2E;
        ks[s * RS + k2] = (1.f - lb0) * sigm(-z0); ks[s * RS + k2 + 1] = (1.f - lb1) * sigm(-z1);
        qs[s * RS + k2] = q0 * sigm(q0); qs[s * RS + k2 + 1] = q1 * sigm(q1);
    }
    __syncthreads();
    {
        float* tot = bl + 1024;
        const int k = tid & 127, seg = tid >> 7; float b = 0.f;
#pragma unroll 4
        for (int s = 16 * seg; s < 16 * seg + 16; ++s) { b += bs[s * RS + k]; bs[s * RS + k] = b; }
        tot[seg * 128 + k] = b;
        __syncthreads();
        float off = 0.f;
        if (seg > 0) off += tot[k]; if (seg > 1) off += tot[128 + k]; if (seg > 2) off += tot[256 + k];
#pragma unroll 4
        for (int s = 16 * seg; s < 16 * seg + 16; ++s) { const float v_ = bs[s * RS + k] + off; bs[s * RS + k] = v_; if ((s & 7) == 7) bl[(s >> 3) * 128 + k] = v_; }
    }
    __syncthreads();
    {
        bf16_t* k16 = (bf16_t*)kt;
#pragma unroll 1
        for (int pass = 0; pass < 2; ++pass) {
            const int p = tid + 512 * pass;
            if (p < 544) {
                int t, s;
                if (p < 288) { const int blk = p / 36, idx = p - 36 * blk; int tl = 0; while (((tl + 1) * (tl + 2) >> 1) <= idx) ++tl; t = 8 * blk + tl; s = 8 * blk + idx - (tl * (tl + 1) >> 1); }
                else { const int q_ = p - 288, m = q_ >> 6; t = 16 * m + 8 + ((q_ >> 3) & 7); s = 16 * m + (q_ & 7); }
                float a = 0.f;
                for (int k4 = 0; k4 < 128; k4 += 4) {
                    const f32x4 q4 = *(const f32x4*)(qs + t * RS + k4), bt = *(const f32x4*)(bs + t * RS + k4), k4v = *(const f32x4*)(ks + s * RS + k4), b4 = *(const f32x4*)(bs + s * RS + k4);
                    a += (q4[0] * k4v[0] * __builtin_amdgcn_exp2f(bt[0] - b4[0]) + q4[1] * k4v[1] * __builtin_amdgcn_exp2f(bt[1] - b4[1]))
                       + (q4[2] * k4v[2] * __builtin_amdgcn_exp2f(bt[2] - b4[2]) + q4[3] * k4v[3] * __builtin_amdgcn_exp2f(bt[3] - b4[3])); }
                at[t * 68 + s] = a;
            }
        }
#pragma unroll
        for (int i = 0; i < 4; ++i) { const int e = tid + 512 * i, s = e >> 5, k4 = (e & 31) * 4;
            const f32x4 kg4 = *(const f32x4*)(ks + s * RS + k4), b4 = *(const f32x4*)(bs + s * RS + k4), bj = *(const f32x4*)(bl + (2 * (s >> 4) + 1) * 128 + k4);
            *(v2u*)(k16 + s * 136 + k4) = (v2u){pk2(kg4[0] * __builtin_amdgcn_exp2f(bj[0] - b4[0]), kg4[1] * __builtin_amdgcn_exp2f(bj[1] - b4[1])),
                                               pk2(kg4[2] * __builtin_amdgcn_exp2f(bj[2] - b4[2]), kg4[3] * __builtin_amdgcn_exp2f(bj[3] - b4[3]))}; }
        __syncthreads();
        {
            const int lane = tid & 63, w = __builtin_amdgcn_readfirstlane(tid >> 6), lr = lane & 15, kgp = lane >> 4;
            if (w < 6) {
                const int m = (w == 0) ? 1 : (w < 3 ? 2 : 3), n = (w == 0) ? 0 : (w < 3 ? w - 1 : w - 3);
                const int trow = 16 * m + lr, srow = 16 * n + lr;
                f32x4 a4 = (f32x4){0.f, 0.f, 0.f, 0.f};
#pragma unroll
                for (int kstep = 0; kstep < 4; ++kstep) {
                    const int k0 = 32 * kstep + 8 * kgp;
                    const f32x4 q0 = *(const f32x4*)(qs + trow * RS + k0), q1 = *(const f32x4*)(qs + trow * RS + k0 + 4);
                    const f32x4 t0_ = *(const f32x4*)(bs + trow * RS + k0), t1_ = *(const f32x4*)(bs + trow * RS + k0 + 4);
                    const f32x4 j0 = *(const f32x4*)(bl + (2 * n + 1) * 128 + k0), j1 = *(const f32x4*)(bl + (2 * n + 1) * 128 + k0 + 4);
                    const bf16x8 A = __builtin_bit_cast(bf16x8, ((v4u){
                        pk2(q0[0] * __builtin_amdgcn_exp2f(t0_[0] - j0[0]), q0[1] * __builtin_amdgcn_exp2f(t0_[1] - j0[1])), pk2(q0[2] * __builtin_amdgcn_exp2f(t0_[2] - j0[2]), q0[3] * __builtin_amdgcn_exp2f(t0_[3] - j0[3])),
                        pk2(q1[0] * __builtin_amdgcn_exp2f(t1_[0] - j1[0]), q1[1] * __builtin_amdgcn_exp2f(t1_[1] - j1[1])), pk2(q1[2] * __builtin_amdgcn_exp2f(t1_[2] - j1[2]), q1[3] * __builtin_amdgcn_exp2f(t1_[3] - j1[3]))}));
                    const bf16x8 B = *(const bf16x8*)(k16 + srow * 136 + k0);
                    a4 = __builtin_amdgcn_mfma_f32_16x16x32_bf16(A, B, a4, 0, 0, 0);
                }
#pragma unroll
                for (int r = 0; r < 4; ++r) at[(16 * m + 4 * kgp + r) * 68 + 16 * n + lr] = a4[r];
            }
        }
    }
    __syncthreads();
#pragma unroll
    for (int i = 0; i < 16; ++i) { const int e = tid + 512 * i, s = e >> 7, k = e & 127; qs[s * RS + k] *= __builtin_amdgcn_exp2f(bs[s * RS + k]); }
    __syncthreads();
    bf16_t* S0T = (bf16_t*)(lds + 33792);
    bf16_t* vT = (bf16_t*)(lds + 68608);
    float* os = kt;
    {
        const bf16_t* DS = (const bf16_t*)(opaque_ptr(P.ws) + WS_DS) + (size_t)unit * 16384;
#pragma unroll
        for (int i = 0; i < 4; ++i) { const int e = tid + 512 * i, v = e >> 4, c8 = (e & 15) * 8; *(v4u*)(S0T + v * 136 + c8) = *(const v4u*)(DS + v * 128 + c8); }
#pragma unroll
        for (int i = 0; i < 8; ++i) { const int e = tid + 512 * i, s = e >> 6, k2 = (e & 63) * 2;
            const unsigned iw = *(const unsigned*)(P2 + (size_t)(t0 + s) * NP2 + C2_HI + h * 128 + k2);
            vT[k2 * 72 + s] = (bf16_t)(iw & 0xffffu); vT[(k2 + 1) * 72 + s] = (bf16_t)(iw >> 16); }
    }
    __syncthreads();
    {
        const int lane = tid & 63, w = __builtin_amdgcn_readfirstlane(tid >> 6), tb = w & 3, vh = w >> 2, lr = lane & 15, kg = lane >> 4;
        const int trow = 16 * tb + lr;
        f32x4 acc4[4];
#pragma unroll
        for (int n = 0; n < 4; ++n) acc4[n] = (f32x4){0.f, 0.f, 0.f, 0.f};
#pragma unroll
        for (int kstep = 0; kstep < 6; ++kstep) {
            const float* src = (kstep < 2) ? (at + trow * 68 + 32 * kstep + 8 * kg) : (qs + trow * RS + 32 * (kstep - 2) + 8 * kg);
            const f32x4 x0 = *(const f32x4*)src, x1 = *(const f32x4*)(src + 4);
            const bf16x8 A = __builtin_bit_cast(bf16x8, ((v4u){pk2(x0[0], x0[1]), pk2(x0[2], x0[3]), pk2(x1[0], x1[1]), pk2(x1[2], x1[3])}));
#pragma unroll
            for (int n = 0; n < 4; ++n) { const int col = 64 * vh + 16 * n + lr;
                const bf16x8 B = (kstep < 2) ? *(const bf16x8*)(vT + col * 72 + 32 * kstep + 8 * kg) : *(const bf16x8*)(S0T + col * 136 + 32 * (kstep - 2) + 8 * kg);
                acc4[n] = __builtin_amdgcn_mfma_f32_16x16x32_bf16(A, B, acc4[n], 0, 0, 0); }
        }
#pragma unroll
        for (int n = 0; n < 4; ++n)
#pragma unroll
            for (int r = 0; r < 4; ++r) os[(16 * tb + 4 * kg + r) * RS + 64 * vh + 16 * n + lr] = acc4[n][r];
    }
    __syncthreads();
    {
        const int t = tid >> 3, vg = tid & 7;
        float o[16];
#pragma unroll
        for (int j = 0; j < 4; ++j) { const f32x4 o4 = *(const f32x4*)(os + t * RS + vg * 16 + 4 * j); o[4 * j] = o4[0]; o[4 * j + 1] = o4[1]; o[4 * j + 2] = o4[2]; o[4 * j + 3] = o4[3]; }
        float ss = 0.f;
#pragma unroll
        for (int j = 0; j < 16; ++j) ss += o[j] * o[j];
        ss += __shfl_xor(ss, 1); ss += __shfl_xor(ss, 2); ss += __shfl_xor(ss, 4);
        const float rinv = rsqrtf(ss * (1.f / 128.f) + NORM_EPS);
        const float* ng = GPF(P.in[32]) + (size_t)l * 128 + vg * 16;
        const bf16_t* cg = P2 + (size_t)(t0 + t) * NP2 + C2_HG + h * 128 + vg * 16;
        const v4u g0 = *(const v4u*)cg, g1 = *(const v4u*)(cg + 8);
        float g[16]; unpack8(g0, g); unpack8(g1, g + 8);
        float r[16];
#pragma unroll
        for (int j = 0; j < 16; ++j) r[j] = o[j] * rinv * ng[j] * (g[j] * sigm(g[j]));
        bf16_t* yc = (bf16_t*)(opaque_ptr(P.ws) + WS_YC) + (size_t)(t0 + t) * 512 + h * 128 + vg * 16;
        *(v4u*)yc = pack8(r); *(v4u*)(yc + 8) = pack8(r + 8);
    }
}
__device__ __forceinline__ void phase_prep2(const Params& P, int l) {
    PHASE_IDS;
    unsigned char* ws = opaque_ptr(P.ws);
    bf16_t* LORA = (bf16_t*)(ws + WS_LORA); bf16_t* KB = (bf16_t*)(ws + WS_KB); bf16_t* VB = (bf16_t*)(ws + WS_VB); const bf16_t* VF = (const bf16_t*)(ws + WS_VFIRST);
    bf16_t* Q = (bf16_t*)(ws + WS_Q);
    const float* COS = (const float*)(ws + WS_COS); const float* SIN = (const float*)(ws + WS_SIN);
    const int ch = lane * 8;
    float w0[8], a0[8], kkw[8], kaw[8], v0[8];
#pragma unroll
    for (int e = 0; e < 8; ++e) {
        w0[e] = (GPF(P.in[11]))[l * 512 + ch + e]; a0[e] = (GPF(P.in[13]))[l * 512 + ch + e];
        kkw[e] = (GPF(P.in[16]))[l * 512 + ch + e]; kaw[e] = (GPF(P.in[17]))[l * 512 + ch + e];
        v0[e] = (l > 0) ? (GPF(P.in[24]))[(l - 1) * 512 + ch + e] : 0.f;
    }
    for (int t = gw; t < T; t += ngw) {
        bf16_t* lr = LORA + (size_t)t * 2048 + ch;
        float lw[8], la[8], lv[8], k[8];
        unpack8(*(const v4u*)lr, lw); unpack8(*(const v4u*)(lr + 512), la); unpack8(*(const v4u*)(lr + 1536), lv);
        unpack8(*(const v4u*)(KB + (size_t)t * 512 + ch), k);
        float ew[8], kk[8], bb[8], km[8]; float ss = 0.f;
#pragma unroll
        for (int e = 0; e < 8; ++e) {
            const float x = -(w0[e] + lw[e]);
            const float sp = fmaxf(x, 0.f) + __logf(1.f + __expf(-fabsf(x)));
            ew[e] = __expf(-sp - 0.5f);
            kk[e] = k[e] * kkw[e]; ss += kk[e] * kk[e];
        }
        ss += __shfl_xor(ss, 1); ss += __shfl_xor(ss, 2); ss += __shfl_xor(ss, 4);
        const float kinv = 1.f / fmaxf(sqrtf(ss), 1e-12f);
#pragma unroll
        for (int e = 0; e < 8; ++e) {
            const float a = sigm(a0[e] + la[e]);
            kk[e] *= kinv; bb[e] = kk[e] * a; km[e] = k[e] * (1.f + (a - 1.f) * kaw[e]);
        }
        *(v4u*)lr = pack8(ew); *(v4u*)(lr + 512) = pack8(kk); *(v4u*)(lr + 1536) = pack8(bb);
        *(v4u*)(KB + (size_t)t * 512 + ch) = pack8(km);
        if (l > 0) {
            float v[8], vf[8];
            unpack8(*(const v4u*)(VB + (size_t)t * 512 + ch), v); unpack8(*(const v4u*)(VF + (size_t)t * 512 + ch), vf);
#pragma unroll
            for (int e = 0; e < 8; ++e) v[e] = v[e] + (vf[e] - v[e]) * sigm(v0[e] + lv[e]);
            *(v4u*)(VB + (size_t)t * 512 + ch) = pack8(v);
        }
        {
            const int h = lane >> 3, sub = lane & 7;
            bf16_t* qh = Q + (size_t)t * 768 + h * 96;
            float qn[8]; unpack8(*(const v4u*)(qh + 8 * sub), qn);
#pragma unroll
            for (int e = 0; e < 8; ++e) qn[e] *= QSCALE;
            const unsigned x1w = *(const unsigned*)(qh + 64 + 2 * sub), x2w = *(const unsigned*)(qh + 80 + 2 * sub);
            const float c0 = COS[t * 16 + 2 * sub], c1 = COS[t * 16 + 2 * sub + 1], s0 = SIN[t * 16 + 2 * sub], s1 = SIN[t * 16 + 2 * sub + 1];
            const float x10 = bflo(x1w), x11 = bfhi(x1w), x20 = bflo(x2w), x21 = bfhi(x2w);
            *(v4u*)(qh + 8 * sub) = pack8(qn);
            *(unsigned*)(qh + 64 + 2 * sub) = pk2((x10 * c0 - x20 * s0) * QSCALE, (x11 * c1 - x21 * s1) * QSCALE);
            *(unsigned*)(qh + 80 + 2 * sub) = pk2((x20 * c0 + x10 * s0) * QSCALE, (x21 * c1 + x11 * s1) * QSCALE);
        }
    }
}

constexpr int RW_NC = 32, RW_LC = T / RW_NC;
typedef float f2v __attribute__((ext_vector_type(2)));
#define LO2(v4) (__builtin_shufflevector((v4), (v4), 0, 1))
#define HI2(v4) (__builtin_shufflevector((v4), (v4), 2, 3))
__device__ __forceinline__ float red8(float x) { x += dppf<0xB1>(x); x += dppf<0x4E>(x); x += dppf<0x141>(x); return x; }
template <int MODE>
__device__ __forceinline__ void rwkv_scan_item(const Params& P, int l, unsigned char* lds, int h, int t0, int nchunk, const float* init, float* fin) {
    const int tid = opaque_tid(), lane = tid & 63, wave = tid >> 6, rowgrp = lane >> 3, kq = lane & 7;
    const int row = wave * 8 + rowgrp;
    unsigned char* ws = opaque_ptr(P.ws);
    const bf16_t* LORA = (const bf16_t*)(ws + WS_LORA); const bf16_t* KB = (const bf16_t*)(ws + WS_KB); const bf16_t* RB = (const bf16_t*)(ws + WS_RB); const bf16_t* VB = (const bf16_t*)(ws + WS_VB);
    bf16_t* YA = (bf16_t*)(ws + WS_YA);
    constexpr int BUF = 49152;
    float* ybuf = (float*)(lds + 2 * BUF);
    const bf16_t* src[3]; int dsto[3], sstride[3];
    const int hi8 = tid >> 8, q = tid & 255, st = q >> 3, c8 = q & 7;
    {
        const int a0 = hi8, a1 = 2 + hi8, a2 = 4 + hi8;
        src[0] = (a0 == 0 ? LORA : LORA + 512) + (size_t)st * 2048 + h * 64 + c8 * 8; sstride[0] = 2048; dsto[0] = (a0 * 2048 + st * 64 + c8 * 8) * 4;
        src[1] = (a1 == 2 ? LORA + 1536 + (size_t)st * 2048 : KB + (size_t)st * 512) + h * 64 + c8 * 8; sstride[1] = (a1 == 2) ? 2048 : 512; dsto[1] = (a1 * 2048 + st * 64 + c8 * 8) * 4;
        src[2] = (a2 == 4 ? RB : VB) + (size_t)st * 512 + h * 64 + c8 * 8; sstride[2] = 512; dsto[2] = (a2 * 2048 + st * 64 + c8 * 8) * 4;
    }
    const bool ld2 = !(MODE == 2 && hi8 == 1);
    f2v S2[4];
    if (MODE == 2) {
#pragma unroll
        for (int j = 0; j < 4; ++j) S2[j] = (f2v){(8 * kq + 2 * j == row) ? 1.f : 0.f, (8 * kq + 2 * j + 1 == row) ? 1.f : 0.f};
    } else if (MODE == 0 && init != nullptr) {
        const f32x4 i0 = *(const f32x4*)(init + row * 64 + 8 * kq), i1 = *(const f32x4*)(init + row * 64 + 8 * kq + 4);
        S2[0] = LO2(i0); S2[1] = HI2(i0); S2[2] = LO2(i1); S2[3] = HI2(i1);
    } else {
#pragma unroll
        for (int j = 0; j < 4; ++j) S2[j] = (f2v){0.f, 0.f};
    }
    const int fs = tid >> 4, fv = (tid & 15) * 4;
    f32x4 rk4 = {0.f, 0.f, 0.f, 0.f}, gg4 = rk4, gb4 = rk4;
    if (MODE == 0) { rk4 = *(const f32x4*)(GPF(P.in[18]) + l * 512 + h * 64 + fv); gg4 = *(const f32x4*)(GPF(P.in[19]) + l * 512 + h * 64 + fv); gb4 = *(const f32x4*)(GPF(P.in[20]) + l * 512 + h * 64 + fv); }
    v4u regs[3];
#define RW_LOAD(tt) do { regs[0] = *(const v4u*)(src[0] + (size_t)(tt) * sstride[0]); regs[1] = *(const v4u*)(src[1] + (size_t)(tt) * sstride[1]); if (ld2) regs[2] = *(const v4u*)(src[2] + (size_t)(tt) * sstride[2]); } while (0)
#define RW_STORE(bufp) do { \
        { float f[8]; unpack8(regs[0], f); if (hi8 == 0) { _Pragma("unroll") for (int e = 0; e < 8; ++e) f[e] = __expf(-f[e]); } else { _Pragma("unroll") for (int e = 0; e < 8; ++e) f[e] = -f[e]; } \
          float* d = (float*)((bufp) + dsto[0]); *(f32x4*)d = (f32x4){f[0], f[1], f[2], f[3]}; *(f32x4*)(d + 4) = (f32x4){f[4], f[5], f[6], f[7]}; } \
        { float f[8]; unpack8(regs[1], f); float* d = (float*)((bufp) + dsto[1]); *(f32x4*)d = (f32x4){f[0], f[1], f[2], f[3]}; *(f32x4*)(d + 4) = (f32x4){f[4], f[5], f[6], f[7]}; } \
        if (ld2) { float f[8]; unpack8(regs[2], f); float* d = (float*)((bufp) + dsto[2]); *(f32x4*)d = (f32x4){f[0], f[1], f[2], f[3]}; *(f32x4*)(d + 4) = (f32x4){f[4], f[5], f[6], f[7]}; } } while (0)
    __syncthreads();
    RW_LOAD(t0);
    RW_STORE(lds);
    __syncthreads();
    for (int c = 0; c < nchunk; ++c) {
        const int tc = t0 + 32 * c;
        const bool more = (c + 1 < nchunk);
        if (more) RW_LOAD(tc + 32);
        const float* buf = (const float*)(lds + (c & 1) * BUF);
#pragma unroll 2
        for (int s = 0; s < 32; ++s) {
            const float* bs_ = buf + s * 64 + 8 * kq;
            const f32x4 nk0 = *(const f32x4*)(bs_ + 2048), nk1 = *(const f32x4*)(bs_ + 2048 + 4);
            f2v p = S2[0] * LO2(nk0); p = S2[1] * HI2(nk0) + p; p = S2[2] * LO2(nk1) + p; p = S2[3] * HI2(nk1) + p;
            float sa = p.x + p.y;
            const f32x4 dw0 = *(const f32x4*)(bs_), dw1 = *(const f32x4*)(bs_ + 4);
            const f32x4 bb0 = *(const f32x4*)(bs_ + 4096), bb1 = *(const f32x4*)(bs_ + 4096 + 4);
            f2v tq[4];
            if (MODE == 2) { tq[0] = S2[0] * LO2(dw0); tq[1] = S2[1] * HI2(dw0); tq[2] = S2[2] * LO2(dw1); tq[3] = S2[3] * HI2(dw1); }
            else {
                const f32x4 kv0 = *(const f32x4*)(bs_ + 6144), kv1 = *(const f32x4*)(bs_ + 6144 + 4);
                const float vv = buf[10240 + s * 64 + row]; const f2v vv2 = {vv, vv};
                tq[0] = S2[0] * LO2(dw0) + vv2 * LO2(kv0); tq[1] = S2[1] * HI2(dw0) + vv2 * HI2(kv0); tq[2] = S2[2] * LO2(dw1) + vv2 * LO2(kv1); tq[3] = S2[3] * HI2(dw1) + vv2 * HI2(kv1);
            }
            sa = red8(sa);
            const f2v sa2 = {sa, sa};
            S2[0] = sa2 * LO2(bb0) + tq[0]; S2[1] = sa2 * HI2(bb0) + tq[1]; S2[2] = sa2 * LO2(bb1) + tq[2]; S2[3] = sa2 * HI2(bb1) + tq[3];
            if (MODE == 0) {
                const f32x4 rv0 = *(const f32x4*)(bs_ + 8192), rv1 = *(const f32x4*)(bs_ + 8192 + 4);
                f2v py = S2[0] * LO2(rv0); py = S2[1] * HI2(rv0) + py; py = S2[2] * LO2(rv1) + py; py = S2[3] * HI2(rv1) + py;
                float y = py.x + py.y;
                y = red8(y);
                if (kq == 0) ybuf[s * 64 + row] = y;
            }
        }
        if (more) RW_STORE(lds + ((c + 1) & 1) * BUF);
        __syncthreads();
        if (MODE == 0) {
            const f32x4 y4 = *(const f32x4*)(ybuf + fs * 64 + fv);
            const f32x4 r4 = *(const f32x4*)(buf + 8192 + fs * 64 + fv), k4 = *(const f32x4*)(buf + 6144 + fs * 64 + fv), v4 = *(const f32x4*)(buf + 10240 + fs * 64 + fv);
            const v2u gw_ = *(const v2u*)(LORA + (size_t)(tc + fs) * 2048 + 1024 + h * 64 + fv);
            float sm = (y4[0] + y4[1]) + (y4[2] + y4[3]);
            float bsum = (r4[0] * k4[0] * rk4[0] + r4[1] * k4[1] * rk4[1]) + (r4[2] * k4[2] * rk4[2] + r4[3] * k4[3] * rk4[3]);
            sm = red16(sm); bsum = red16(bsum);
            const float mean = sm * (1.f / 64.f);
            const f32x4 d4 = y4 - mean;
            float qv = (d4[0] * d4[0] + d4[1] * d4[1]) + (d4[2] * d4[2] + d4[3] * d4[3]);
            qv = red16(qv);
            const float rstd = rsqrtf(qv * (1.f / 64.f) + 64e-5f);
            const f32x4 o4 = d4 * rstd * gg4 + gb4 + v4 * bsum;
            *(v2u*)(YA + (size_t)(tc + fs) * 512 + h * 64 + fv) = (v2u){pk2(o4[0] * bflo(gw_.x), o4[1] * bfhi(gw_.x)), pk2(o4[2] * bflo(gw_.y), o4[3] * bfhi(gw_.y))};
            __syncthreads();
        }
    }
#undef RW_LOAD
#undef RW_STORE
    if (MODE != 0) { *(f32x4*)(fin + row * 64 + 8 * kq) = (f32x4){S2[0].x, S2[0].y, S2[1].x, S2[1].y}; *(f32x4*)(fin + row * 64 + 8 * kq + 4) = (f32x4){S2[2].x, S2[2].y, S2[3].x, S2[3].y}; }
}
__device__ __forceinline__ void rwkv_scan_pu(const Params& P, unsigned char* lds, int h, int t0, int nchunk, float* finP, float* finU) {
    const int tid = opaque_tid(), lane = tid & 63, wave = tid >> 6, rowgrp = lane >> 3, kq = lane & 7;
    const int row = wave * 8 + rowgrp;
    unsigned char* ws = opaque_ptr(P.ws);
    const bf16_t* LORA = (const bf16_t*)(ws + WS_LORA); const bf16_t* KB = (const bf16_t*)(ws + WS_KB); const bf16_t* VB = (const bf16_t*)(ws + WS_VB);
    constexpr int BUF = 49152;
    const bf16_t* src[3]; int dsto[3], sstride[3];
    const int hi8 = tid >> 8, q = tid & 255, st = q >> 3, c8 = q & 7;
    src[0] = (hi8 == 0 ? LORA : LORA + 512) + (size_t)st * 2048 + h * 64 + c8 * 8; sstride[0] = 2048; dsto[0] = (hi8 * 2048 + st * 64 + c8 * 8) * 4;
    src[1] = (hi8 == 0 ? LORA + 1536 + (size_t)st * 2048 : KB + (size_t)st * 512) + h * 64 + c8 * 8; sstride[1] = (hi8 == 0) ? 2048 : 512; dsto[1] = ((2 + hi8) * 2048 + st * 64 + c8 * 8) * 4;
    src[2] = VB + (size_t)st * 512 + h * 64 + c8 * 8; sstride[2] = 512; dsto[2] = (5 * 2048 + st * 64 + c8 * 8) * 4;
    const bool ld2 = hi8 == 1;
    f2v SP2[4], SU2[4];
#pragma unroll
    for (int j = 0; j < 4; ++j) { SP2[j] = (f2v){(8 * kq + 2 * j == row) ? 1.f : 0.f, (8 * kq + 2 * j + 1 == row) ? 1.f : 0.f}; SU2[j] = (f2v){0.f, 0.f}; }
    v4u regs[3];
#define PU_LOAD(tt) do { regs[0] = *(const v4u*)(src[0] + (size_t)(tt) * sstride[0]); regs[1] = *(const v4u*)(src[1] + (size_t)(tt) * sstride[1]); if (ld2) regs[2] = *(const v4u*)(src[2] + (size_t)(tt) * sstride[2]); } while (0)
#define PU_STORE(bufp) do { \
        { float f[8]; unpack8(regs[0], f); if (hi8 == 0) { _Pragma("unroll") for (int e = 0; e < 8; ++e) f[e] = __expf(-f[e]); } else { _Pragma("unroll") for (int e = 0; e < 8; ++e) f[e] = -f[e]; } \
          float* d = (float*)((bufp) + dsto[0]); *(f32x4*)d = (f32x4){f[0], f[1], f[2], f[3]}; *(f32x4*)(d + 4) = (f32x4){f[4], f[5], f[6], f[7]}; } \
        { float f[8]; unpack8(regs[1], f); float* d = (float*)((bufp) + dsto[1]); *(f32x4*)d = (f32x4){f[0], f[1], f[2], f[3]}; *(f32x4*)(d + 4) = (f32x4){f[4], f[5], f[6], f[7]}; } \
        if (ld2) { float f[8]; unpack8(regs[2], f); float* d = (float*)((bufp) + dsto[2]); *(f32x4*)d = (f32x4){f[0], f[1], f[2], f[3]}; *(f32x4*)(d + 4) = (f32x4){f[4], f[5], f[6], f[7]}; } } while (0)
    __syncthreads();
    PU_LOAD(t0);
    PU_STORE(lds);
    __syncthreads();
    for (int c = 0; c < nchunk; ++c) {
        const int tc = t0 + 32 * c;
        const bool more = (c + 1 < nchunk);
        if (more) PU_LOAD(tc + 32);
        const float* buf = (const float*)(lds + (c & 1) * BUF);
#pragma unroll 2
        for (int s = 0; s < 32; ++s) {
            const float* bs_ = buf + s * 64 + 8 * kq;
            const f32x4 nk0 = *(const f32x4*)(bs_ + 2048), nk1 = *(const f32x4*)(bs_ + 2048 + 4);
            f2v pP = SP2[0] * LO2(nk0); pP = SP2[1] * HI2(nk0) + pP; pP = SP2[2] * LO2(nk1) + pP; pP = SP2[3] * HI2(nk1) + pP;
            f2v pU = SU2[0] * LO2(nk0); pU = SU2[1] * HI2(nk0) + pU; pU = SU2[2] * LO2(nk1) + pU; pU = SU2[3] * HI2(nk1) + pU;
            float saP = pP.x + pP.y, saU = pU.x + pU.y;
            const f32x4 dw0 = *(const f32x4*)(bs_), dw1 = *(const f32x4*)(bs_ + 4);
            const f32x4 bb0 = *(const f32x4*)(bs_ + 4096), bb1 = *(const f32x4*)(bs_ + 4096 + 4);
            const f32x4 kv0 = *(const f32x4*)(bs_ + 6144), kv1 = *(const f32x4*)(bs_ + 6144 + 4);
            const float vv = buf[10240 + s * 64 + row]; const f2v vv2 = {vv, vv};
            f2v tp[4], tu[4];
            tp[0] = SP2[0] * LO2(dw0); tp[1] = SP2[1] * HI2(dw0); tp[2] = SP2[2] * LO2(dw1); tp[3] = SP2[3] * HI2(dw1);
            tu[0] = SU2[0] * LO2(dw0) + vv2 * LO2(kv0); tu[1] = SU2[1] * HI2(dw0) + vv2 * HI2(kv0); tu[2] = SU2[2] * LO2(dw1) + vv2 * LO2(kv1); tu[3] = SU2[3] * HI2(dw1) + vv2 * HI2(kv1);
            saP += dppf<0xB1>(saP); saU += dppf<0xB1>(saU);
            saP += dppf<0x4E>(saP); saU += dppf<0x4E>(saU);
            saP += dppf<0x141>(saP); saU += dppf<0x141>(saU);
            const f2v sP2 = {saP, saP}, sU2 = {saU, saU};
            SP2[0] = sP2 * LO2(bb0) + tp[0]; SP2[1] = sP2 * HI2(bb0) + tp[1]; SP2[2] = sP2 * LO2(bb1) + tp[2]; SP2[3] = sP2 * HI2(bb1) + tp[3];
            SU2[0] = sU2 * LO2(bb0) + tu[0]; SU2[1] = sU2 * HI2(bb0) + tu[1]; SU2[2] = sU2 * LO2(bb1) + tu[2]; SU2[3] = sU2 * HI2(bb1) + tu[3];
        }
        if (more) PU_STORE(lds + ((c + 1) & 1) * BUF);
        __syncthreads();
    }
#undef PU_LOAD
#undef PU_STORE
    if (finP != nullptr) { *(f32x4*)(finP + row * 64 + 8 * kq) = (f32x4){SP2[0].x, SP2[0].y, SP2[1].x, SP2[1].y}; *(f32x4*)(finP + row * 64 + 8 * kq + 4) = (f32x4){SP2[2].x, SP2[2].y, SP2[3].x, SP2[3].y}; }
    *(f32x4*)(finU + row * 64 + 8 * kq) = (f32x4){SU2[0].x, SU2[0].y, SU2[1].x, SU2[1].y}; *(f32x4*)(finU + row * 64 + 8 * kq + 4) = (f32x4){SU2[2].x, SU2[2].y, SU2[3].x, SU2[3].y};
}
__device__ __forceinline__ void rwkv_pass2(const Params& P, unsigned char* lds, int h, int part) {
    const int tid = opaque_tid(), vl = tid >> 5, v = part * 16 + vl, kq = tid & 31;
    const float* PU = (const float*)(opaque_ptr(P.ws) + WS_PU) + (size_t)h * RW_NC * 8192;
    float* SI = (float*)(opaque_ptr(P.ws) + WS_SINIT) + (size_t)h * RW_NC * 4096;
    typedef float f32x2 __attribute__((ext_vector_type(2)));
    float* Ss = (float*)lds;
    float* Pl = (float*)(lds + 4352);
    const int pr = tid >> 3, pc = (tid & 7) * 8;
    __syncthreads();
    f32x2 a = *(const f32x2*)(PU + 4096 + v * 64 + 2 * kq);
    f32x4 p0, p1; f32x2 u;
    { const float* pcur = PU + (size_t)8192; p0 = *(const f32x4*)(pcur + pr * 64 + pc); p1 = *(const f32x4*)(pcur + pr * 64 + pc + 4); u = *(const f32x2*)(pcur + 4096 + v * 64 + 2 * kq); }
    for (int c = 1; c < RW_NC; ++c) {
        *(f32x2*)(SI + (size_t)c * 4096 + v * 64 + 2 * kq) = a;
        if (c + 1 == RW_NC) break;
        Ss[vl * 65 + 2 * kq] = a[0]; Ss[vl * 65 + 2 * kq + 1] = a[1];
        *(f32x4*)(Pl + pr * 64 + pc) = p0; *(f32x4*)(Pl + pr * 64 + pc + 4) = p1;
        a = u;
        if (c + 2 < RW_NC) { const float* pn = PU + (size_t)(c + 1) * 8192; p0 = *(const f32x4*)(pn + pr * 64 + pc); p1 = *(const f32x4*)(pn + pr * 64 + pc + 4); u = *(const f32x2*)(pn + 4096 + v * 64 + 2 * kq); }
        __syncthreads();
#pragma unroll 16
        for (int i = 0; i < 64; ++i) { const float s = Ss[vl * 65 + i]; const f32x2 q = *(const f32x2*)(Pl + i * 64 + 2 * kq); a += q * s; }
        __syncthreads();
    }
}
__device__ __forceinline__ int crow(int r, int hi) { return (r & 3) + 8 * (r >> 2) + 4 * hi; }
__device__ __forceinline__ void attn_qk(const unsigned char* Kb, const bf16x8 (&qr)[6], const f32x16& negm, f32x16& s0, f32x16& s1, int r32, int hi) {
    constexpr int KROW = 208;
#pragma unroll
    for (int d0 = 0; d0 < 6; ++d0) {
        const bf16x8 a0 = *(const bf16x8*)(Kb + r32 * KROW + d0 * 32 + hi * 16);
        const bf16x8 a1 = *(const bf16x8*)(Kb + (32 + r32) * KROW + d0 * 32 + hi * 16);
        s0 = __builtin_amdgcn_mfma_f32_32x32x16_bf16(a0, qr[d0], d0 == 0 ? negm : s0, 0, 0, 0);
        s1 = __builtin_amdgcn_mfma_f32_32x32x16_bf16(a1, qr[d0], d0 == 0 ? negm : s1, 0, 0, 0);
    }
}
__device__ __forceinline__ void attn_mask(f32x16& s0, f32x16& s1, int k0, int qg, int hi) {
#pragma unroll
    for (int r = 0; r < 16; ++r) { const int key = k0 + crow(r, hi); if (key > qg) s0[r] = -1e30f; if (key + 32 > qg) s1[r] = -1e30f; }
}
#define MX3(a, b, c) __builtin_fmaxf(__builtin_fmaxf((a), (b)), (c))
#define SBAR() __builtin_amdgcn_sched_barrier(0)
#define PINF(x) asm volatile("" : "+v"(x))
#define ATT_GAP(A_, B_) do { _Pragma("unroll") for (int e = (A_); e < (B_); ++e) { float x_ = (e < 16) ? c0[e & 15] : c1[e & 15]; PINF(x_); x_ = __builtin_amdgcn_exp2f(x_); PINF(x_); if (e < 16) { c0[e & 15] = x_; ps0 += x_; } else { c1[e & 15] = x_; ps1 += x_; } } \
    _Pragma("unroll") for (int p = (A_) / 2; p < (B_) / 2; ++p) { const float lo_ = (2 * p < 16) ? c0[(2 * p) & 15] : c1[(2 * p) & 15], hi_ = (2 * p + 1 < 16) ? c0[(2 * p + 1) & 15] : c1[(2 * p + 1) & 15]; unsigned w_ = pk2(lo_, hi_); PINF(w_); pw[p >> 2][p & 3] = w_; } } while (0)
__device__ __forceinline__ void attn_unit(const Params& P, unsigned char* lds, int h, int qb) {
    const int tid = opaque_tid(), lane = tid & 63, wave = __builtin_amdgcn_readfirstlane(tid >> 6), r32 = lane & 31, hi = lane >> 5;
    unsigned char* ws = opaque_ptr(P.ws);
    const bf16_t* Q = (const bf16_t*)(ws + WS_Q); const bf16_t* KN = (const bf16_t*)(ws + WS_KNOPE); const bf16_t* KR = (const bf16_t*)(ws + WS_KROPE);
    const bf16_t* VT = (const bf16_t*)(ws + WS_VT); bf16_t* YB = (bf16_t*)(ws + WS_YB);
    constexpr int KROW = 208, VROW = 136, KBUF = 64 * KROW, VBUF = 64 * VROW;
    constexpr float THR = 8.0f;
    const int q0 = qb * 256, qw0 = q0 + wave * 32, NT = (q0 + 256) >> 6, qg = qw0 + r32;
    const int ntw = (qw0 + 31) / 64 + 1;
    const int kkey = tid >> 3, kch = tid & 7, rkey = (tid & 255) >> 2, rch = tid & 3;
    const bf16_t* kn_src = KN + (size_t)kkey * 512 + h * 64 + kch * 8;
    const bf16_t* kr_src = KR + (size_t)rkey * 32 + rch * 8;
    const bf16_t* vt_src = VT + (size_t)(h * 64 + kkey) * T + kch * 8;
    const int kn_dst = kkey * KROW + kch * 16, kr_dst = rkey * KROW + 128 + rch * 16, vt_dst = 2 * KBUF + kkey * VROW + kch * 16;
    const bool has_kr = tid < 256;
    bf16x8 qr[6];
#pragma unroll
    for (int d0 = 0; d0 < 6; ++d0) qr[d0] = *(const bf16x8*)(Q + (size_t)(qw0 + r32) * 768 + h * 96 + d0 * 16 + hi * 8);
    f32x16 o0, o1, negm;
#pragma unroll
    for (int r = 0; r < 16; ++r) { o0[r] = 0.f; o1[r] = 0.f; negm[r] = 0.f; }
    float m = 0.f, lsum = 0.f;
    v4u rkn, rkr = (v4u){0u, 0u, 0u, 0u}, rvt;
#define AT_LOADK(tile) do { const int kk0_ = (tile) * 64; rkn = *(const v4u*)(kn_src + (size_t)kk0_ * 512); if (has_kr) rkr = *(const v4u*)(kr_src + (size_t)kk0_ * 32); } while (0)
#define AT_LOADV(tile) do { rvt = *(const v4u*)(vt_src + (tile) * 64); } while (0)
#define AT_STOREK(b) do { unsigned char* nb_ = lds + (b) * KBUF; *(v4u*)(nb_ + kn_dst) = rkn; if (has_kr) *(v4u*)(nb_ + kr_dst) = rkr; } while (0)
#define AT_STOREV(b) do { unsigned char* nv_ = lds + (b) * VBUF; *(v2u*)(nv_ + vt_dst) = (v2u){rvt.x, rvt.y}; *(v2u*)(nv_ + vt_dst + 8) = (v2u){rvt.z, rvt.w}; } while (0)
    __syncthreads();
    AT_LOADK(0); AT_LOADV(0); AT_STOREK(0); AT_STOREV(0);
    AT_LOADK(1); AT_STOREK(1);
    AT_LOADK(2); AT_LOADV(1);
    __syncthreads();
    f32x16 c0, c1, n0, n1;
    attn_qk(lds, qr, negm, c0, c1, r32, hi);
    if (63 > qw0) attn_mask(c0, c1, 0, qg, hi);
    __syncthreads();
    for (int t = 0; t < NT; ++t) {
        const bool act = t < ntw, actn = (t + 1) < ntw;
        if (act) {
            float mx = MX3(c0[0], c0[1], c1[0]);
            mx = MX3(mx, c1[1], c0[2]);
#pragma unroll
            for (int r = 2; r < 16; r += 2) { mx = MX3(mx, c0[r], c0[r + 1]); mx = MX3(mx, c1[r], c1[r + 1]); }
            mx = fmaxf(mx, __shfl_xor(mx, 32));
            if (t == 0 || __any(mx > THR)) {
                const float dl = (t == 0) ? mx : fmaxf(mx, 0.f), f = __builtin_amdgcn_exp2f(-dl);
                m += dl; lsum *= f;
#pragma unroll
                for (int r = 0; r < 16; ++r) { c0[r] -= dl; c1[r] -= dl; o0[r] *= f; o1[r] *= f; negm[r] = -m; }
            }
        }
        float ps0 = 0.f, ps1 = 0.f;
        v4u pw[4];
        if (act && actn) {
            const unsigned char* Kn = lds + ((t + 1) & 1) * KBUF + r32 * KROW + hi * 16;
            SBAR();
#pragma unroll
            for (int g = 0; g < 6; ++g) {
                const bf16x8 ka = *(const bf16x8*)(Kn + g * 32), kb = *(const bf16x8*)(Kn + 32 * KROW + g * 32);
                n0 = __builtin_amdgcn_mfma_f32_32x32x16_bf16(ka, qr[g], g == 0 ? negm : n0, 0, 0, 0);
                SBAR();
                ATT_GAP((32 * (2 * g)) / 12, (32 * (2 * g + 1)) / 12);
                SBAR();
                n1 = __builtin_amdgcn_mfma_f32_32x32x16_bf16(kb, qr[g], g == 0 ? negm : n1, 0, 0, 0);
                SBAR();
                ATT_GAP((32 * (2 * g + 1)) / 12, (32 * (2 * g + 2)) / 12);
                SBAR();
            }
            if ((t + 1) * 64 + 63 > qw0) attn_mask(n0, n1, (t + 1) * 64, qg, hi);
        } else if (act) {
            ATT_GAP(0, 32);
        }
        if (act) {
            lsum += ps0 + ps1;
            const unsigned char* Vb = lds + 2 * KBUF + (t & 1) * VBUF;
#pragma unroll
            for (int ks = 0; ks < 4; ++ks) {
                const bf16x8 pa = __builtin_bit_cast(bf16x8, pw[ks]);
                const unsigned char* va = Vb + r32 * VROW + (16 * ks + 4 * hi) * 2;
                const v2u l0 = *(const v2u*)va, h0 = *(const v2u*)(va + 16);
                const v2u l1 = *(const v2u*)(va + 32 * VROW), h1 = *(const v2u*)(va + 32 * VROW + 16);
                const bf16x8 vf0 = __builtin_bit_cast(bf16x8, ((v4u){l0.x, l0.y, h0.x, h0.y}));
                const bf16x8 vf1 = __builtin_bit_cast(bf16x8, ((v4u){l1.x, l1.y, h1.x, h1.y}));
                o0 = __builtin_amdgcn_mfma_f32_32x32x16_bf16(vf0, pa, o0, 0, 0, 0);
                o1 = __builtin_amdgcn_mfma_f32_32x32x16_bf16(vf1, pa, o1, 0, 0, 0);
            }
        }
        if (t + 2 < NT) AT_STOREK(t & 1);
        if (t + 1 < NT) AT_STOREV((t + 1) & 1);
        if (t + 3 < NT) AT_LOADK(t + 3);
        if (t + 2 < NT) AT_LOADV(t + 2);
        __syncthreads();
        c0 = n0; c1 = n1;
    }
#undef AT_LOADK
#undef AT_LOADV
#undef AT_STOREK
#undef AT_STOREV
    lsum += __shfl_xor(lsum, 32);
    const float inv = 1.f / lsum;
    bf16_t* yrow = YB + (size_t)(qw0 + r32) * 512 + h * 64;
#pragma unroll
    for (int g = 0; g < 4; ++g) {
        const int dv = 8 * g + 4 * hi;
        *(v2u*)(yrow + dv) = (v2u){pk2(o0[4 * g] * inv, o0[4 * g + 1] * inv), pk2(o0[4 * g + 2] * inv, o0[4 * g + 3] * inv)};
        *(v2u*)(yrow + 32 + dv) = (v2u){pk2(o1[4 * g] * inv, o1[4 * g + 1] * inv), pk2(o1[4 * g + 2] * inv, o1[4 * g + 3] * inv)};
    }
}

constexpr int RW_I1 = (RW_NC - 1) * 8;
constexpr int Q_CONV0 = RW_I1 + 512 + 1024, Q_P20 = Q_CONV0 + 66, Q_END = Q_P20 + 32, Q_SPLIT = 300;
#define GEMM_CALL1(EPI, Ap, Bp, M_, N_, K_, E) { pg8::Gemm g_{(const pg8::bf16_t*)(Ap), (const pg8::bf16_t*)(Bp), (M_), (N_), (K_)}; pg8::StaticOrder S_; S_.init((M_), (N_), G, bid); \
    pg8::gemm_phase<EPI, pg8::StaticOrder, true, true>((PG8_LAS unsigned char*)lds, g_, S_, (E)); }
#ifndef PROBE_M
#define PROBE_M 0
#endif
#ifndef PROBE_S
#define PROBE_S 0
#endif
#define GSYNC() do { XcdBarrier xb_; xb_.bar = (unsigned*)(opaque_ptr(P.ws) + WS_CTL) + 4096; xb_.x = xb_xcc_id(); xb_.st = (volatile LAS unsigned*)((LAS unsigned char*)lds + LDS_BYTES - 64); xcd_barrier(xb_); for (int s_ = 0; s_ < PROBE_S; ++s_) xcd_barrier(xb_); } while (0)
#ifndef PROBE_G
#define PROBE_G 0
#endif
#define GEMM_CALL(EPI, Ap, Bp, M_, N_, K_, E) for (int rep_ = 0; rep_ < 1 + PROBE_G; ++rep_) { pg8::Gemm g_{(const pg8::bf16_t*)(Ap), (const pg8::bf16_t*)(Bp), (M_), (N_), (K_)}; pg8::StaticOrder S_; S_.init((M_), (N_), G, bid); \
    pg8::gemm_phase<EPI, pg8::StaticOrder, true, true>((PG8_LAS unsigned char*)lds, g_, S_, (E)); }

#define WSB (opaque_ptr(P.ws))
#define HRES ((float*)(GAS1 float*)(P.out))
#define XNB ((bf16_t*)(WSB + WS_XN))
#define YB32 ((bf16_t*)(WSB + WS_Y))
#define ACTB ((bf16_t*)(WSB + WS_ACT))
#define CTLW ((unsigned*)(WSB + WS_CTL))
__global__ void __launch_bounds__(512, 2) fwd_kernel(Params P) {
    extern __shared__ __attribute__((aligned(16))) unsigned char lds[];
    cg::grid_group grid = cg::this_grid();
    const int bid = blockIdx.x, G = gridDim.x;
    volatile LAS unsigned* xst = (volatile LAS unsigned*)((LAS unsigned char*)lds + LDS_BYTES - 64);
    if (threadIdx.x < 4) xst[threadIdx.x] = 0u;
    __syncthreads();
    (void)xcd_barrier_post((unsigned*)(opaque_ptr(P.ws) + WS_CTL) + 4096, xst);
    int* qslot = (int*)(lds + LDS_BYTES - 16);

    phase_tables(P);
    if (PROBE_M & 4) conv_ffn(GPF(P.in[4]), GPF(P.in[5]), GPF(P.in[6]), WSB, lds, 0);
    conv_ffn(GPF(P.in[4]), GPF(P.in[5]), GPF(P.in[6]), WSB, lds, 0);
    phase_rowwise(nullptr, GPF(P.in[0]), HRES, 0.f, nullptr, GPF(P.in[2]), XNB);
    grid.sync();
    GSYNC();

#pragma unroll 1
    for (int l = 0; l < NL; ++l) {
#pragma unroll 1
        for (int f = 0; f < 2; ++f) {

#ifndef SKIP_G1
            { pg8::EpiSwiGLU E{ACTB, DFF}; GEMM_CALL(pg8::EpiSwiGLU, XNB, WSB + WA_GU, T, 2 * DFF, DM, E); }
#endif

            GSYNC();

#ifndef SKIP_G2
            { pg8::EpiBf16Split E{(pg8::bf16_t*)YB32, DM, 1 << 30, nullptr, 0}; GEMM_CALL(pg8::EpiBf16Split, ACTB, WSB + WA_D, T, DM, DFF, E); }
#endif

            GSYNC();
            if (f == 1) {
                const float* gpost = GPF(P.in[36]) + (size_t)l * DM;
                const float* gpre = (l + 1 < NL) ? GPF(P.in[2]) + (size_t)(l + 1) * DM : nullptr;
                if (PROBE_M & 8) phase_rowwise(YB32, HRES, (float*)ACTB, 0.5f, gpost, gpre, XNB);
                phase_rowwise(YB32, HRES, HRES, 0.5f, gpost, gpre, XNB);
                if ((PROBE_M & 4) && l + 1 < NL) conv_ffn(GPF(P.in[4]) + (size_t)(l + 1) * DM * DFF, GPF(P.in[5]) + (size_t)(l + 1) * DM * DFF, GPF(P.in[6]) + (size_t)(l + 1) * DM * DFF, WSB, lds, 0);
                if (l + 1 < NL) conv_ffn(GPF(P.in[4]) + (size_t)(l + 1) * DM * DFF, GPF(P.in[5]) + (size_t)(l + 1) * DM * DFF, GPF(P.in[6]) + (size_t)(l + 1) * DM * DFF, WSB, lds, 0);
                GSYNC();
                continue;
            }
            if (PROBE_M & 8) phase_rowwise(YB32, HRES, (float*)ACTB, 0.5f, GPF(P.in[3]) + (size_t)l * DM, GPF(P.in[7]) + (size_t)l * DM, XNB);
            phase_rowwise(YB32, HRES, HRES, 0.5f, GPF(P.in[3]) + (size_t)l * DM, GPF(P.in[7]) + (size_t)l * DM, XNB);

#ifndef SKIP_CM
            if (PROBE_M & 4) conv_mixer(P, l, lds);
            conv_mixer(P, l, lds);
#endif

            GSYNC();

#ifndef SKIP_G3
            { pg8::EpiBf16Split E{(pg8::bf16_t*)(WSB + WS_P1), NP1, NP1 / 256, (pg8::bf16_t*)(WSB + WS_P2), NP2}; GEMM_CALL(pg8::EpiBf16Split, XNB, WSB + WB_IN, T, NP1 + NP2, DM, E); }
#endif

            GSYNC();

#ifndef SKIP_PREP
            for (int rep2 = 0; rep2 < 1 + ((PROBE_M & 2) ? 1 : 0); ++rep2) {
            phase_prep(P, l);
#endif


#ifndef SKIP_HA
            for (int u = bid; u < 1024; u += G) hgrn_a_unit(P, l, u, lds);
            }
#endif

            GSYNC();

#ifndef SKIP_HB
            hgrn_b(P, lds);
#endif

            __syncthreads();
#pragma unroll 1
            for (int gi = 0; gi < 4; ++gi) {
                const unsigned char* Ap; const unsigned char* Bp; unsigned char* Op; int M_, N_, K_, ld;
                if (gi == 0) { Ap = WSB + WS_LIN; Bp = WSB + WB_LORA; Op = WSB + WS_LORA; M_ = T; N_ = 2048; K_ = 384; ld = 2048; }
                else if (gi == 1) { Ap = WSB + WS_CQN; Bp = WSB + WB_UQ; Op = WSB + WS_Q; M_ = T; N_ = 768; K_ = 384; ld = 768; }
                else if (gi == 2) { Ap = WSB + WS_CKVN; Bp = WSB + WB_UK; Op = WSB + WS_KNOPE; M_ = T; N_ = 512; K_ = 256; ld = 512; }
                else { Ap = WSB + WB_UV; Bp = WSB + WS_CKVN; Op = WSB + WS_VT; M_ = 512; N_ = T; K_ = 256; ld = T; }
                pg8::EpiBf16Split E{(pg8::bf16_t*)Op, ld, 1 << 30, nullptr, 0};

#ifndef SKIP_G4
                GEMM_CALL(pg8::EpiBf16Split, Ap, Bp, M_, N_, K_, E);
#endif

            }
            GSYNC();

#ifndef SKIP_PREP2
            phase_prep2(P, l);
#endif

            GSYNC();

#ifndef PROBE_Q
#define PROBE_Q 0
#endif
#pragma unroll 1
            for (int rep = 0; rep < 1 + (PROBE_Q ? 1 : 0); ++rep) {
            for (;;) {
                __syncthreads();
                if (threadIdx.x == 0) *qslot = (int)atomicAdd(CTLW + 64 * l + 16 * rep, 1u);
                __syncthreads();
                int item = *qslot;
                if (item >= (rep ? Q_CONV0 : Q_END)) break;
                if (!rep) {
                    const int a0_ = RW_I1 + Q_SPLIT, nx_ = Q_END - Q_CONV0;
                    if (item >= a0_ && item < a0_ + nx_) { const int x_ = item - a0_; item = (x_ < 32) ? Q_P20 + x_ : Q_CONV0 + (x_ - 32); }
                    else if (item >= a0_ + nx_) item -= nx_;
                }
                if (item < RW_I1) {
                    if (rep && !(PROBE_Q & 1)) continue;
                    const int hh = item & 7, cc = item >> 3;
                    float* fin = (float*)(WSB + WS_PU) + (size_t)(hh * RW_NC + cc) * 8192;
                    rwkv_scan_pu(P, lds, hh, cc * RW_LC, RW_LC / 32, cc > 0 ? fin : nullptr, fin + 4096);
                    if (!rep) {
                        asm volatile("s_waitcnt vmcnt(0)" ::: "memory");
                        __syncthreads();
                        if (threadIdx.x == 0) { __builtin_amdgcn_fence(__ATOMIC_RELEASE, "agent"); asm volatile("s_waitcnt vmcnt(0)" ::: "memory");
                            __hip_atomic_fetch_add(CTLW + 64 * l + 32 + hh, 1u, __ATOMIC_RELAXED, __HIP_MEMORY_SCOPE_AGENT); }
                    }
                    continue;
                }
                if (item >= Q_CONV0) {
                    if (item < Q_P20) { conv_ffn_item(GPF(P.in[37]) + (size_t)l * DM * DFF, GPF(P.in[38]) + (size_t)l * DM * DFF, GPF(P.in[39]) + (size_t)l * DM * DFF, WSB, lds, item - Q_CONV0); continue; }
                    const int hh = (item - Q_P20) >> 2, part = (item - Q_P20) & 3;
                    if (threadIdx.x == 0) { unsigned spins = 0; while (__hip_atomic_load(CTLW + 64 * l + 32 + hh, __ATOMIC_RELAXED, __HIP_MEMORY_SCOPE_AGENT) < (unsigned)(RW_NC - 1) && ++spins < 4000000u) __builtin_amdgcn_s_sleep(2); }
                    __syncthreads();
                    __builtin_amdgcn_fence(__ATOMIC_ACQUIRE, "agent"); asm volatile("s_waitcnt vmcnt(0)" ::: "memory");
                    __syncthreads();
                    rwkv_pass2(P, lds, hh, part);
                    continue;
                }
                item -= RW_I1;
                if (item < 512) { if (rep && !(PROBE_Q & 2)) continue; attn_unit(P, lds, item & 7, 63 - (item >> 3)); }
                else { if (rep && !(PROBE_Q & 4)) continue; hgrn_c_unit(P, l, item - 512, lds); }
            }
            }
            GSYNC();
            for (int rep3 = 0; rep3 < 1 + ((PROBE_M & 1) ? 1 : 0); ++rep3)
            for (int it = bid; it < 8 * RW_NC; it += G) { const int hh = it & 7, cc = it >> 3;
                rwkv_scan_item<0>(P, l, lds, hh, cc * RW_LC, RW_LC / 32, cc ? (const float*)(WSB + WS_SINIT) + (size_t)(hh * RW_NC + cc) * 4096 : nullptr, nullptr); }
            GSYNC();
#pragma unroll 1
            for (int br = 0; br < 3; ++br) {
                const unsigned char* Ap = br == 0 ? WSB + WS_YA : (br == 1 ? WSB + WS_YB : WSB + WS_YC);
                pg8::EpiGate E{(const pg8::bf16_t*)(WSB + WS_P2) + C2_GATE + br * 1024, NP2, (pg8::bf16_t*)(WSB + WS_MERGED), DM, br == 0 ? 1 : 0};

#ifndef SKIP_G5
                GEMM_CALL1(pg8::EpiGate, Ap, WSB + WB_OUT + (size_t)br * 1024 * 512 * 2, T, DM, 512, E);
#endif

            }
            GSYNC();

#ifndef SKIP_G6
            { pg8::EpiBf16Split E{(pg8::bf16_t*)YB32, DM, 1 << 30, nullptr, 0}; GEMM_CALL(pg8::EpiBf16Split, WSB + WS_MERGED, WSB + WB_O, T, DM, DM, E); }
#endif

            GSYNC();
            if (PROBE_M & 8) phase_rowwise(YB32, HRES, (float*)ACTB, 1.0f, GPF(P.in[8]) + (size_t)l * DM, GPF(P.in[35]) + (size_t)l * DM, XNB);
            phase_rowwise(YB32, HRES, HRES, 1.0f, GPF(P.in[8]) + (size_t)l * DM, GPF(P.in[35]) + (size_t)l * DM, XNB);
            GSYNC();
        }
    }
}

extern "C" void kernel_launch(void* const* d_in, const int* in_sizes, int n_in, void* d_out, int out_size, void* d_ws, size_t ws_size, hipStream_t stream) {
    static int grid = 0;
    if (grid == 0) {
        if (n_in != 40 || out_size != T * DM || ws_size < WS_END) { fprintf(stderr, "kernel_launch: unexpected problem (n_in %d out %d ws %zu)\n", n_in, out_size, ws_size); grid = -1; return; }
        int dev = 0, cus = 0, per_cu = 0;
        hipGetDevice(&dev);
        hipDeviceGetAttribute(&cus, hipDeviceAttributeMultiprocessorCount, dev);
        hipFuncSetAttribute((const void*)fwd_kernel, hipFuncAttributeMaxDynamicSharedMemorySize, LDS_BYTES);
        hipOccupancyMaxActiveBlocksPerMultiprocessor(&per_cu, (const void*)fwd_kernel, 512, LDS_BYTES);
        (void)hipGetLastError();
        if (per_cu < 1) per_cu = 1;
        grid = cus;
        if (grid < 64) { grid = -1; return; }
    }
    if (grid < 0) return;
    hipMemsetAsync((char*)d_ws + WS_CTL, 0, 65536, stream);
    Params p{};
    for (int i = 0; i < 40; ++i) p.in[i] = d_in[i];
    p.out = (float*)d_out; p.ws = (unsigned char*)d_ws;
    void* args[] = {&p};
    hipError_t e = hipLaunchCooperativeKernel((const void*)fwd_kernel, dim3(grid), dim3(512), args, LDS_BYTES, stream);
    if (e != hipSuccess) fprintf(stderr, "cooperative launch failed: %s (grid %d)\n", hipGetErrorString(e), grid);
}
```

```cpp
#include <hip/hip_runtime.h>
#include <hip/hip_cooperative_groups.h>
#include <cstdio>
#include <cstdint>
namespace cg = cooperative_groups;
__device__ __forceinline__ int opaque_tid() { int t = threadIdx.x; asm volatile("" : "+v"(t)); return t; }
__device__ __forceinline__ unsigned char* opaque_ptr(unsigned char* p) {
    const unsigned long long v = (unsigned long long)p;
    unsigned lo = __builtin_amdgcn_readfirstlane((unsigned)v), hi = __builtin_amdgcn_readfirstlane((unsigned)(v >> 32));
    asm volatile("" : "+s"(lo), "+s"(hi));
    return (unsigned char*)(__attribute__((address_space(1))) unsigned char*)(((unsigned long long)hi << 32) | lo);
}
#define GAS1 __attribute__((address_space(1)))
#define GPF(p) ((const float*)(const GAS1 float*)(p))
#define GPI(p) ((const int*)(const GAS1 int*)(p))
#define PHASE_IDS const int tid = opaque_tid(), lane = tid & 63, wave = __builtin_amdgcn_readfirstlane(tid >> 6), bid = blockIdx.x, G = gridDim.x, gw = bid * 8 + wave, ngw = G * 8, gtid = bid * 512 + tid, gthreads = G * 512; (void)lane; (void)gw; (void)ngw; (void)gtid; (void)gthreads;
namespace pg8 {
#define PG8_LAS __attribute__((address_space(3)))
typedef unsigned short bf16_t;
typedef short bf16x8 __attribute__((ext_vector_type(8)));
typedef float f32x4 __attribute__((ext_vector_type(4)));
typedef unsigned u32x4 __attribute__((ext_vector_type(4)));
constexpr int BM = 256, BK = 64, HALF = 128, HTB = HALF * BK * 2  , STAGE_BYTES = 8 * HTB, NXCD = 8, WGM = 8;

__host__ __device__ __forceinline__ int lds_byte(int r, int c) { const int st = (r >> 4) * 2 + (c >> 5), rr = r & 15, cc = c & 31, ob = rr * 64 + cc * 2; return st * 1024 + (ob ^ (((ob >> 9) & 1) << 5)); }
__host__ __device__ __forceinline__ void stage_rc(int b, int& R, int& C) { const int st = b / 1024, sb = b % 1024, swz = sb ^ (((sb >> 9) & 1) << 5); R = (st >> 1) * 16 + swz / 64; C = (st & 1) * 32 + (swz % 64) / 2; }
__host__ __device__ __forceinline__ int perm32(int rho) { const int n = rho >> 4, i = rho & 15; return 8 * (i >> 2) + 4 * n + (i & 3); }

struct Unit { int pm, pn; };
struct Gemm { const bf16_t* A; const bf16_t* Bt; int M, N, K; };

struct StaticOrder {
    int nM, nN, nwg, G, c;
    __host__ __device__ void init(int M, int N, int G_, int c_) { nM = M / BM; nN = N / BM; nwg = nM * nN; G = G_; c = c_; }
    __host__ __device__ bool next(int i, Unit& u) const {
        const long L = (long)i * G + c; if (L >= nwg) return false;
        int wgid = (int)L; { const int q = nwg / NXCD, r = nwg % NXCD, xcd = wgid % NXCD, off = wgid / NXCD; wgid = (xcd < r ? xcd * (q + 1) : r * (q + 1) + (xcd - r) * q) + off; }
        const int nig = WGM * nN, gid = wgid / nig, fm = gid * WGM, gsz = (nM - fm) < WGM ? (nM - fm) : WGM;
        u.pm = fm + ((wgid % nig) % gsz); u.pn = (wgid % nig) / gsz; return true;
    }
    __device__ __forceinline__ void a_ready(const Unit&) const {}
    __device__ __forceinline__ void done(const Unit&) const {}
};

typedef float f32x2e __attribute__((ext_vector_type(2))); typedef __bf16 bf16x2e __attribute__((ext_vector_type(2)));
__device__ __forceinline__ unsigned cvt_pk_bf16(float lo, float hi) { f32x2e v = {lo, hi}; bf16x2e b = __builtin_convertvector(v, bf16x2e); return __builtin_bit_cast(unsigned, b); }
__device__ __forceinline__ float bflo(unsigned w) { return __uint_as_float(w << 16); }
__device__ __forceinline__ float bfhi(unsigned w) { return __uint_as_float(w & 0xffff0000u); }
__device__ __forceinline__ float sigm(float x) { return 1.0f / (1.0f + __expf(-x)); }

struct EpiBf16Split {
    static constexpr bool PERM = true, AFTER_DRAIN = false;
    bf16_t* O0; int ld0; int split_pn; bf16_t* O1; int ld1;
    __device__ __forceinline__ void operator()(const f32x4 (&acc)[2][2][4][2], const Unit& u, int wr, int wc, int fr, int fq) const {
        int pn = u.pn; bf16_t* base = O0; int ld = ld0;
        if (pn >= split_pn) { pn -= split_pn; base = O1; ld = ld1; }
        const int row0 = u.pm * BM + wr * 64 + fr, col0 = pn * BM + wc * 32 + 8 * fq;
#pragma unroll
        for (int ai = 0; ai < 2; ++ai)
#pragma unroll
            for (int m = 0; m < 4; ++m) { bf16_t* rowp = base + (size_t)(row0 + ai * HALF + m * 16) * ld + col0;
#pragma unroll
                for (int bj = 0; bj < 2; ++bj) { const f32x4 v0 = acc[ai][bj][m][0], v1 = acc[ai][bj][m][1];
                    u32x4 w; w.x = cvt_pk_bf16(v0[0], v0[1]); w.y = cvt_pk_bf16(v0[2], v0[3]); w.z = cvt_pk_bf16(v1[0], v1[1]); w.w = cvt_pk_bf16(v1[2], v1[3]);
                    *(u32x4*)(rowp + bj * HALF) = w; } }
    }
};
struct EpiF32 {
    static constexpr bool PERM = false, AFTER_DRAIN = false;
    float* O; int ldc;
    __device__ __forceinline__ void operator()(const f32x4 (&acc)[2][2][4][2], const Unit& u, int wr, int wc, int fr, int fq) const {
        const int row0 = u.pm * BM + wr * 64 + fr, col0 = u.pn * BM + wc * 32 + 4 * fq;
#pragma unroll
        for (int ai = 0; ai < 2; ++ai)
#pragma unroll
            for (int m = 0; m < 4; ++m) { float* rowp = O + (size_t)(row0 + ai * HALF + m * 16) * ldc + col0;
#pragma unroll
                for (int bj = 0; bj < 2; ++bj)
#pragma unroll
                    for (int n = 0; n < 2; ++n) *(f32x4*)(rowp + bj * HALF + n * 16) = acc[ai][bj][m][n]; }
    }
};
struct EpiSwiGLU {
    static constexpr bool PERM = false, AFTER_DRAIN = false;
    bf16_t* O; int ldo;
    __device__ __forceinline__ void operator()(const f32x4 (&acc)[2][2][4][2], const Unit& u, int wr, int wc, int fr, int fq) const {
        const int row0 = u.pm * BM + wr * 64 + fr, j0 = u.pn * 128 + wc * 16 + 4 * fq;
#pragma unroll
        for (int ai = 0; ai < 2; ++ai)
#pragma unroll
            for (int m = 0; m < 4; ++m) { bf16_t* rowp = O + (size_t)(row0 + ai * HALF + m * 16) * ldo + j0;
#pragma unroll
                for (int bj = 0; bj < 2; ++bj) { const f32x4 g = acc[ai][bj][m][0], up = acc[ai][bj][m][1];
                    float a[4];
#pragma unroll
                    for (int i = 0; i < 4; ++i) a[i] = g[i] * sigm(g[i]) * up[i];
                    unsigned long long w = (unsigned long long)cvt_pk_bf16(a[0], a[1]) | ((unsigned long long)cvt_pk_bf16(a[2], a[3]) << 32);
                    *(unsigned long long*)(rowp + bj * 64) = w; } }
    }
};
struct EpiGate {
    static constexpr bool PERM = true, AFTER_DRAIN = false;
    const bf16_t* G; int ldg; bf16_t* O; int ldo; int first;
    __device__ __forceinline__ void operator()(const f32x4 (&acc)[2][2][4][2], const Unit& u, int wr, int wc, int fr, int fq) const {
        const int row0 = u.pm * BM + wr * 64 + fr, col0 = u.pn * BM + wc * 32 + 8 * fq;
#pragma unroll
        for (int ai = 0; ai < 2; ++ai)
#pragma unroll
            for (int m = 0; m < 4; ++m) { const size_t row = (size_t)(row0 + ai * HALF + m * 16);
#pragma unroll
                for (int bj = 0; bj < 2; ++bj) { const f32x4 v0 = acc[ai][bj][m][0], v1 = acc[ai][bj][m][1];
                    const u32x4 gw = *(const u32x4*)(G + row * ldg + col0 + bj * HALF);
                    float r[8];
                    r[0] = sigm(bflo(gw.x)) * v0[0]; r[1] = sigm(bfhi(gw.x)) * v0[1]; r[2] = sigm(bflo(gw.y)) * v0[2]; r[3] = sigm(bfhi(gw.y)) * v0[3];
                    r[4] = sigm(bflo(gw.z)) * v1[0]; r[5] = sigm(bfhi(gw.z)) * v1[1]; r[6] = sigm(bflo(gw.w)) * v1[2]; r[7] = sigm(bfhi(gw.w)) * v1[3];
                    bf16_t* op = O + row * ldo + col0 + bj * HALF;
                    if (!first) { const u32x4 ow = *(const u32x4*)op;
                        r[0] += bflo(ow.x); r[1] += bfhi(ow.x); r[2] += bflo(ow.y); r[3] += bfhi(ow.y); r[4] += bflo(ow.z); r[5] += bfhi(ow.z); r[6] += bflo(ow.w); r[7] += bfhi(ow.w); }
                    u32x4 w; w.x = cvt_pk_bf16(r[0], r[1]); w.y = cvt_pk_bf16(r[2], r[3]); w.z = cvt_pk_bf16(r[4], r[5]); w.w = cvt_pk_bf16(r[6], r[7]);
                    *(u32x4*)op = w; } }
    }
};
template <class Epi, class Sched, bool ALIGN_EPI = false, bool SP2 = false>
__device__ __forceinline__ void gemm_phase(PG8_LAS unsigned char* lds, const Gemm g, const Sched& S, const Epi& E) {
    const int tid = opaque_tid(), wid = __builtin_amdgcn_readfirstlane(tid >> 6), lane = tid & 63, wr = wid >> 2, wc = wid & 3, fr = lane & 15, fq = lane >> 4;
    const int K = g.K, nt = K / BK;
    unsigned voffA[2], voffB[2];
#pragma unroll
    for (int i = 0; i < 2; ++i) { int R, C; stage_rc(tid * 16 + i * 8192, R, C); const int Rb = Epi::PERM ? ((R & ~31) + perm32(R & 31)) : R;
        voffA[i] = (unsigned)(R * K + C) * 2u; voffB[i] = (unsigned)(Rb * K + C) * 2u; }
    const size_t kstep = (size_t)(BK * 2);
    const size_t hstep = (size_t)HALF * K * 2;
    const size_t tstep = 2 * hstep;
    const unsigned ldsw = (unsigned)wid * 1024u;
    const int aoff = lds_byte(wr * 64 + fr, fq * 8), boff = lds_byte(wc * 32 + fr, fq * 8);
#define PG8_SA(b, h) (((b) * 2 + (h)) * HTB)
#define PG8_SB(b, h) ((4 + (b) * 2 + (h)) * HTB)
#define PG8_STAGE(bufoff, gbase, voff) do { _Pragma("unroll") for (int _i = 0; _i < 2; ++_i) \
        __builtin_amdgcn_global_load_lds((const unsigned*)((const char*)(gbase) + (voff)[_i]), (PG8_LAS unsigned*)(lds + (bufoff) + ldsw + _i * 8192), 16, 0, 0); } while (0)
#define PG8_LDA(dst, b, h) do { _Pragma("unroll") for (int m = 0; m < 4; ++m) _Pragma("unroll") for (int k = 0; k < 2; ++k) dst[m][k] = *(const PG8_LAS bf16x8*)(lds + PG8_SA(b, h) + aoff + m * 2048 + k * 1024); } while (0)
#define PG8_LDB(dst, b, h) do { _Pragma("unroll") for (int n = 0; n < 2; ++n) _Pragma("unroll") for (int k = 0; k < 2; ++k) dst[n][k] = *(const PG8_LAS bf16x8*)(lds + PG8_SB(b, h) + boff + n * 2048 + k * 1024); } while (0)
#define PG8_MMA(ai, bj, At, Bt) do { __builtin_amdgcn_s_setprio(1); _Pragma("unroll") for (int m = 0; m < 4; ++m) _Pragma("unroll") for (int n = 0; n < 2; ++n) _Pragma("unroll") for (int k = 0; k < 2; ++k) \
        acc[ai][bj][m][n] = __builtin_amdgcn_mfma_f32_16x16x32_bf16(Bt[n][k], At[m][k], acc[ai][bj][m][n], 0, 0, 0); __builtin_amdgcn_s_setprio(0); } while (0)
#define PG8_WAIT_V(n) asm volatile("s_waitcnt vmcnt(" #n ")" ::: "memory")
#define PG8_WAIT_L(n) asm volatile("s_waitcnt lgkmcnt(" #n ")" ::: "memory")
#define PG8_BAR __builtin_amdgcn_s_barrier()
#define PG8_SCHED __builtin_amdgcn_sched_barrier(0)
    Unit cur, nxt; int ui = 0;
    if (!S.next(0, cur)) return;
    f32x4 acc[2][2][4][2];
#pragma unroll
    for (int a = 0; a < 2; ++a)
#pragma unroll
        for (int b = 0; b < 2; ++b)
#pragma unroll
            for (int m = 0; m < 4; ++m)
#pragma unroll
                for (int n = 0; n < 2; ++n) acc[a][b][m][n] = (f32x4){0.f, 0.f, 0.f, 0.f};
    bf16x8 At[4][2], B0[2][2], B1[2][2];
    const char* cA = (const char*)g.A + (size_t)cur.pm * tstep; const char* cB = (const char*)g.Bt + (size_t)cur.pn * tstep;
    S.a_ready(cur);
    if constexpr (SP2) {
        PG8_STAGE(PG8_SB(0, 0), cB, voffB); PG8_STAGE(PG8_SB(0, 1), cB + hstep, voffB); PG8_STAGE(PG8_SA(0, 0), cA, voffA); PG8_STAGE(PG8_SA(0, 1), cA + hstep, voffA);
        if (wr == 1) PG8_BAR;
        PG8_WAIT_V(2); PG8_BAR;
        PG8_STAGE(PG8_SB(1, 0), cB + kstep, voffB); PG8_STAGE(PG8_SA(1, 0), cA + kstep, voffA); PG8_STAGE(PG8_SB(1, 1), cB + hstep + kstep, voffB);
        PG8_WAIT_V(6); PG8_BAR;
    } else {
        PG8_STAGE(PG8_SB(0, 0), cB, voffB); PG8_STAGE(PG8_SA(0, 0), cA, voffA); PG8_STAGE(PG8_SB(0, 1), cB + hstep, voffB); PG8_STAGE(PG8_SA(0, 1), cA + hstep, voffA);
        if (wr == 1) PG8_BAR;
        PG8_WAIT_V(4); PG8_BAR;
        PG8_STAGE(PG8_SB(1, 0), cB + kstep, voffB); PG8_STAGE(PG8_SA(1, 0), cA + kstep, voffA); PG8_STAGE(PG8_SB(1, 1), cB + hstep + kstep, voffB);
        PG8_WAIT_V(6); PG8_BAR;
    }
    for (;;) {
        const bool has_next = S.next(ui + 1, nxt);
        const char* nA = has_next ? (const char*)g.A + (size_t)nxt.pm * tstep : cA; const char* nB = has_next ? (const char*)g.Bt + (size_t)nxt.pn * tstep : cB;
        for (int t = 0; t < nt; t += 2) {
            const bool last = (t == nt - 2);
            const char* a1 = cA + (size_t)(t + 1) * kstep;
            const char* a2 = last ? nA : cA + (size_t)(t + 2) * kstep; const char* b2 = last ? nB : cB + (size_t)(t + 2) * kstep;
            const char* a3 = a2 + kstep; const char* b3 = b2 + kstep;
            if (last && has_next) S.a_ready(nxt);
            if constexpr (SP2) {
            PG8_LDB(B0, 0, 0); PG8_LDB(B1, 0, 1); PG8_SCHED; PG8_LDA(At, 0, 0); PG8_STAGE(PG8_SA(1, 1), a1 + hstep, voffA);
            PG8_WAIT_V(8); PG8_WAIT_L(0); PG8_BAR; PG8_MMA(0, 0, At, B0); PG8_MMA(0, 1, At, B1); PG8_BAR; PG8_SCHED;
            PG8_LDA(At, 0, 1); PG8_STAGE(PG8_SB(0, 0), b2, voffB); PG8_STAGE(PG8_SB(0, 1), b2 + hstep, voffB); PG8_STAGE(PG8_SA(0, 0), a2, voffA);
            PG8_WAIT_V(8); PG8_WAIT_L(0); PG8_BAR; PG8_MMA(1, 0, At, B0); PG8_MMA(1, 1, At, B1); PG8_BAR; PG8_SCHED;
            PG8_LDB(B0, 1, 0); PG8_LDB(B1, 1, 1); PG8_SCHED; PG8_LDA(At, 1, 0); PG8_STAGE(PG8_SA(0, 1), a2 + hstep, voffA);
            PG8_WAIT_V(8); PG8_WAIT_L(0); PG8_BAR; PG8_MMA(0, 0, At, B0); PG8_MMA(0, 1, At, B1); PG8_BAR; PG8_SCHED;
            PG8_LDA(At, 1, 1); PG8_STAGE(PG8_SB(1, 0), b3, voffB); PG8_STAGE(PG8_SB(1, 1), b3 + hstep, voffB); PG8_STAGE(PG8_SA(1, 0), a3, voffA);
            PG8_WAIT_V(8); PG8_WAIT_L(0); PG8_BAR; PG8_MMA(1, 0, At, B0); PG8_MMA(1, 1, At, B1); PG8_BAR; PG8_SCHED;
            } else {
            PG8_LDB(B0, 0, 0); PG8_SCHED; PG8_LDA(At, 0, 0); PG8_STAGE(PG8_SA(1, 1), a1 + hstep, voffA);
            PG8_WAIT_L(8); PG8_BAR; PG8_WAIT_L(0); PG8_MMA(0, 0, At, B0); PG8_BAR; PG8_SCHED;
            PG8_LDB(B1, 0, 1); PG8_STAGE(PG8_SB(0, 0), b2, voffB);
            PG8_BAR; PG8_WAIT_L(0); PG8_MMA(0, 1, At, B1); PG8_BAR;
            PG8_LDA(At, 0, 1); PG8_STAGE(PG8_SA(0, 0), a2, voffA);
            PG8_BAR; PG8_WAIT_L(0); PG8_MMA(1, 0, At, B0); PG8_BAR; PG8_SCHED;
            PG8_STAGE(PG8_SB(0, 1), b2 + hstep, voffB);
            PG8_WAIT_V(6); PG8_BAR; PG8_MMA(1, 1, At, B1); PG8_BAR;
            PG8_LDB(B0, 1, 0); PG8_SCHED; PG8_LDA(At, 1, 0); PG8_STAGE(PG8_SA(0, 1), a2 + hstep, voffA);
            PG8_WAIT_L(8); PG8_BAR; PG8_WAIT_L(0); PG8_MMA(0, 0, At, B0); PG8_BAR; PG8_SCHED;
            PG8_LDB(B1, 1, 1); PG8_STAGE(PG8_SB(1, 0), b3, voffB);
            PG8_BAR; PG8_WAIT_L(0); PG8_MMA(0, 1, At, B1); PG8_BAR;
            PG8_LDA(At, 1, 1); PG8_STAGE(PG8_SA(1, 0), a3, voffA);
            PG8_BAR; PG8_WAIT_L(0); PG8_MMA(1, 0, At, B0); PG8_BAR; PG8_SCHED;
            PG8_STAGE(PG8_SB(1, 1), b3 + hstep, voffB);
            PG8_WAIT_V(6); PG8_BAR; PG8_MMA(1, 1, At, B1); PG8_BAR;
            }
        }
        if constexpr (ALIGN_EPI) { if (wr == 0) PG8_BAR; }
        if constexpr (!Epi::AFTER_DRAIN) { E(acc, cur, wr, wc, fr, fq); S.done(cur); }
        if (!has_next) break;
#pragma unroll
        for (int a = 0; a < 2; ++a)
#pragma unroll
            for (int b = 0; b < 2; ++b)
#pragma unroll
                for (int m = 0; m < 4; ++m)
#pragma unroll
                    for (int n = 0; n < 2; ++n) acc[a][b][m][n] = (f32x4){0.f, 0.f, 0.f, 0.f};
        cur = nxt; cA = nA; cB = nB; ++ui;
        if constexpr (ALIGN_EPI) { if (wr == 1) PG8_BAR; }
    }
    PG8_WAIT_V(0);
    if constexpr (!ALIGN_EPI) { if (wr == 0) PG8_BAR; }
    PG8_BAR;
    if constexpr (Epi::AFTER_DRAIN) { E.fused(acc, cur, wr, wc, fr, fq, lds, wid, lane); S.done(cur); }
#undef PG8_SA
#undef PG8_SB
#undef PG8_STAGE
#undef PG8_LDA
#undef PG8_LDB
#undef PG8_MMA
#undef PG8_WAIT_V
#undef PG8_WAIT_L
#undef PG8_BAR
#undef PG8_SCHED
}
}
constexpr int T = 16384, DM = 1024, NL = 4, DFF = 2816;
constexpr int NP1 = 2560, NP2 = 5120;
constexpr int C1_VRES = 1792, C1_CQ = 1824, C1_CKV = 2208, C1_KR = 2464;
constexpr int C2_HQ = 0, C2_HF = 512, C2_HI = 1024, C2_HG = 1536, C2_GATE = 2048;
constexpr float NORM_EPS = 1e-6f;
constexpr float QSCALE = 0.10206207261596575f * 1.4426950408889634f;
constexpr float LOG2E = 1.4426950408889634f;

constexpr size_t MiB = 1u << 20;
constexpr size_t WS_CTL = 0;
constexpr size_t WS_COS = 1 * MiB, WS_SIN = 2 * MiB, WS_LB = 3 * MiB;
constexpr size_t WS_WA = 4 * MiB;
constexpr size_t WA_GU = WS_WA, WA_D = WS_WA + (size_t)5632 * 1024 * 2;
constexpr size_t WS_WB = 22 * MiB;
constexpr size_t WB_IN = WS_WB;
constexpr size_t WB_LORA = WB_IN + (size_t)7680 * 1024 * 2;
constexpr size_t WB_UQ = WB_LORA + (size_t)2048 * 384 * 2;
constexpr size_t WB_UK = WB_UQ + (size_t)768 * 384 * 2;
constexpr size_t WB_UV = WB_UK + (size_t)512 * 256 * 2;
constexpr size_t WB_OUT = WB_UV + (size_t)512 * 256 * 2;
constexpr size_t WB_O = WB_OUT + (size_t)3 * 1024 * 512 * 2;
static_assert(WB_O + (size_t)1024 * 1024 * 2 <= 46 * MiB, "W_B region");
static_assert(WA_D + (size_t)1024 * 2816 * 2 <= 22 * MiB, "W_A region");
constexpr size_t WS_VFIRST = 46 * MiB;
constexpr size_t WS_P1 = 62 * MiB;
constexpr size_t WS_P2 = 142 * MiB;
constexpr size_t WS_ACT = WS_P1;
constexpr size_t WS_LORA = WS_P1;
constexpr size_t WS_YA = WS_P1 + 64 * MiB;
constexpr size_t WS_MERGED = WS_P1;
constexpr size_t WS_Y = 302 * MiB;
constexpr size_t WS_XN = 366 * MiB;
constexpr size_t WS_RB = 302 * MiB, WS_KB = 318 * MiB, WS_VB = 334 * MiB;
constexpr size_t WS_Q = 350 * MiB;
constexpr size_t WS_KNOPE = 374 * MiB;
constexpr size_t WS_LIN = 398 * MiB;
constexpr size_t WS_CQN = 410 * MiB;
constexpr size_t WS_CKVN = 422 * MiB;
constexpr size_t WS_KROPE = 430 * MiB;
constexpr size_t WS_DVEC = 431 * MiB;
constexpr size_t WS_DS = 432 * MiB;
constexpr size_t WS_VT = 464 * MiB;
constexpr size_t WS_YB = 398 * MiB, WS_YC = 414 * MiB;
constexpr size_t WS_PU = 480 * MiB;
constexpr size_t WS_SINIT = 488 * MiB;
constexpr size_t WS_END = 492 * MiB;

constexpr int LDS_BYTES = 159744;

typedef unsigned short bf16_t;
typedef unsigned v4u __attribute__((ext_vector_type(4)));
typedef unsigned v2u __attribute__((ext_vector_type(2)));
typedef float f32x4 __attribute__((ext_vector_type(4)));
typedef float f32x16 __attribute__((ext_vector_type(16)));
typedef short bf16x8 __attribute__((ext_vector_type(8)));
#define LDS_WAIT() asm volatile("s_waitcnt lgkmcnt(0)" ::: "memory")
__device__ __forceinline__ unsigned f2bf(float f) { unsigned u = __float_as_uint(f); return (u + 0x7fffu + ((u >> 16) & 1u)) >> 16; }
typedef float f32x2_t __attribute__((ext_vector_type(2))); typedef __bf16 bf16x2_t __attribute__((ext_vector_type(2)));
__device__ __forceinline__ unsigned pk2(float lo, float hi) { f32x2_t v = {lo, hi}; bf16x2_t b = __builtin_convertvector(v, bf16x2_t); return __builtin_bit_cast(unsigned, b); }
__device__ __forceinline__ float bflo(unsigned w) { return __uint_as_float(w << 16); }
__device__ __forceinline__ float bfhi(unsigned w) { return __uint_as_float(w & 0xffff0000u); }
__device__ __forceinline__ float bf1(bf16_t v) { return __uint_as_float(((unsigned)v) << 16); }
__device__ __forceinline__ float sigm(float x) { return 1.0f / (1.0f + __expf(-x)); }
__device__ __forceinline__ float wave_sum(float v) {
#pragma unroll
    for (int o = 1; o < 64; o <<= 1) v += __shfl_xor(v, o);
    return v;
}
template <int CTRL> __device__ __forceinline__ float dppf(float x) { return __int_as_float(__builtin_amdgcn_update_dpp(0, __float_as_int(x), CTRL, 0xF, 0xF, true)); }
__device__ __forceinline__ float red16(float x) {
    x += dppf<0xB1>(x);
    x += dppf<0x4E>(x);
    x += dppf<0x141>(x);
    x += dppf<0x140>(x);
    return x;
}
__device__ __forceinline__ void unpack8(const v4u w, float* f) { f[0] = bflo(w.x); f[1] = bfhi(w.x); f[2] = bflo(w.y); f[3] = bfhi(w.y); f[4] = bflo(w.z); f[5] = bfhi(w.z); f[6] = bflo(w.w); f[7] = bfhi(w.w); }
__device__ __forceinline__ v4u pack8(const float* f) { v4u w; w.x = pk2(f[0], f[1]); w.y = pk2(f[2], f[3]); w.z = pk2(f[4], f[5]); w.w = pk2(f[6], f[7]); return w; }

struct Params { const void* in[40]; float* out; unsigned char* ws; };

__device__ __forceinline__ void conv_load(const float* __restrict__ W, int ldw, int k0, int n0, float (&wv_)[32], int lane) {
#pragma unroll
    for (int i = 0; i < 32; ++i) wv_[i] = W[(size_t)(k0 + 2 * i + (lane >> 5)) * ldw + n0 + (lane & 31)];
}
__device__ __forceinline__ void conv_store(const float (&wv_)[32], int k0, bf16_t* WT, int ldk, int drow0, int extra16, float* scr, int lane) {
#pragma unroll
    for (int i = 0; i < 32; ++i) scr[(2 * i + (lane >> 5)) * 33 + (lane & 31)] = wv_[i];
    LDS_WAIT();
    const int c = lane & 7;
#pragma unroll
    for (int j = 0; j < 4; ++j) { const int n = (lane >> 3) + 8 * j; const float* s = scr + (8 * c) * 33 + n;
        v4u o; o.x = pk2(s[0 * 33], s[1 * 33]); o.y = pk2(s[2 * 33], s[3 * 33]); o.z = pk2(s[4 * 33], s[5 * 33]); o.w = pk2(s[6 * 33], s[7 * 33]);
        const int row = drow0 + n + (n >= 16 ? extra16 : 0);
        *(v4u*)(WT + (size_t)row * ldk + k0 + 8 * c) = o; }
    LDS_WAIT();
}
__device__ __forceinline__ void conv_item(const float* __restrict__ W, int ldw, int k0, int n0, bf16_t* WT, int ldk, int drow0, int extra16, float* scr, int lane) {
    float wv_[32];
    conv_load(W, ldw, k0, n0, wv_, lane);
    conv_store(wv_, k0, WT, ldk, drow0, extra16, scr, lane);
}
struct ConvDesc { const float* W; int ldw, k0, n0; bf16_t* WT; int ldk, drow0, extra16; };
__device__ __forceinline__ ConvDesc ffn_desc(int r, const float* wg, const float* wu, const float* wd, bf16_t* GU, bf16_t* Dn) {
    ConvDesc d;
    if (r < 1408) { const int kb = r / 88, nb = r % 88; d = ConvDesc{wg, DFF, 64 * kb, 32 * nb, GU, 1024, 64 * nb, 16}; }
    else if (r < 2816) { r -= 1408; const int kb = r / 88, nb = r % 88; d = ConvDesc{wu, DFF, 64 * kb, 32 * nb, GU, 1024, 64 * nb + 16, 16}; }
    else { r -= 2816; const int kb = r / 32, nb = r % 32; d = ConvDesc{wd, 1024, 64 * kb, 32 * nb, Dn, DFF, 32 * nb, 0}; }
    return d;
}
__device__ __forceinline__ void zero_item(bf16_t* WT, int ldk, int row0, int k0, int lane) {
    const int c = lane & 7;
#pragma unroll
    for (int j = 0; j < 4; ++j) { const int n = (lane >> 3) + 8 * j; *(v4u*)(WT + (size_t)(row0 + n) * ldk + k0 + 8 * c) = (v4u){0u, 0u, 0u, 0u}; }
}
__device__ __forceinline__ void conv_ffn(const float* wg, const float* wu, const float* wd, unsigned char* ws, unsigned char* lds, int wg0) {
    PHASE_IDS; float* scr = (float*)(lds + wave * 8448);
    if (bid < wg0) return;
    const int gw_ = (bid - wg0) * 8 + wave, ngw_ = (G - wg0) * 8;
    bf16_t* GU = (bf16_t*)(ws + WA_GU); bf16_t* Dn = (bf16_t*)(ws + WA_D);
    for (int it = gw_; it < 3 * 1408; it += 2 * ngw_) {
        const int it2 = it + ngw_; const bool two = it2 < 3 * 1408;
        const ConvDesc a = ffn_desc(it, wg, wu, wd, GU, Dn), b = ffn_desc(two ? it2 : it, wg, wu, wd, GU, Dn);
        float wa[32], wb[32];
        conv_load(a.W, a.ldw, a.k0, a.n0, wa, lane);
        if (two) conv_load(b.W, b.ldw, b.k0, b.n0, wb, lane);
        conv_store(wa, a.k0, a.WT, a.ldk, a.drow0, a.extra16, scr, lane);
        if (two) conv_store(wb, b.k0, b.WT, b.ldk, b.drow0, b.extra16, scr, lane);
    }
}
__device__ __forceinline__ void conv_ffn_item(const float* wg, const float* wu, const float* wd, unsigned char* ws, unsigned char* lds, int item) {
    const int tid = opaque_tid(), lane = tid & 63, wave = __builtin_amdgcn_readfirstlane(tid >> 6); float* scr = (float*)(lds + wave * 8448);
    bf16_t* GU = (bf16_t*)(ws + WA_GU); bf16_t* Dn = (bf16_t*)(ws + WA_D);
    __syncthreads();
    for (int j = 0; j < 8; ++j) {
        int r = item * 64 + wave * 8 + j;
        if (r >= 3 * 1408) break;
        if (r < 1408) { const int kb = r / 88, nb = r % 88; conv_item(wg, DFF, 64 * kb, 32 * nb, GU, 1024, 64 * nb, 16, scr, lane); continue; } r -= 1408;
        if (r < 1408) { const int kb = r / 88, nb = r % 88; conv_item(wu, DFF, 64 * kb, 32 * nb, GU, 1024, 64 * nb + 16, 16, scr, lane); continue; } r -= 1408;
        { const int kb = r / 32, nb = r % 32; conv_item(wd, 1024, 64 * kb, 32 * nb, Dn, DFF, 32 * nb, 0, scr, lane); }
    }
}
__device__ __forceinline__ void conv_mixer(const Params& P, int l, unsigned char* lds) {
    PHASE_IDS; float* scr = (float*)(lds + wave * 8448);
    unsigned char* ws = opaque_ptr(P.ws);
    bf16_t* WIN = (bf16_t*)(ws + WB_IN); bf16_t* WLORA = (bf16_t*)(ws + WB_LORA); bf16_t* WUQ = (bf16_t*)(ws + WB_UQ); bf16_t* WUK = (bf16_t*)(ws + WB_UK);
    bf16_t* WUV = (bf16_t*)(ws + WB_UV); bf16_t* WOUT = (bf16_t*)(ws + WB_OUT); bf16_t* WO = (bf16_t*)(ws + WB_O);
    const float* w_in = GPF(P.in[9]) + (size_t)l * 1024 * 7584;
    const float* w_up = GPF(P.in[12]) + (size_t)l * 64 * 512;
    const float* a_up = GPF(P.in[14]) + (size_t)l * 64 * 512;
    const float* g_up = GPF(P.in[15]) + (size_t)l * 128 * 512;
    const float* vdown = (l > 0) ? GPF(P.in[21]) + (size_t)(l - 1) * 1024 * 32 : nullptr;
    const float* vup = (l > 0) ? GPF(P.in[23]) + (size_t)(l - 1) * 32 * 512 : nullptr;
    const float* w_uq = GPF(P.in[27]) + (size_t)l * 384 * 768;
    const float* w_ukv = GPF(P.in[29]) + (size_t)l * 256 * 1024;
    const float* w_o = GPF(P.in[34]) + (size_t)l * 1024 * 1024;
    constexpr int I_IN = 16 * 237, I_VD = 16, I_PAD = 32, I_LORA = 6 * 64, I_UQ = 6 * 24, I_UKV = 4 * 32, I_OUT = 3 * 256, I_O = 16 * 32;
    constexpr int NITEMS = I_IN + I_VD + I_PAD + I_LORA + I_UQ + I_UKV + I_OUT + I_O;
    for (int it = gw; it < NITEMS; it += ngw) {
        int r = it;
        if (r < I_IN) { const int kb = r / 237, nb = r % 237, n0 = 32 * nb; const int dr = n0 + (n0 < 1792 ? 0 : (n0 < 2464 ? 32 : 96));
            conv_item(w_in, 7584, 64 * kb, n0, WIN, 1024, dr, 0, scr, lane); continue; } r -= I_IN;
        if (r < I_VD) { if (l > 0) conv_item(vdown, 32, 64 * r, 0, WIN, 1024, C1_VRES, 0, scr, lane); else zero_item(WIN, 1024, C1_VRES, 64 * r, lane); continue; } r -= I_VD;
        if (r < I_PAD) { zero_item(WIN, 1024, 2496 + 32 * (r >> 4), 64 * (r & 15), lane); continue; } r -= I_PAD;
        if (r < I_LORA) { const int kb = r / 64, nb = r % 64; const int b = nb >> 4, nn = (32 * nb) & 511;
            const float* src = b == 0 ? w_up : (b == 1 ? a_up : (b == 2 ? g_up : vup));
            const int ks = b == 0 ? 0 : (b == 1 ? 64 : (b == 2 ? 128 : 256)), ke = b == 0 ? 64 : (b == 1 ? 128 : (b == 2 ? 256 : 288));
            const int c = lane & 7;
#pragma unroll
            for (int j = 0; j < 4; ++j) { const int n = (lane >> 3) + 8 * j; float f[8];
#pragma unroll
                for (int e = 0; e < 8; ++e) { const int k = 64 * kb + 8 * c + e; f[e] = (src != nullptr && k >= ks && k < ke) ? src[(size_t)(k - ks) * 512 + nn + n] : 0.f; }
                *(v4u*)(WLORA + (size_t)(32 * nb + n) * 384 + 64 * kb + 8 * c) = pack8(f); }
            continue; } r -= I_LORA;
        if (r < I_UQ) { const int kb = r / 24, nb = r % 24; conv_item(w_uq, 768, 64 * kb, 32 * nb, WUQ, 384, 32 * nb, 0, scr, lane); continue; } r -= I_UQ;
        if (r < I_UKV) { const int kb = r / 32, nb = r % 32, n0 = 32 * nb, h = n0 >> 7, j = n0 & 127;
            if (j < 64) conv_item(w_ukv, 1024, 64 * kb, n0, WUK, 256, h * 64 + j, 0, scr, lane); else conv_item(w_ukv, 1024, 64 * kb, n0, WUV, 256, h * 64 + j - 64, 0, scr, lane);
            continue; } r -= I_UKV;
        if (r < I_OUT) { const int br = r / 256, q = r % 256, kb = q / 32, nb = q % 32;
            const float* src = GPF(P.in[br == 0 ? 25 : (br == 1 ? 30 : 33)]) + (size_t)l * 512 * 1024;
            conv_item(src, 1024, 64 * kb, 32 * nb, WOUT + (size_t)br * 1024 * 512, 512, 32 * nb, 0, scr, lane); continue; } r -= I_OUT;
        { const int kb = r / 32, nb = r % 32; conv_item(w_o, 1024, 64 * kb, 32 * nb, WO, 1024, 32 * nb, 0, scr, lane); }
    }
}

__device__ __forceinline__ void phase_rowwise(const bf16_t* ysrc, const float* hin, float* hout, float wt, const float* g_post, const float* g_pre, bf16_t* xn) {
    PHASE_IDS;
    for (int row = gw; row < T; row += 2 * ngw) {
        const int rowb = row + ngw; const bool two = rowb < T; const int rb = two ? rowb : row;
        f32x4 ha[4], hb[4]; v2u ya[4], yb[4];
        { const f32x4* hr = (const f32x4*)(hin + (size_t)row * DM) + lane; const f32x4* hr2 = (const f32x4*)(hin + (size_t)rb * DM) + lane;
#pragma unroll
          for (int j = 0; j < 4; ++j) { ha[j] = hr[64 * j]; hb[j] = hr2[64 * j]; }
          if (ysrc) { const v2u* yr = (const v2u*)(ysrc + (size_t)row * DM) + lane; const v2u* yr2 = (const v2u*)(ysrc + (size_t)rb * DM) + lane;
#pragma unroll
            for (int j = 0; j < 4; ++j) { ya[j] = yr[64 * j]; yb[j] = yr2[64 * j]; } } }
#pragma unroll
        for (int half = 0; half < 2; ++half) {
            if (half == 1 && !two) break;
            const int r = half ? rowb : row;
            f32x4 h[4];
#pragma unroll
            for (int j = 0; j < 4; ++j) h[j] = half ? hb[j] : ha[j];
            if (ysrc) {
                f32x4 y[4]; float s = 0.f;
#pragma unroll
                for (int j = 0; j < 4; ++j) { const v2u w = half ? yb[j] : ya[j]; y[j] = (f32x4){bflo(w.x), bfhi(w.x), bflo(w.y), bfhi(w.y)}; s += (y[j].x * y[j].x + y[j].y * y[j].y) + (y[j].z * y[j].z + y[j].w * y[j].w); }
                const float rinv = wt * rsqrtf(wave_sum(s) * (1.f / DM) + NORM_EPS);
#pragma unroll
                for (int j = 0; j < 4; ++j) { const f32x4 g = *((const f32x4*)g_post + lane + 64 * j); h[j] = h[j] + y[j] * g * rinv; }
            }
            f32x4* ho = (f32x4*)(hout + (size_t)r * DM) + lane;
#pragma unroll
            for (int j = 0; j < 4; ++j) ho[64 * j] = h[j];
            if (g_pre) {
                float s = 0.f;
#pragma unroll
                for (int j = 0; j < 4; ++j) s += (h[j].x * h[j].x + h[j].y * h[j].y) + (h[j].z * h[j].z + h[j].w * h[j].w);
                const float rinv = rsqrtf(wave_sum(s) * (1.f / DM) + NORM_EPS);
                unsigned long long* o8 = (unsigned long long*)(xn + (size_t)r * DM) + lane;
#pragma unroll
                for (int j = 0; j < 4; ++j) { const f32x4 g = *((const f32x4*)g_pre + lane + 64 * j); const f32x4 v = h[j] * g * rinv;
                    o8[64 * j] = (unsigned long long)pk2(v.x, v.y) | ((unsigned long long)pk2(v.z, v.w) << 32); }
            }
        }
    }
}
#define LAS __attribute__((address_space(3)))
#define XB_TMO      128
#define XB_XCNT(j)  (256  + 64 * (j))
#define XB_XSUB(j)  (1280 + 64 * (j))
#define XB_XGEN(j)  (2304 + 64 * (j))
#define XB_TOP      3328
#define XB_TOPGEN   3392
#define XCD_BAR_WORDS 3456
#define XB_SPIN_CAP (1u << 18)

__device__ __forceinline__ unsigned xb_ld(unsigned* p)              { return __hip_atomic_load(p, __ATOMIC_RELAXED, __HIP_MEMORY_SCOPE_AGENT); }
__device__ __forceinline__ unsigned xb_add(unsigned* p, unsigned v) { return __hip_atomic_fetch_add(p, v, __ATOMIC_RELAXED, __HIP_MEMORY_SCOPE_AGENT); }
__device__ __forceinline__ unsigned xb_xcc_id() { return (unsigned)__builtin_amdgcn_s_getreg((3 << 11) | 20) & 0xFu; }
#define XB_SPIN(cond, bar) do { unsigned _sp = 0; while (cond) { __builtin_amdgcn_s_sleep(1); \
    if ((++_sp & 255u) == 0u) { if (xb_ld(&(bar)[XB_TMO])) break; if (_sp > XB_SPIN_CAP) { atomicAdd(&(bar)[XB_TMO], 1u); break; } } } } while (0)

struct XcdBarrier {
    unsigned* bar; unsigned x;
    volatile LAS unsigned* st;
};

__device__ __forceinline__ XcdBarrier xcd_barrier_post(unsigned* bar, volatile LAS unsigned* st) {
    XcdBarrier b; b.bar = bar; b.x = xb_xcc_id(); b.st = st;
    if (threadIdx.x == 0) (void)xb_add(&bar[XB_XCNT(b.x)], 1u);
    return b;
}
__device__ __forceinline__ void xcd_barrier_complete(unsigned* bar, unsigned x, unsigned& nloc, unsigned& nx) {
    const unsigned G = gridDim.x * gridDim.y * gridDim.z;
    unsigned sum, cnt, mine, sp = 0u;
    for (;;) {
        sum = 0u; cnt = 0u; mine = 0u;
#pragma unroll
        for (unsigned j = 0; j < 16; ++j) { const unsigned c = xb_ld(&bar[XB_XCNT(j)]); sum += c; cnt += (c > 0u) ? 1u : 0u; mine = (j == x) ? c : mine; }
        if (sum == G) break;
        __builtin_amdgcn_s_sleep(1);
        if ((++sp & 255u) == 0u) { if (xb_ld(&bar[XB_TMO])) break; if (sp > XB_SPIN_CAP) { atomicAdd(&bar[XB_TMO], 1u); break; } }
    }
    nloc = mine > 0u ? mine : 1u; nx = cnt > 0u ? cnt : 1u;
}

__device__ __forceinline__ void xcd_barrier(const XcdBarrier& b) {
    asm volatile("s_waitcnt vmcnt(0)" ::: "memory");
    __syncthreads();
    if (threadIdx.x == 0) {
        unsigned* bar = b.bar;
        __builtin_amdgcn_s_waitcnt(0);
        unsigned nloc = b.st[0], nx = b.st[1];
        if (nloc == 0u) { xcd_barrier_complete(bar, b.x, nloc, nx); b.st[0] = nloc; b.st[1] = nx; }
        const unsigned old = xb_add(&bar[XB_XSUB(b.x)], 1u);
        const unsigned gen = old / nloc;
        if (old + 1u == (gen + 1u) * nloc) {
            __builtin_amdgcn_fence(__ATOMIC_RELEASE, "agent");
            asm volatile("s_waitcnt vmcnt(0)" ::: "memory");
            const unsigned og = xb_add(&bar[XB_TOP], 1u);
            const unsigned tg = og / nx;
            if (og + 1u == (tg + 1u) * nx) xb_add(&bar[XB_TOPGEN], 1u);
            else XB_SPIN(xb_ld(&bar[XB_TOPGEN]) == tg, bar);
            __builtin_amdgcn_fence(__ATOMIC_ACQUIRE, "agent");
            xb_add(&bar[XB_XGEN(b.x)], 1u);
            asm volatile("s_waitcnt vmcnt(0)" ::: "memory");
        } else {
            XB_SPIN(xb_ld(&bar[XB_XGEN(b.x)]) == gen, bar);
            __builtin_amdgcn_fence(__ATOMIC_ACQUIRE, "agent");
            asm volatile("s_waitcnt vmcnt(0)" ::: "memory");
        }
    }
    __syncthreads();
}
__device__ __forceinline__ void phase_tables(const Params& P) {
    PHASE_IDS;
    float* COS = (float*)(opaque_ptr(P.ws) + WS_COS); float* SIN = (float*)(opaque_ptr(P.ws) + WS_SIN); float* LB = (float*)(opaque_ptr(P.ws) + WS_LB);
    const int* pos = GPI(P.in[1]);
    for (int e = gtid; e < T * 16; e += gthreads) {
        const int t = e >> 4, i = e & 15;
        const double inv_freq = exp(-(double)i * (9.210340371976184 / 16.0));
        double rev = (double)pos[t] * inv_freq * 0.15915494309189535;
        rev -= floor(rev);
        const float x = (float)rev;
        COS[e] = __builtin_amdgcn_cosf(x); SIN[e] = __builtin_amdgcn_sinf(x);
    }
    if (gtid < 512) {
        const float* lbw = GPF(P.in[31]);
        float v[NL], mx = -1e30f, s = 0.f;
#pragma unroll
        for (int l = 0; l < NL; ++l) { v[l] = lbw[l * 512 + gtid]; mx = fmaxf(mx, v[l]); }
#pragma unroll
        for (int l = 0; l < NL; ++l) { v[l] = __expf(v[l] - mx); s += v[l]; }
        float c = 0.f; const float p0 = v[0] / s;
#pragma unroll
        for (int l = 0; l < NL; ++l) { c += v[l] / s; LB[l * 512 + gtid] = c - p0; }
    }
}

__device__ __forceinline__ void phase_prep(const Params& P, int l) {
    PHASE_IDS;
    unsigned char* ws = opaque_ptr(P.ws);
    const bf16_t* P1 = (const bf16_t*)(ws + WS_P1);
    bf16_t* RB = (bf16_t*)(ws + WS_RB); bf16_t* KB = (bf16_t*)(ws + WS_KB); bf16_t* VB = (bf16_t*)(ws + WS_VB); bf16_t* VF = (bf16_t*)(ws + WS_VFIRST);
    bf16_t* LIN = (bf16_t*)(ws + WS_LIN); bf16_t* CQN = (bf16_t*)(ws + WS_CQN); bf16_t* CKVN = (bf16_t*)(ws + WS_CKVN); bf16_t* KROPE = (bf16_t*)(ws + WS_KROPE);
    const float* COS = (const float*)(ws + WS_COS); const float* SIN = (const float*)(ws + WS_SIN);
    const float* mu = GPF(P.in[10]) + (size_t)l * 1792;
    const float* vmu = (l > 0) ? GPF(P.in[22]) + (size_t)(l - 1) * 32 : nullptr;
    const float* qg = GPF(P.in[26]) + (size_t)l * 384;
    const float* kvg = GPF(P.in[28]) + (size_t)l * 256;
    for (int t = gw; t < T; t += ngw) {
        const unsigned* cur = (const unsigned*)(P1 + (size_t)t * NP1);
        const unsigned* prv = (const unsigned*)(P1 + (size_t)(t > 0 ? t - 1 : 0) * NP1);
        const bool hasp = t > 0;
#pragma unroll
        for (int i = 0; i < 14; ++i) {
            const int j = lane + 64 * i, col = 2 * j;
            const unsigned cw = cur[j], pw = hasp ? prv[j] : 0u;
            const float c0 = bflo(cw), c1 = bfhi(cw), p0 = bflo(pw), p1 = bfhi(pw);
            float m0 = c0 + (p0 - c0) * mu[col], m1 = c1 + (p1 - c1) * mu[col + 1];
            if (i < 4) { *(unsigned*)(RB + (size_t)t * 512 + col) = pk2(m0, m1); }
            else if (i < 8) { *(unsigned*)(KB + (size_t)t * 512 + col - 512) = pk2(m0, m1); }
            else if (i < 12) { const unsigned w = pk2(m0, m1); *(unsigned*)(VB + (size_t)t * 512 + col - 1024) = w; if (l == 0) *(unsigned*)(VF + (size_t)t * 512 + col - 1024) = w; }
            else {
                if (col < 1600) { m0 = tanhf(m0); m1 = tanhf(m1); } else if (col >= 1664) { m0 = sigm(m0); m1 = sigm(m1); }
                *(unsigned*)(LIN + (size_t)t * 384 + col - 1536) = pk2(m0, m1);
            }
        }
        if (lane < 16) {
            unsigned w = 0u;
            if (l > 0) { const int j = (C1_VRES >> 1) + lane; const unsigned cw = cur[j], pw = hasp ? prv[j] : 0u;
                const float c0 = bflo(cw), c1 = bfhi(cw), p0 = bflo(pw), p1 = bfhi(pw);
                w = pk2(c0 + (p0 - c0) * vmu[2 * lane], c1 + (p1 - c1) * vmu[2 * lane + 1]); }
            *(unsigned*)(LIN + (size_t)t * 384 + 256 + 2 * lane) = w;
        } else {
            *(unsigned*)(LIN + (size_t)t * 384 + 288 + 2 * (lane - 16)) = 0u;
        }
        {
            float c[6]; float s = 0.f;
#pragma unroll
            for (int i = 0; i < 3; ++i) { const unsigned w = cur[(C1_CQ >> 1) + lane + 64 * i]; c[2 * i] = bflo(w); c[2 * i + 1] = bfhi(w); s += c[2 * i] * c[2 * i] + c[2 * i + 1] * c[2 * i + 1]; }
            const float rinv = rsqrtf(wave_sum(s) * (1.f / 384.f) + NORM_EPS);
#pragma unroll
            for (int i = 0; i < 3; ++i) { const int cc = 2 * (lane + 64 * i); *(unsigned*)(CQN + (size_t)t * 384 + cc) = pk2(c[2 * i] * rinv * qg[cc], c[2 * i + 1] * rinv * qg[cc + 1]); }
        }
        {
            float c[4]; float s = 0.f;
#pragma unroll
            for (int i = 0; i < 2; ++i) { const unsigned w = cur[(C1_CKV >> 1) + lane + 64 * i]; c[2 * i] = bflo(w); c[2 * i + 1] = bfhi(w); s += c[2 * i] * c[2 * i] + c[2 * i + 1] * c[2 * i + 1]; }
            const float rinv = rsqrtf(wave_sum(s) * (1.f / 256.f) + NORM_EPS);
#pragma unroll
            for (int i = 0; i < 2; ++i) { const int cc = 2 * (lane + 64 * i); *(unsigned*)(CKVN + (size_t)t * 256 + cc) = pk2(c[2 * i] * rinv * kvg[cc], c[2 * i + 1] * rinv * kvg[cc + 1]); }
        }
        if (lane < 16) {
            const bf16_t* row = P1 + (size_t)t * NP1 + C1_KR;
            const float x1 = bf1(row[lane]), x2 = bf1(row[16 + lane]);
            const float cs = COS[t * 16 + lane], sn = SIN[t * 16 + lane];
            KROPE[(size_t)t * 32 + lane] = (bf16_t)f2bf(x1 * cs - x2 * sn);
            KROPE[(size_t)t * 32 + 16 + lane] = (bf16_t)f2bf(x2 * cs + x1 * sn);
        }
    }
}

__device__ __forceinline__ void hgrn_a_unit(const Params& P, int l, int unit, unsigned char* lds) {
    const int tid = opaque_tid();
    const int c = unit >> 2, h = unit & 3, t0 = c * 64;
    const bf16_t* P2 = (const bf16_t*)(opaque_ptr(P.ws) + WS_P2);
    const float* LB = (const float*)(opaque_ptr(P.ws) + WS_LB) + l * 512 + h * 128;
    float* kd = (float*)lds;
    float* kg = (float*)(lds + 32768);
    bf16_t* vT = (bf16_t*)(lds + 65536);
    bf16_t* kdT = (bf16_t*)(lds + 102400);
    float* bl = (float*)(lds + 98304);
    __syncthreads();
#pragma unroll
    for (int i = 0; i < 8; ++i) {
        const int e = tid + 512 * i, s = e >> 6, k2 = (e & 63) * 2;
        const unsigned fw = *(const unsigned*)(P2 + (size_t)(t0 + s) * NP2 + C2_HF + h * 128 + k2);
        const unsigned iw = *(const unsigned*)(P2 + (size_t)(t0 + s) * NP2 + C2_HI + h * 128 + k2);
        const float lb0 = LB[k2], lb1 = LB[k2 + 1];
        const float z0 = bflo(fw), z1 = bfhi(fw);
        const float f0 = lb0 + (1.f - lb0) * sigm(z0), f1 = lb1 + (1.f - lb1) * sigm(z1);
        kd[s * 128 + k2] = __logf(fmaxf(f0, 1e-6f)); kd[s * 128 + k2 + 1] = __logf(fmaxf(f1, 1e-6f));
        kg[s * 128 + k2] = (1.f - lb0) * sigm(-z0); kg[s * 128 + k2 + 1] = (1.f - lb1) * sigm(-z1);
        vT[k2 * 72 + s] = (bf16_t)(iw & 0xffffu); vT[(k2 + 1) * 72 + s] = (bf16_t)(iw >> 16);
    }
    __syncthreads();
    {
        float* tot = bl + 128;
        const int k = tid & 127, seg = tid >> 7; float b = 0.f;
#pragma unroll 4
        for (int s = 16 * seg; s < 16 * seg + 16; ++s) { b += kd[s * 128 + k]; kd[s * 128 + k] = b; }
        tot[seg * 128 + k] = b;
        __syncthreads();
        float off = 0.f;
        if (seg > 0) off += tot[k]; if (seg > 1) off += tot[128 + k]; if (seg > 2) off += tot[256 + k];
#pragma unroll 4
        for (int s = 16 * seg; s < 16 * seg + 16; ++s) kd[s * 128 + k] += off;
        if (seg == 3) { const float bt_ = b + off; bl[k] = bt_; ((float*)(opaque_ptr(P.ws) + WS_DVEC))[(size_t)unit * 128 + k] = __expf(bt_); }
    }
    __syncthreads();
#pragma unroll
    for (int i = 0; i < 16; ++i) { const int e = tid + 512 * i, k = e & 127, s = e >> 7; kdT[k * 72 + s] = (bf16_t)f2bf(kg[e] * __expf(bl[k] - kd[e])); }
    __syncthreads();
    {
        const int lane = tid & 63, w = __builtin_amdgcn_readfirstlane(tid >> 6), lr = lane & 15, kgp = lane >> 4;
        const bf16x8 B0 = *(const bf16x8*)(vT + (16 * w + lr) * 72 + 8 * kgp), B1 = *(const bf16x8*)(vT + (16 * w + lr) * 72 + 32 + 8 * kgp);
        bf16_t* DS = (bf16_t*)(opaque_ptr(P.ws) + WS_DS) + (size_t)unit * 16384;
#pragma unroll
        for (int kt_ = 0; kt_ < 8; ++kt_) {
            const bf16x8 A0 = *(const bf16x8*)(kdT + (16 * kt_ + lr) * 72 + 8 * kgp), A1 = *(const bf16x8*)(kdT + (16 * kt_ + lr) * 72 + 32 + 8 * kgp);
            f32x4 a4 = (f32x4){0.f, 0.f, 0.f, 0.f};
            a4 = __builtin_amdgcn_mfma_f32_16x16x32_bf16(A0, B0, a4, 0, 0, 0);
            a4 = __builtin_amdgcn_mfma_f32_16x16x32_bf16(A1, B1, a4, 0, 0, 0);
            *(v2u*)(DS + (16 * w + lr) * 128 + 16 * kt_ + 4 * kgp) = (v2u){pk2(a4[0], a4[1]), pk2(a4[2], a4[3])};
        }
    }
}
__device__ __forceinline__ void hgrn_b(const Params& P, unsigned char* lds) {
    const int tid = opaque_tid(), el = tid & 127, qtr = __builtin_amdgcn_readfirstlane(tid >> 7);
    float* xd = (float*)lds;
    float* xs = xd + 512;
    for (int it = blockIdx.x; it < 512; it += gridDim.x) {
        const int h = it >> 7, kvb = (it & 127) * 128;
        bf16_t* dsb = (bf16_t*)(opaque_ptr(P.ws) + WS_DS) + ((size_t)(64 * qtr) * 4 + h) * 16384 + kvb;
        const float* dvb = (const float*)(opaque_ptr(P.ws) + WS_DVEC) + ((size_t)(64 * qtr) * 4 + h) * 128;
        float ds[64], dv[64];
#pragma unroll
        for (int i = 0; i < 64; ++i) { ds[i] = bf1(dsb[(size_t)i * 65536 + el]); dv[i] = dvb[(size_t)i * 512 + el]; }
        float D = 1.f, S = 0.f;
#pragma unroll
        for (int i = 0; i < 64; ++i) { S = dv[i] * S + ds[i]; D *= dv[i]; }
        __syncthreads();
        xd[qtr * 128 + el] = D; xs[qtr * 128 + el] = S;
        __syncthreads();
        S = 0.f;
        for (int j = 0; j < qtr; ++j) S = xd[j * 128 + el] * S + xs[j * 128 + el];
#pragma unroll
        for (int i = 0; i < 64; ++i) { dsb[(size_t)i * 65536 + el] = (bf16_t)f2bf(S); S = dv[i] * S + ds[i]; }
    }
}
__device__ __forceinline__ void hgrn_c_unit(const Params& P, int l, int unit, unsigned char* lds) {
    const int tid = opaque_tid();
    const int c = unit >> 2, h = unit & 3, t0 = c * 64;
    const bf16_t* P2 = (const bf16_t*)(opaque_ptr(P.ws) + WS_P2);
    const float* LB = (const float*)(opaque_ptr(P.ws) + WS_LB) + l * 512 + h * 128;
    constexpr int RS = 132;
    float* qs = (float*)lds;
    float* bs = (float*)(lds + 33792);
    float* ks = (float*)(lds + 67584);
    float* kt = (float*)(lds + 101376);
    float* at = (float*)(lds + 135168);
    float* bl = (float*)(lds + 152576);
    __syncthreads();
#pragma unroll
    for (int i = 0; i < 9; ++i) { const int e = tid + 512 * i; if (e < 64 * 68) at[e] = 0.f; }
#pragma unroll
    for (int i = 0; i < 8; ++i) {
        const int e = tid + 512 * i, s = e >> 6, k2 = (e & 63) * 2;
        const unsigned qw = *(const unsigned*)(P2 + (size_t)(t0 + s) * NP2 + C2_HQ + h * 128 + k2);
        const unsigned fw = *(const unsigned*)(P2 + (size_t)(t0 + s) * NP2 + C2_HF + h * 128 + k2);
        const float lb0 = LB[k2], lb1 = LB[k2 + 1];
        const float z0 = bflo(fw), z1 = bfhi(fw), q0 = bflo(qw), q1 = bfhi(qw);
        const float f0 = lb0 + (1.f - lb0) * sigm(z0), f1 = lb1 + (1.f - lb1) * sigm(z1);
        bs[s * RS + k2] = __logf(fmaxf(f0, 1e-6f)) * LOG2E; bs[s * RS + k2 + 1] = __logf(fmaxf(f1, 1e-6f)) * LOG2E;
        ks[s * RS + k2] = (1.f - lb0) * sigm(-z0); ks[s * RS + k2 + 1] = (1.f - lb1) * sigm(-z1);
        qs[s * RS + k2] = q0 * sigm(q0); qs[s * RS + k2 + 1] = q1 * sigm(q1);
    }
    __syncthreads();
    {
        float* tot = bl + 1024;
        const int k = tid & 127, seg = tid >> 7; float b = 0.f;
#pragma unroll 4
        for (int s = 16 * seg; s < 16 * seg + 16; ++s) { b += bs[s * RS + k]; bs[s * RS + k] = b; }
        tot[seg * 128 + k] = b;
        __syncthreads();
        float off = 0.f;
        if (seg > 0) off += tot[k]; if (seg > 1) off += tot[128 + k]; if (seg > 2) off += tot[256 + k];
#pragma unroll 4
        for (int s = 16 * seg; s < 16 * seg + 16; ++s) { const float v_ = bs[s * RS + k] + off; bs[s * RS + k] = v_; if ((s & 7) == 7) bl[(s >> 3) * 128 + k] = v_; }
    }
    __syncthreads();
    {
        bf16_t* k16 = (bf16_t*)kt;
#pragma unroll 1
        for (int pass = 0; pass < 2; ++pass) {
            const int p = tid + 512 * pass;
            if (p < 544) {
                int t, s;
                if (p < 288) { const int blk = p / 36, idx = p - 36 * blk; int tl = 0; while (((tl + 1) * (tl + 2) >> 1) <= idx) ++tl; t = 8 * blk + tl; s = 8 * blk + idx - (tl * (tl + 1) >> 1); }
                else { const int q_ = p - 288, m = q_ >> 6; t = 16 * m + 8 + ((q_ >> 3) & 7); s = 16 * m + (q_ & 7); }
                float a = 0.f;
                for (int k4 = 0; k4 < 128; k4 += 4) {
                    const f32x4 q4 = *(const f32x4*)(qs + t * RS + k4), bt = *(const f32x4*)(bs + t * RS + k4), k4v = *(const f32x4*)(ks + s * RS + k4), b4 = *(const f32x4*)(bs + s * RS + k4);
                    a += (q4[0] * k4v[0] * __builtin_amdgcn_exp2f(bt[0] - b4[0]) + q4[1] * k4v[1] * __builtin_amdgcn_exp2f(bt[1] - b4[1]))
                       + (q4[2] * k4v[2] * __builtin_amdgcn_exp2f(bt[2] - b4[2]) + q4[3] * k4v[3] * __builtin_amdgcn_exp2f(bt[3] - b4[3])); }
                at[t * 68 + s] = a;
            }
        }
#pragma unroll
        for (int i = 0; i < 4; ++i) { const int e = tid + 512 * i, s = e >> 5, k4 = (e & 31) * 4;
            const f32x4 kg4 = *(const f32x4*)(ks + s * RS + k4), b4 = *(const f32x4*)(bs + s * RS + k4), bj = *(const f32x4*)(bl + (2 * (s >> 4) + 1) * 128 + k4);
            *(v2u*)(k16 + s * 136 + k4) = (v2u){pk2(kg4[0] * __builtin_amdgcn_exp2f(bj[0] - b4[0]), kg4[1] * __builtin_amdgcn_exp2f(bj[1] - b4[1])),
                                               pk2(kg4[2] * __builtin_amdgcn_exp2f(bj[2] - b4[2]), kg4[3] * __builtin_amdgcn_exp2f(bj[3] - b4[3]))}; }
        __syncthreads();
        {
            const int lane = tid & 63, w = __builtin_amdgcn_readfirstlane(tid >> 6), lr = lane & 15, kgp = lane >> 4;
            if (w < 6) {
                const int m = (w == 0) ? 1 : (w < 3 ? 2 : 3), n = (w == 0) ? 0 : (w < 3 ? w - 1 : w - 3);
                const int trow = 16 * m + lr, srow = 16 * n + lr;
                f32x4 a4 = (f32x4){0.f, 0.f, 0.f, 0.f};
#pragma unroll
                for (int kstep = 0; kstep < 4; ++kstep) {
                    const int k0 = 32 * kstep + 8 * kgp;
                    const f32x4 q0 = *(const f32x4*)(qs + trow * RS + k0), q1 = *(const f32x4*)(qs + trow * RS + k0 + 4);
                    const f32x4 t0_ = *(const f32x4*)(bs + trow * RS + k0), t1_ = *(const f32x4*)(bs + trow * RS + k0 + 4);
                    const f32x4 j0 = *(const f32x4*)(bl + (2 * n + 1) * 128 + k0), j1 = *(const f32x4*)(bl + (2 * n + 1) * 128 + k0 + 4);
                    const bf16x8 A = __builtin_bit_cast(bf16x8, ((v4u){
                        pk2(q0[0] * __builtin_amdgcn_exp2f(t0_[0] - j0[0]), q0[1] * __builtin_amdgcn_exp2f(t0_[1] - j0[1])), pk2(q0[2] * __builtin_amdgcn_exp2f(t0_[2] - j0[2]), q0[3] * __builtin_amdgcn_exp2f(t0_[3] - j0[3])),
                        pk2(q1[0] * __builtin_amdgcn_exp2f(t1_[0] - j1[0]), q1[1] * __builtin_amdgcn_exp2f(t1_[1] - j1[1])), pk2(q1[2] * __builtin_amdgcn_exp2f(t1_[2] - j1[2]), q1[3] * __builtin_amdgcn_exp2f(t1_[3] - j1[3]))}));
                    const bf16x8 B = *(const bf16x8*)(k16 + srow * 136 + k0);
                    a4 = __builtin_amdgcn_mfma_f32_16x16x32_bf16(A, B, a4, 0, 0, 0);
                }
#pragma unroll
                for (int r = 0; r < 4; ++r) at[(16 * m + 4 * kgp + r) * 68 + 16 * n + lr] = a4[r];
            }
        }
    }
    __syncthreads();
#pragma unroll
    for (int i = 0; i < 16; ++i) { const int e = tid + 512 * i, s = e >> 7, k = e & 127; qs[s * RS + k] *= __builtin_amdgcn_exp2f(bs[s * RS + k]); }
    __syncthreads();
    bf16_t* S0T = (bf16_t*)(lds + 33792);
    bf16_t* vT = (bf16_t*)(lds + 68608);
    float* os = kt;
    {
        const bf16_t* DS = (const bf16_t*)(opaque_ptr(P.ws) + WS_DS) + (size_t)unit * 16384;
#pragma unroll
        for (int i = 0; i < 4; ++i) { const int e = tid + 512 * i, v = e >> 4, c8 = (e & 15) * 8; *(v4u*)(S0T + v * 136 + c8) = *(const v4u*)(DS + v * 128 + c8); }
#pragma unroll
        for (int i = 0; i < 8; ++i) { const int e = tid + 512 * i, s = e >> 6, k2 = (e & 63) * 2;
            const unsigned iw = *(const unsigned*)(P2 + (size_t)(t0 + s) * NP2 + C2_HI + h * 128 + k2);
            vT[k2 * 72 + s] = (bf16_t)(iw & 0xffffu); vT[(k2 + 1) * 72 + s] = (bf16_t)(iw >> 16); }
    }
    __syncthreads();
    {
        const int lane = tid & 63, w = __builtin_amdgcn_readfirstlane(tid >> 6), tb = w & 3, vh = w >> 2, lr = lane & 15, kg = lane >> 4;
        const int trow = 16 * tb + lr;
        f32x4 acc4[4];
#pragma unroll
        for (int n = 0; n < 4; ++n) acc4[n] = (f32x4){0.f, 0.f, 0.f, 0.f};
#pragma unroll
        for (int kstep = 0; kstep < 6; ++kstep) {
            const float* src = (kstep < 2) ? (at + trow * 68 + 32 * kstep + 8 * kg) : (qs + trow * RS + 32 * (kstep - 2) + 8 * kg);
            const f32x4 x0 = *(const f32x4*)src, x1 = *(const f32x4*)(src + 4);
            const bf16x8 A = __builtin_bit_cast(bf16x8, ((v4u){pk2(x0[0], x0[1]), pk2(x0[2], x0[3]), pk2(x1[0], x1[1]), pk2(x1[2], x1[3])}));
#pragma unroll
            for (int n = 0; n < 4; ++n) { const int col = 64 * vh + 16 * n + lr;
                const bf16x8 B = (kstep < 2) ? *(const bf16x8*)(vT + col * 72 + 32 * kstep + 8 * kg) : *(const bf16x8*)(S0T + col * 136 + 32 * (kstep - 2) + 8 * kg);
                acc4[n] = __builtin_amdgcn_mfma_f32_16x16x32_bf16(A, B, acc4[n], 0, 0, 0); }
        }
#pragma unroll
        for (int n = 0; n < 4; ++n)
#pragma unroll
            for (int r = 0; r < 4; ++r) os[(16 * tb + 4 * kg + r) * RS + 64 * vh + 16 * n + lr] = acc4[n][r];
    }
    __syncthreads();
    {
        const int t = tid >> 3, vg = tid & 7;
        float o[16];
#pragma unroll
        for (int j = 0; j < 4; ++j) { const f32x4 o4 = *(const f32x4*)(os + t * RS + vg * 16 + 4 * j); o[4 * j] = o4[0]; o[4 * j + 1] = o4[1]; o[4 * j + 2] = o4[2]; o[4 * j + 3] = o4[3]; }
        float ss = 0.f;
#pragma unroll
        for (int j = 0; j < 16; ++j) ss += o[j] * o[j];
        ss += __shfl_xor(ss, 1); ss += __shfl_xor(ss, 2); ss += __shfl_xor(ss, 4);
        const float rinv = rsqrtf(ss * (1.f / 128.f) + NORM_EPS);
        const float* ng = GPF(P.in[32]) + (size_t)l * 128 + vg * 16;
        const bf16_t* cg = P2 + (size_t)(t0 + t) * NP2 + C2_HG + h * 128 + vg * 16;
        const v4u g0 = *(const v4u*)cg, g1 = *(const v4u*)(cg + 8);
        float g[16]; unpack8(g0, g); unpack8(g1, g + 8);
        float r[16];
#pragma unroll
        for (int j = 0; j < 16; ++j) r[j] = o[j] * rinv * ng[j] * (g[j] * sigm(g[j]));
        bf16_t* yc = (bf16_t*)(opaque_ptr(P.ws) + WS_YC) + (size_t)(t0 + t) * 512 + h * 128 + vg * 16;
        *(v4u*)yc = pack8(r); *(v4u*)(yc + 8) = pack8(r + 8);
    }
}
__device__ __forceinline__ void phase_prep2(const Params& P, int l) {
    PHASE_IDS;
    unsigned char* ws = opaque_ptr(P.ws);
    bf16_t* LORA = (bf16_t*)(ws + WS_LORA); bf16_t* KB = (bf16_t*)(ws + WS_KB); bf16_t* VB = (bf16_t*)(ws + WS_VB); const bf16_t* VF = (const bf16_t*)(ws + WS_VFIRST);
    bf16_t* Q = (bf16_t*)(ws + WS_Q);
    const float* COS = (const float*)(ws + WS_COS); const float* SIN = (const float*)(ws + WS_SIN);
    const int ch = lane * 8;
    float w0[8], a0[8], kkw[8], kaw[8], v0[8];
#pragma unroll
    for (int e = 0; e < 8; ++e) {
        w0[e] = (GPF(P.in[11]))[l * 512 + ch + e]; a0[e] = (GPF(P.in[13]))[l * 512 + ch + e];
        kkw[e] = (GPF(P.in[16]))[l * 512 + ch + e]; kaw[e] = (GPF(P.in[17]))[l * 512 + ch + e];
        v0[e] = (l > 0) ? (GPF(P.in[24]))[(l - 1) * 512 + ch + e] : 0.f;
    }
    for (int t = gw; t < T; t += ngw) {
        bf16_t* lr = LORA + (size_t)t * 2048 + ch;
        float lw[8], la[8], lv[8], k[8];
        unpack8(*(const v4u*)lr, lw); unpack8(*(const v4u*)(lr + 512), la); unpack8(*(const v4u*)(lr + 1536), lv);
        unpack8(*(const v4u*)(KB + (size_t)t * 512 + ch), k);
        float ew[8], kk[8], bb[8], km[8]; float ss = 0.f;
#pragma unroll
        for (int e = 0; e < 8; ++e) {
            const float x = -(w0[e] + lw[e]);
            const float sp = fmaxf(x, 0.f) + __logf(1.f + __expf(-fabsf(x)));
            ew[e] = __expf(-sp - 0.5f);
            kk[e] = k[e] * kkw[e]; ss += kk[e] * kk[e];
        }
        ss += __shfl_xor(ss, 1); ss += __shfl_xor(ss, 2); ss += __shfl_xor(ss, 4);
        const float kinv = 1.f / fmaxf(sqrtf(ss), 1e-12f);
#pragma unroll
        for (int e = 0; e < 8; ++e) {
            const float a = sigm(a0[e] + la[e]);
            kk[e] *= kinv; bb[e] = kk[e] * a; km[e] = k[e] * (1.f + (a - 1.f) * kaw[e]);
        }
        *(v4u*)lr = pack8(ew); *(v4u*)(lr + 512) = pack8(kk); *(v4u*)(lr + 1536) = pack8(bb);
        *(v4u*)(KB + (size_t)t * 512 + ch) = pack8(km);
        if (l > 0) {
            float v[8], vf[8];
            unpack8(*(const v4u*)(VB + (size_t)t * 512 + ch), v); unpack8(*(const v4u*)(VF + (size_t)t * 512 + ch), vf);
#pragma unroll
            for (int e = 0; e < 8; ++e) v[e] = v[e] + (vf[e] - v[e]) * sigm(v0[e] + lv[e]);
            *(v4u*)(VB + (size_t)t * 512 + ch) = pack8(v);
        }
        {
            const int h = lane >> 3, sub = lane & 7;
            bf16_t* qh = Q + (size_t)t * 768 + h * 96;
            float qn[8]; unpack8(*(const v4u*)(qh + 8 * sub), qn);
#pragma unroll
            for (int e = 0; e < 8; ++e) qn[e] *= QSCALE;
            const unsigned x1w = *(const unsigned*)(qh + 64 + 2 * sub), x2w = *(const unsigned*)(qh + 80 + 2 * sub);
            const float c0 = COS[t * 16 + 2 * sub], c1 = COS[t * 16 + 2 * sub + 1], s0 = SIN[t * 16 + 2 * sub], s1 = SIN[t * 16 + 2 * sub + 1];
            const float x10 = bflo(x1w), x11 = bfhi(x1w), x20 = bflo(x2w), x21 = bfhi(x2w);
            *(v4u*)(qh + 8 * sub) = pack8(qn);
            *(unsigned*)(qh + 64 + 2 * sub) = pk2((x10 * c0 - x20 * s0) * QSCALE, (x11 * c1 - x21 * s1) * QSCALE);
            *(unsigned*)(qh + 80 + 2 * sub) = pk2((x20 * c0 + x10 * s0) * QSCALE, (x21 * c1 + x11 * s1) * QSCALE);
        }
    }
}

constexpr int RW_NC = 32, RW_LC = T / RW_NC;
typedef float f2v __attribute__((ext_vector_type(2)));
#define LO2(v4) (__builtin_shufflevector((v4), (v4), 0, 1))
#define HI2(v4) (__builtin_shufflevector((v4), (v4), 2, 3))
__device__ __forceinline__ float red8(float x) { x += dppf<0xB1>(x); x += dppf<0x4E>(x); x += dppf<0x141>(x); return x; }
template <int MODE>
__device__ __forceinline__ void rwkv_scan_item(const Params& P, int l, unsigned char* lds, int h, int t0, int nchunk, const float* init, float* fin) {
    const int tid = opaque_tid(), lane = tid & 63, wave = tid >> 6, rowgrp = lane >> 3, kq = lane & 7;
    const int row = wave * 8 + rowgrp;
    unsigned char* ws = opaque_ptr(P.ws);
    const bf16_t* LORA = (const bf16_t*)(ws + WS_LORA); const bf16_t* KB = (const bf16_t*)(ws + WS_KB); const bf16_t* RB = (const bf16_t*)(ws + WS_RB); const bf16_t* VB = (const bf16_t*)(ws + WS_VB);
    bf16_t* YA = (bf16_t*)(ws + WS_YA);
    constexpr int BUF = 49152;
    float* ybuf = (float*)(lds + 2 * BUF);
    const bf16_t* src[3]; int dsto[3], sstride[3];
    const int hi8 = tid >> 8, q = tid & 255, st = q >> 3, c8 = q & 7;
    {
        const int a0 = hi8, a1 = 2 + hi8, a2 = 4 + hi8;
        src[0] = (a0 == 0 ? LORA : LORA + 512) + (size_t)st * 2048 + h * 64 + c8 * 8; sstride[0] = 2048; dsto[0] = (a0 * 2048 + st * 64 + c8 * 8) * 4;
        src[1] = (a1 == 2 ? LORA + 1536 + (size_t)st * 2048 : KB + (size_t)st * 512) + h * 64 + c8 * 8; sstride[1] = (a1 == 2) ? 2048 : 512; dsto[1] = (a1 * 2048 + st * 64 + c8 * 8) * 4;
        src[2] = (a2 == 4 ? RB : VB) + (size_t)st * 512 + h * 64 + c8 * 8; sstride[2] = 512; dsto[2] = (a2 * 2048 + st * 64 + c8 * 8) * 4;
    }
    const bool ld2 = !(MODE == 2 && hi8 == 1);
    f2v S2[4];
    if (MODE == 2) {
#pragma unroll
        for (int j = 0; j < 4; ++j) S2[j] = (f2v){(8 * kq + 2 * j == row) ? 1.f : 0.f, (8 * kq + 2 * j + 1 == row) ? 1.f : 0.f};
    } else if (MODE == 0 && init != nullptr) {
        const f32x4 i0 = *(const f32x4*)(init + row * 64 + 8 * kq), i1 = *(const f32x4*)(init + row * 64 + 8 * kq + 4);
        S2[0] = LO2(i0); S2[1] = HI2(i0); S2[2] = LO2(i1); S2[3] = HI2(i1);
    } else {
#pragma unroll
        for (int j = 0; j < 4; ++j) S2[j] = (f2v){0.f, 0.f};
    }
    const int fs = tid >> 4, fv = (tid & 15) * 4;
    f32x4 rk4 = {0.f, 0.f, 0.f, 0.f}, gg4 = rk4, gb4 = rk4;
    if (MODE == 0) { rk4 = *(const f32x4*)(GPF(P.in[18]) + l * 512 + h * 64 + fv); gg4 = *(const f32x4*)(GPF(P.in[19]) + l * 512 + h * 64 + fv); gb4 = *(const f32x4*)(GPF(P.in[20]) + l * 512 + h * 64 + fv); }
    v4u regs[3];
#define RW_LOAD(tt) do { regs[0] = *(const v4u*)(src[0] + (size_t)(tt) * sstride[0]); regs[1] = *(const v4u*)(src[1] + (size_t)(tt) * sstride[1]); if (ld2) regs[2] = *(const v4u*)(src[2] + (size_t)(tt) * sstride[2]); } while (0)
#define RW_STORE(bufp) do { \
        { float f[8]; unpack8(regs[0], f); if (hi8 == 0) { _Pragma("unroll") for (int e = 0; e < 8; ++e) f[e] = __expf(-f[e]); } else { _Pragma("unroll") for (int e = 0; e < 8; ++e) f[e] = -f[e]; } \
          float* d = (float*)((bufp) + dsto[0]); *(f32x4*)d = (f32x4){f[0], f[1], f[2], f[3]}; *(f32x4*)(d + 4) = (f32x4){f[4], f[5], f[6], f[7]}; } \
        { float f[8]; unpack8(regs[1], f); float* d = (float*)((bufp) + dsto[1]); *(f32x4*)d = (f32x4){f[0], f[1], f[2], f[3]}; *(f32x4*)(d + 4) = (f32x4){f[4], f[5], f[6], f[7]}; } \
        if (ld2) { float f[8]; unpack8(regs[2], f); float* d = (float*)((bufp) + dsto[2]); *(f32x4*)d = (f32x4){f[0], f[1], f[2], f[3]}; *(f32x4*)(d + 4) = (f32x4){f[4], f[5], f[6], f[7]}; } } while (0)
    __syncthreads();
    RW_LOAD(t0);
    RW_STORE(lds);
    __syncthreads();
    for (int c = 0; c < nchunk; ++c) {
        const int tc = t0 + 32 * c;
        const bool more = (c + 1 < nchunk);
        if (more) RW_LOAD(tc + 32);
        const float* buf = (const float*)(lds + (c & 1) * BUF);
#pragma unroll 2
        for (int s = 0; s < 32; ++s) {
            const float* bs_ = buf + s * 64 + 8 * kq;
            const f32x4 nk0 = *(const f32x4*)(bs_ + 2048), nk1 = *(const f32x4*)(bs_ + 2048 + 4);
            f2v p = S2[0] * LO2(nk0); p = S2[1] * HI2(nk0) + p; p = S2[2] * LO2(nk1) + p; p = S2[3] * HI2(nk1) + p;
            float sa = p.x + p.y;
            const f32x4 dw0 = *(const f32x4*)(bs_), dw1 = *(const f32x4*)(bs_ + 4);
            const f32x4 bb0 = *(const f32x4*)(bs_ + 4096), bb1 = *(const f32x4*)(bs_ + 4096 + 4);
            f2v tq[4];
            if (MODE == 2) { tq[0] = S2[0] * LO2(dw0); tq[1] = S2[1] * HI2(dw0); tq[2] = S2[2] * LO2(dw1); tq[3] = S2[3] * HI2(dw1); }
            else {
                const f32x4 kv0 = *(const f32x4*)(bs_ + 6144), kv1 = *(const f32x4*)(bs_ + 6144 + 4);
                const float vv = buf[10240 + s * 64 + row]; const f2v vv2 = {vv, vv};
                tq[0] = S2[0] * LO2(dw0) + vv2 * LO2(kv0); tq[1] = S2[1] * HI2(dw0) + vv2 * HI2(kv0); tq[2] = S2[2] * LO2(dw1) + vv2 * LO2(kv1); tq[3] = S2[3] * HI2(dw1) + vv2 * HI2(kv1);
            }
            sa = red8(sa);
            const f2v sa2 = {sa, sa};
            S2[0] = sa2 * LO2(bb0) + tq[0]; S2[1] = sa2 * HI2(bb0) + tq[1]; S2[2] = sa2 * LO2(bb1) + tq[2]; S2[3] = sa2 * HI2(bb1) + tq[3];
            if (MODE == 0) {
                const f32x4 rv0 = *(const f32x4*)(bs_ + 8192), rv1 = *(const f32x4*)(bs_ + 8192 + 4);
                f2v py = S2[0] * LO2(rv0); py = S2[1] * HI2(rv0) + py; py = S2[2] * LO2(rv1) + py; py = S2[3] * HI2(rv1) + py;
                float y = py.x + py.y;
                y = red8(y);
                if (kq == 0) ybuf[s * 64 + row] = y;
            }
        }
        if (more) RW_STORE(lds + ((c + 1) & 1) * BUF);
        __syncthreads();
        if (MODE == 0) {
            const f32x4 y4 = *(const f32x4*)(ybuf + fs * 64 + fv);
            const f32x4 r4 = *(const f32x4*)(buf + 8192 + fs * 64 + fv), k4 = *(const f32x4*)(buf + 6144 + fs * 64 + fv), v4 = *(const f32x4*)(buf + 10240 + fs * 64 + fv);
            const v2u gw_ = *(const v2u*)(LORA + (size_t)(tc + fs) * 2048 + 1024 + h * 64 + fv);
            float sm = (y4[0] + y4[1]) + (y4[2] + y4[3]);
            float bsum = (r4[0] * k4[0] * rk4[0] + r4[1] * k4[1] * rk4[1]) + (r4[2] * k4[2] * rk4[2] + r4[3] * k4[3] * rk4[3]);
            sm = red16(sm); bsum = red16(bsum);
            const float mean = sm * (1.f / 64.f);
            const f32x4 d4 = y4 - mean;
            float qv = (d4[0] * d4[0] + d4[1] * d4[1]) + (d4[2] * d4[2] + d4[3] * d4[3]);
            qv = red16(qv);
            const float rstd = rsqrtf(qv * (1.f / 64.f) + 64e-5f);
            const f32x4 o4 = d4 * rstd * gg4 + gb4 + v4 * bsum;
            *(v2u*)(YA + (size_t)(tc + fs) * 512 + h * 64 + fv) = (v2u){pk2(o4[0] * bflo(gw_.x), o4[1] * bfhi(gw_.x)), pk2(o4[2] * bflo(gw_.y), o4[3] * bfhi(gw_.y))};
            __syncthreads();
        }
    }
#undef RW_LOAD
#undef RW_STORE
    if (MODE != 0) { *(f32x4*)(fin + row * 64 + 8 * kq) = (f32x4){S2[0].x, S2[0].y, S2[1].x, S2[1].y}; *(f32x4*)(fin + row * 64 + 8 * kq + 4) = (f32x4){S2[2].x, S2[2].y, S2[3].x, S2[3].y}; }
}
__device__ __forceinline__ void rwkv_scan_pu(const Params& P, unsigned char* lds, int h, int t0, int nchunk, float* finP, float* finU) {
    const int tid = opaque_tid(), lane = tid & 63, wave = tid >> 6, rowgrp = lane >> 3, kq = lane & 7;
    const int row = wave * 8 + rowgrp;
    unsigned char* ws = opaque_ptr(P.ws);
    const bf16_t* LORA = (const bf16_t*)(ws + WS_LORA); const bf16_t* KB = (const bf16_t*)(ws + WS_KB); const bf16_t* VB = (const bf16_t*)(ws + WS_VB);
    constexpr int BUF = 49152;
    const bf16_t* src[3]; int dsto[3], sstride[3];
    const int hi8 = tid >> 8, q = tid & 255, st = q >> 3, c8 = q & 7;
    src[0] = (hi8 == 0 ? LORA : LORA + 512) + (size_t)st * 2048 + h * 64 + c8 * 8; sstride[0] = 2048; dsto[0] = (hi8 * 2048 + st * 64 + c8 * 8) * 4;
    src[1] = (hi8 == 0 ? LORA + 1536 + (size_t)st * 2048 : KB + (size_t)st * 512) + h * 64 + c8 * 8; sstride[1] = (hi8 == 0) ? 2048 : 512; dsto[1] = ((2 + hi8) * 2048 + st * 64 + c8 * 8) * 4;
    src[2] = VB + (size_t)st * 512 + h * 64 + c8 * 8; sstride[2] = 512; dsto[2] = (5 * 2048 + st * 64 + c8 * 8) * 4;
    const bool ld2 = hi8 == 1;
    f2v SP2[4], SU2[4];
#pragma unroll
    for (int j = 0; j < 4; ++j) { SP2[j] = (f2v){(8 * kq + 2 * j == row) ? 1.f : 0.f, (8 * kq + 2 * j + 1 == row) ? 1.f : 0.f}; SU2[j] = (f2v){0.f, 0.f}; }
    v4u regs[3];
#define PU_LOAD(tt) do { regs[0] = *(const v4u*)(src[0] + (size_t)(tt) * sstride[0]); regs[1] = *(const v4u*)(src[1] + (size_t)(tt) * sstride[1]); if (ld2) regs[2] = *(const v4u*)(src[2] + (size_t)(tt) * sstride[2]); } while (0)
#define PU_STORE(bufp) do { \
        { float f[8]; unpack8(regs[0], f); if (hi8 == 0) { _Pragma("unroll") for (int e = 0; e < 8; ++e) f[e] = __expf(-f[e]); } else { _Pragma("unroll") for (int e = 0; e < 8; ++e) f[e] = -f[e]; } \
          float* d = (float*)((bufp) + dsto[0]); *(f32x4*)d = (f32x4){f[0], f[1], f[2], f[3]}; *(f32x4*)(d + 4) = (f32x4){f[4], f[5], f[6], f[7]}; } \
        { float f[8]; unpack8(regs[1], f); float* d = (float*)((bufp) + dsto[1]); *(f32x4*)d = (f32x4){f[0], f[1], f[2], f[3]}; *(f32x4*)(d + 4) = (f32x4){f[4], f[5], f[6], f[7]}; } \
        if (ld2) { float f[8]; unpack8(regs[2], f); float* d = (float*)((bufp) + dsto[2]); *(f32x4*)d = (f32x4){f[0], f[1], f[2], f[3]}; *(f32x4*)(d + 4) = (f32x4){f[4], f[5], f[6], f[7]}; } } while (0)
    __syncthreads();
    PU_LOAD(t0);
    PU_STORE(lds);
    __syncthreads();
    for (int c = 0; c < nchunk; ++c) {
        const int tc = t0 + 32 * c;
        const bool more = (c + 1 < nchunk);
        if (more) PU_LOAD(tc + 32);
        const float* buf = (const float*)(lds + (c & 1) * BUF);
#pragma unroll 2
        for (int s = 0; s < 32; ++s) {
            const float* bs_ = buf + s * 64 + 8 * kq;
            const f32x4 nk0 = *(const f32x4*)(bs_ + 2048), nk1 = *(const f32x4*)(bs_ + 2048 + 4);
            f2v pP = SP2[0] * LO2(nk0); pP = SP2[1] * HI2(nk0) + pP; pP = SP2[2] * LO2(nk1) + pP; pP = SP2[3] * HI2(nk1) + pP;
            f2v pU = SU2[0] * LO2(nk0); pU = SU2[1] * HI2(nk0) + pU; pU = SU2[2] * LO2(nk1) + pU; pU = SU2[3] * HI2(nk1) + pU;
            float saP = pP.x + pP.y, saU = pU.x + pU.y;
            const f32x4 dw0 = *(const f32x4*)(bs_), dw1 = *(const f32x4*)(bs_ + 4);
            const f32x4 bb0 = *(const f32x4*)(bs_ + 4096), bb1 = *(const f32x4*)(bs_ + 4096 + 4);
            const f32x4 kv0 = *(const f32x4*)(bs_ + 6144), kv1 = *(const f32x4*)(bs_ + 6144 + 4);
            const float vv = buf[10240 + s * 64 + row]; const f2v vv2 = {vv, vv};
            f2v tp[4], tu[4];
            tp[0] = SP2[0] * LO2(dw0); tp[1] = SP2[1] * HI2(dw0); tp[2] = SP2[2] * LO2(dw1); tp[3] = SP2[3] * HI2(dw1);
            tu[0] = SU2[0] * LO2(dw0) + vv2 * LO2(kv0); tu[1] = SU2[1] * HI2(dw0) + vv2 * HI2(kv0); tu[2] = SU2[2] * LO2(dw1) + vv2 * LO2(kv1); tu[3] = SU2[3] * HI2(dw1) + vv2 * HI2(kv1);
            saP += dppf<0xB1>(saP); saU += dppf<0xB1>(saU);
            saP += dppf<0x4E>(saP); saU += dppf<0x4E>(saU);
            saP += dppf<0x141>(saP); saU += dppf<0x141>(saU);
            const f2v sP2 = {saP, saP}, sU2 = {saU, saU};
            SP2[0] = sP2 * LO2(bb0) + tp[0]; SP2[1] = sP2 * HI2(bb0) + tp[1]; SP2[2] = sP2 * LO2(bb1) + tp[2]; SP2[3] = sP2 * HI2(bb1) + tp[3];
            SU2[0] = sU2 * LO2(bb0) + tu[0]; SU2[1] = sU2 * HI2(bb0) + tu[1]; SU2[2] = sU2 * LO2(bb1) + tu[2]; SU2[3] = sU2 * HI2(bb1) + tu[3];
        }
        if (more) PU_STORE(lds + ((c + 1) & 1) * BUF);
        __syncthreads();
    }
#undef PU_LOAD
#undef PU_STORE
    if (finP != nullptr) { *(f32x4*)(finP + row * 64 + 8 * kq) = (f32x4){SP2[0].x, SP2[0].y, SP2[1].x, SP2[1].y}; *(f32x4*)(finP + row * 64 + 8 * kq + 4) = (f32x4){SP2[2].x, SP2[2].y, SP2[3].x, SP2[3].y}; }
    *(f32x4*)(finU + row * 64 + 8 * kq) = (f32x4){SU2[0].x, SU2[0].y, SU2[1].x, SU2[1].y}; *(f32x4*)(finU + row * 64 + 8 * kq + 4) = (f32x4){SU2[2].x, SU2[2].y, SU2[3].x, SU2[3].y};
}
__device__ __forceinline__ void rwkv_pass2(const Params& P, unsigned char* lds, int h, int part) {
    const int tid = opaque_tid(), vl = tid >> 5, v = part * 16 + vl, kq = tid & 31;
    const float* PU = (const float*)(opaque_ptr(P.ws) + WS_PU) + (size_t)h * RW_NC * 8192;
    float* SI = (float*)(opaque_ptr(P.ws) + WS_SINIT) + (size_t)h * RW_NC * 4096;
    typedef float f32x2 __attribute__((ext_vector_type(2)));
    float* Ss = (float*)lds;
    float* Pl = (float*)(lds + 4352);
    const int pr = tid >> 3, pc = (tid & 7) * 8;
    __syncthreads();
    f32x2 a = *(const f32x2*)(PU + 4096 + v * 64 + 2 * kq);
    f32x4 p0, p1; f32x2 u;
    { const float* pcur = PU + (size_t)8192; p0 = *(const f32x4*)(pcur + pr * 64 + pc); p1 = *(const f32x4*)(pcur + pr * 64 + pc + 4); u = *(const f32x2*)(pcur + 4096 + v * 64 + 2 * kq); }
    for (int c = 1; c < RW_NC; ++c) {
        *(f32x2*)(SI + (size_t)c * 4096 + v * 64 + 2 * kq) = a;
        if (c + 1 == RW_NC) break;
        Ss[vl * 65 + 2 * kq] = a[0]; Ss[vl * 65 + 2 * kq + 1] = a[1];
        *(f32x4*)(Pl + pr * 64 + pc) = p0; *(f32x4*)(Pl + pr * 64 + pc + 4) = p1;
        a = u;
        if (c + 2 < RW_NC) { const float* pn = PU + (size_t)(c + 1) * 8192; p0 = *(const f32x4*)(pn + pr * 64 + pc); p1 = *(const f32x4*)(pn + pr * 64 + pc + 4); u = *(const f32x2*)(pn + 4096 + v * 64 + 2 * kq); }
        __syncthreads();
#pragma unroll 16
        for (int i = 0; i < 64; ++i) { const float s = Ss[vl * 65 + i]; const f32x2 q = *(const f32x2*)(Pl + i * 64 + 2 * kq); a += q * s; }
        __syncthreads();
    }
}
__device__ __forceinline__ int crow(int r, int hi) { return (r & 3) + 8 * (r >> 2) + 4 * hi; }
__device__ __forceinline__ void attn_qk(const unsigned char* Kb, const bf16x8 (&qr)[6], const f32x16& negm, f32x16& s0, f32x16& s1, int r32, int hi) {
    constexpr int KROW = 208;
#pragma unroll
    for (int d0 = 0; d0 < 6; ++d0) {
        const bf16x8 a0 = *(const bf16x8*)(Kb + r32 * KROW + d0 * 32 + hi * 16);
        const bf16x8 a1 = *(const bf16x8*)(Kb + (32 + r32) * KROW + d0 * 32 + hi * 16);
        s0 = __builtin_amdgcn_mfma_f32_32x32x16_bf16(a0, qr[d0], d0 == 0 ? negm : s0, 0, 0, 0);
        s1 = __builtin_amdgcn_mfma_f32_32x32x16_bf16(a1, qr[d0], d0 == 0 ? negm : s1, 0, 0, 0);
    }
}
__device__ __forceinline__ void attn_mask(f32x16& s0, f32x16& s1, int k0, int qg, int hi) {
#pragma unroll
    for (int r = 0; r < 16; ++r) { const int key = k0 + crow(r, hi); if (key > qg) s0[r] = -1e30f; if (key + 32 > qg) s1[r] = -1e30f; }
}
#define MX3(a, b, c) __builtin_fmaxf(__builtin_fmaxf((a), (b)), (c))
#define SBAR() __builtin_amdgcn_sched_barrier(0)
#define PINF(x) asm volatile("" : "+v"(x))
#define ATT_GAP(A_, B_) do { _Pragma("unroll") for (int e = (A_); e < (B_); ++e) { float x_ = (e < 16) ? c0[e & 15] : c1[e & 15]; PINF(x_); x_ = __builtin_amdgcn_exp2f(x_); PINF(x_); if (e < 16) { c0[e & 15] = x_; ps0 += x_; } else { c1[e & 15] = x_; ps1 += x_; } } \
    _Pragma("unroll") for (int p = (A_) / 2; p < (B_) / 2; ++p) { const float lo_ = (2 * p < 16) ? c0[(2 * p) & 15] : c1[(2 * p) & 15], hi_ = (2 * p + 1 < 16) ? c0[(2 * p + 1) & 15] : c1[(2 * p + 1) & 15]; unsigned w_ = pk2(lo_, hi_); PINF(w_); pw[p >> 2][p & 3] = w_; } } while (0)
__device__ __forceinline__ void attn_unit(const Params& P, unsigned char* lds, int h, int qb) {
    const int tid = opaque_tid(), lane = tid & 63, wave = __builtin_amdgcn_readfirstlane(tid >> 6), r32 = lane & 31, hi = lane >> 5;
    unsigned char* ws = opaque_ptr(P.ws);
    const bf16_t* Q = (const bf16_t*)(ws + WS_Q); const bf16_t* KN = (const bf16_t*)(ws + WS_KNOPE); const bf16_t* KR = (const bf16_t*)(ws + WS_KROPE);
    const bf16_t* VT = (const bf16_t*)(ws + WS_VT); bf16_t* YB = (bf16_t*)(ws + WS_YB);
    constexpr int KROW = 208, VROW = 136, KBUF = 64 * KROW, VBUF = 64 * VROW;
    constexpr float THR = 8.0f;
    const int q0 = qb * 256, qw0 = q0 + wave * 32, NT = (q0 + 256) >> 6, qg = qw0 + r32;
    const int ntw = (qw0 + 31) / 64 + 1;
    const int kkey = tid >> 3, kch = tid & 7, rkey = (tid & 255) >> 2, rch = tid & 3;
    const bf16_t* kn_src = KN + (size_t)kkey * 512 + h * 64 + kch * 8;
    const bf16_t* kr_src = KR + (size_t)rkey * 32 + rch * 8;
    const bf16_t* vt_src = VT + (size_t)(h * 64 + kkey) * T + kch * 8;
    const int kn_dst = kkey * KROW + kch * 16, kr_dst = rkey * KROW + 128 + rch * 16, vt_dst = 2 * KBUF + kkey * VROW + kch * 16;
    const bool has_kr = tid < 256;
    bf16x8 qr[6];
#pragma unroll
    for (int d0 = 0; d0 < 6; ++d0) qr[d0] = *(const bf16x8*)(Q + (size_t)(qw0 + r32) * 768 + h * 96 + d0 * 16 + hi * 8);
    f32x16 o0, o1, negm;
#pragma unroll
    for (int r = 0; r < 16; ++r) { o0[r] = 0.f; o1[r] = 0.f; negm[r] = 0.f; }
    float m = 0.f, lsum = 0.f;
    v4u rkn, rkr = (v4u){0u, 0u, 0u, 0u}, rvt;
#define AT_LOADK(tile) do { const int kk0_ = (tile) * 64; rkn = *(const v4u*)(kn_src + (size_t)kk0_ * 512); if (has_kr) rkr = *(const v4u*)(kr_src + (size_t)kk0_ * 32); } while (0)
#define AT_LOADV(tile) do { rvt = *(const v4u*)(vt_src + (tile) * 64); } while (0)
#define AT_STOREK(b) do { unsigned char* nb_ = lds + (b) * KBUF; *(v4u*)(nb_ + kn_dst) = rkn; if (has_kr) *(v4u*)(nb_ + kr_dst) = rkr; } while (0)
#define AT_STOREV(b) do { unsigned char* nv_ = lds + (b) * VBUF; *(v2u*)(nv_ + vt_dst) = (v2u){rvt.x, rvt.y}; *(v2u*)(nv_ + vt_dst + 8) = (v2u){rvt.z, rvt.w}; } while (0)
    __syncthreads();
    AT_LOADK(0); AT_LOADV(0); AT_STOREK(0); AT_STOREV(0);
    AT_LOADK(1); AT_STOREK(1);
    AT_LOADK(2); AT_LOADV(1);
    __syncthreads();
    f32x16 c0, c1, n0, n1;
    attn_qk(lds, qr, negm, c0, c1, r32, hi);
    if (63 > qw0) attn_mask(c0, c1, 0, qg, hi);
    __syncthreads();
    for (int t = 0; t < NT; ++t) {
        const bool act = t < ntw, actn = (t + 1) < ntw;
        if (act) {
            float mx = MX3(c0[0], c0[1], c1[0]);
            mx = MX3(mx, c1[1], c0[2]);
#pragma unroll
            for (int r = 2; r < 16; r += 2) { mx = MX3(mx, c0[r], c0[r + 1]); mx = MX3(mx, c1[r], c1[r + 1]); }
            mx = fmaxf(mx, __shfl_xor(mx, 32));
            if (t == 0 || __any(mx > THR)) {
                const float dl = (t == 0) ? mx : fmaxf(mx, 0.f), f = __builtin_amdgcn_exp2f(-dl);
                m += dl; lsum *= f;
#pragma unroll
                for (int r = 0; r < 16; ++r) { c0[r] -= dl; c1[r] -= dl; o0[r] *= f; o1[r] *= f; negm[r] = -m; }
            }
        }
        float ps0 = 0.f, ps1 = 0.f;
        v4u pw[4];
        if (act && actn) {
            const unsigned char* Kn = lds + ((t + 1) & 1) * KBUF + r32 * KROW + hi * 16;
            SBAR();
#pragma unroll
            for (int g = 0; g < 6; ++g) {
                const bf16x8 ka = *(const bf16x8*)(Kn + g * 32), kb = *(const bf16x8*)(Kn + 32 * KROW + g * 32);
                n0 = __builtin_amdgcn_mfma_f32_32x32x16_bf16(ka, qr[g], g == 0 ? negm : n0, 0, 0, 0);
                SBAR();
                ATT_GAP((32 * (2 * g)) / 12, (32 * (2 * g + 1)) / 12);
                SBAR();
                n1 = __builtin_amdgcn_mfma_f32_32x32x16_bf16(kb, qr[g], g == 0 ? negm : n1, 0, 0, 0);
                SBAR();
                ATT_GAP((32 * (2 * g + 1)) / 12, (32 * (2 * g + 2)) / 12);
                SBAR();
            }
            if ((t + 1) * 64 + 63 > qw0) attn_mask(n0, n1, (t + 1) * 64, qg, hi);
        } else if (act) {
            ATT_GAP(0, 32);
        }
        if (act) {
            lsum += ps0 + ps1;
            const unsigned char* Vb = lds + 2 * KBUF + (t & 1) * VBUF;
#pragma unroll
            for (int ks = 0; ks < 4; ++ks) {
                const bf16x8 pa = __builtin_bit_cast(bf16x8, pw[ks]);
                const unsigned char* va = Vb + r32 * VROW + (16 * ks + 4 * hi) * 2;
                const v2u l0 = *(const v2u*)va, h0 = *(const v2u*)(va + 16);
                const v2u l1 = *(const v2u*)(va + 32 * VROW), h1 = *(const v2u*)(va + 32 * VROW + 16);
                const bf16x8 vf0 = __builtin_bit_cast(bf16x8, ((v4u){l0.x, l0.y, h0.x, h0.y}));
                const bf16x8 vf1 = __builtin_bit_cast(bf16x8, ((v4u){l1.x, l1.y, h1.x, h1.y}));
                o0 = __builtin_amdgcn_mfma_f32_32x32x16_bf16(vf0, pa, o0, 0, 0, 0);
                o1 = __builtin_amdgcn_mfma_f32_32x32x16_bf16(vf1, pa, o1, 0, 0, 0);
            }
        }
        if (t + 2 < NT) AT_STOREK(t & 1);
        if (t + 1 < NT) AT_STOREV((t + 1) & 1);
        if (t + 3 < NT) AT_LOADK(t + 3);
        if (t + 2 < NT) AT_LOADV(t + 2);
        __syncthreads();
        c0 = n0; c1 = n1;
    }
#undef AT_LOADK
#undef AT_LOADV
#undef AT_STOREK
#undef AT_STOREV
    lsum += __shfl_xor(lsum, 32);
    const float inv = 1.f / lsum;
    bf16_t* yrow = YB + (size_t)(qw0 + r32) * 512 + h * 64;
#pragma unroll
    for (int g = 0; g < 4; ++g) {
        const int dv = 8 * g + 4 * hi;
        *(v2u*)(yrow + dv) = (v2u){pk2(o0[4 * g] * inv, o0[4 * g + 1] * inv), pk2(o0[4 * g + 2] * inv, o0[4 * g + 3] * inv)};
        *(v2u*)(yrow + 32 + dv) = (v2u){pk2(o1[4 * g] * inv, o1[4 * g + 1] * inv), pk2(o1[4 * g + 2] * inv, o1[4 * g + 3] * inv)};
    }
}

constexpr int RW_I1 = (RW_NC - 1) * 8;
constexpr int Q_CONV0 = RW_I1 + 512 + 1024, Q_P20 = Q_CONV0 + 66, Q_END = Q_P20 + 32, Q_SPLIT = 300;
#define GEMM_CALL1(EPI, Ap, Bp, M_, N_, K_, E) { pg8::Gemm g_{(const pg8::bf16_t*)(Ap), (const pg8::bf16_t*)(Bp), (M_), (N_), (K_)}; pg8::StaticOrder S_; S_.init((M_), (N_), G, bid); \
    pg8::gemm_phase<EPI, pg8::StaticOrder, true, true>((PG8_LAS unsigned char*)lds, g_, S_, (E)); }
#ifndef PROBE_M
#define PROBE_M 0
#endif
#ifndef PROBE_S
#define PROBE_S 0
#endif
#define GSYNC() do { XcdBarrier xb_; xb_.bar = (unsigned*)(opaque_ptr(P.ws) + WS_CTL) + 4096; xb_.x = xb_xcc_id(); xb_.st = (volatile LAS unsigned*)((LAS unsigned char*)lds + LDS_BYTES - 64); xcd_barrier(xb_); for (int s_ = 0; s_ < PROBE_S; ++s_) xcd_barrier(xb_); } while (0)
#ifndef PROBE_G
#define PROBE_G 0
#endif
#define GEMM_CALL(EPI, Ap, Bp, M_, N_, K_, E) for (int rep_ = 0; rep_ < 1 + PROBE_G; ++rep_) { pg8::Gemm g_{(const pg8::bf16_t*)(Ap), (const pg8::bf16_t*)(Bp), (M_), (N_), (K_)}; pg8::StaticOrder S_; S_.init((M_), (N_), G, bid); \
    pg8::gemm_phase<EPI, pg8::StaticOrder, true, true>((PG8_LAS unsigned char*)lds, g_, S_, (E)); }

#define WSB (opaque_ptr(P.ws))
#define HRES ((float*)(GAS1 float*)(P.out))
#define XNB ((bf16_t*)(WSB + WS_XN))
#define YB32 ((bf16_t*)(WSB + WS_Y))
#define ACTB ((bf16_t*)(WSB + WS_ACT))
#define CTLW ((unsigned*)(WSB + WS_CTL))
__global__ void __launch_bounds__(512, 2) fwd_kernel(Params P) {
    extern __shared__ __attribute__((aligned(16))) unsigned char lds[];
    cg::grid_group grid = cg::this_grid();
    const int bid = blockIdx.x, G = gridDim.x;
    volatile LAS unsigned* xst = (volatile LAS unsigned*)((LAS unsigned char*)lds + LDS_BYTES - 64);
    if (threadIdx.x < 4) xst[threadIdx.x] = 0u;
    __syncthreads();
    (void)xcd_barrier_post((unsigned*)(opaque_ptr(P.ws) + WS_CTL) + 4096, xst);
    int* qslot = (int*)(lds + LDS_BYTES - 16);

    phase_tables(P);
    if (PROBE_M & 4) conv_ffn(GPF(P.in[4]), GPF(P.in[5]), GPF(P.in[6]), WSB, lds, 0);
    conv_ffn(GPF(P.in[4]), GPF(P.in[5]), GPF(P.in[6]), WSB, lds, 0);
    phase_rowwise(nullptr, GPF(P.in[0]), HRES, 0.f, nullptr, GPF(P.in[2]), XNB);
    grid.sync();
    GSYNC();

#pragma unroll 1
    for (int l = 0; l < NL; ++l) {
#pragma unroll 1
        for (int f = 0; f < 2; ++f) {

#ifndef SKIP_G1
            { pg8::EpiSwiGLU E{ACTB, DFF}; GEMM_CALL(pg8::EpiSwiGLU, XNB, WSB + WA_GU, T, 2 * DFF, DM, E); }
#endif

            GSYNC();

#ifndef SKIP_G2
            { pg8::EpiBf16Split E{(pg8::bf16_t*)YB32, DM, 1 << 30, nullptr, 0}; GEMM_CALL(pg8::EpiBf16Split, ACTB, WSB + WA_D, T, DM, DFF, E); }
#endif

            GSYNC();
            if (f == 1) {
                const float* gpost = GPF(P.in[36]) + (size_t)l * DM;
                const float* gpre = (l + 1 < NL) ? GPF(P.in[2]) + (size_t)(l + 1) * DM : nullptr;
                if (PROBE_M & 8) phase_rowwise(YB32, HRES, (float*)ACTB, 0.5f, gpost, gpre, XNB);
                phase_rowwise(YB32, HRES, HRES, 0.5f, gpost, gpre, XNB);
                if ((PROBE_M & 4) && l + 1 < NL) conv_ffn(GPF(P.in[4]) + (size_t)(l + 1) * DM * DFF, GPF(P.in[5]) + (size_t)(l + 1) * DM * DFF, GPF(P.in[6]) + (size_t)(l + 1) * DM * DFF, WSB, lds, 0);
                if (l + 1 < NL) conv_ffn(GPF(P.in[4]) + (size_t)(l + 1) * DM * DFF, GPF(P.in[5]) + (size_t)(l + 1) * DM * DFF, GPF(P.in[6]) + (size_t)(l + 1) * DM * DFF, WSB, lds, 0);
                GSYNC();
                continue;
            }
            if (PROBE_M & 8) phase_rowwise(YB32, HRES, (float*)ACTB, 0.5f, GPF(P.in[3]) + (size_t)l * DM, GPF(P.in[7]) + (size_t)l * DM, XNB);
            phase_rowwise(YB32, HRES, HRES, 0.5f, GPF(P.in[3]) + (size_t)l * DM, GPF(P.in[7]) + (size_t)l * DM, XNB);

#ifndef SKIP_CM
            if (PROBE_M & 4) conv_mixer(P, l, lds);
            conv_mixer(P, l, lds);
#endif

            GSYNC();

#ifndef SKIP_G3
            { pg8::EpiBf16Split E{(pg8::bf16_t*)(WSB + WS_P1), NP1, NP1 / 256, (pg8::bf16_t*)(WSB + WS_P2), NP2}; GEMM_CALL(pg8::EpiBf16Split, XNB, WSB + WB_IN, T, NP1 + NP2, DM, E); }
#endif

            GSYNC();

#ifndef SKIP_PREP
            for (int rep2 = 0; rep2 < 1 + ((PROBE_M & 2) ? 1 : 0); ++rep2) {
            phase_prep(P, l);
#endif


#ifndef SKIP_HA
            for (int u = bid; u < 1024; u += G) hgrn_a_unit(P, l, u, lds);
            }
#endif

            GSYNC();

#ifndef SKIP_HB
            hgrn_b(P, lds);
#endif

            __syncthreads();
#pragma unroll 1
            for (int gi = 0; gi < 4; ++gi) {
                const unsigned char* Ap; const unsigned char* Bp; unsigned char* Op; int M_, N_, K_, ld;
                if (gi == 0) { Ap = WSB + WS_LIN; Bp = WSB + WB_LORA; Op = WSB + WS_LORA; M_ = T; N_ = 2048; K_ = 384; ld = 2048; }
                else if (gi == 1) { Ap = WSB + WS_CQN; Bp = WSB + WB_UQ; Op = WSB + WS_Q; M_ = T; N_ = 768; K_ = 384; ld = 768; }
                else if (gi == 2) { Ap = WSB + WS_CKVN; Bp = WSB + WB_UK; Op = WSB + WS_KNOPE; M_ = T; N_ = 512; K_ = 256; ld = 512; }
                else { Ap = WSB + WB_UV; Bp = WSB + WS_CKVN; Op = WSB + WS_VT; M_ = 512; N_ = T; K_ = 256; ld = T; }
                pg8::EpiBf16Split E{(pg8::bf16_t*)Op, ld, 1 << 30, nullptr, 0};

#ifndef SKIP_G4
                GEMM_CALL(pg8::EpiBf16Split, Ap, Bp, M_, N_, K_, E);
#endif

            }
            GSYNC();

#ifndef SKIP_PREP2
            phase_prep2(P, l);
#endif

            GSYNC();

#ifndef PROBE_Q
#define PROBE_Q 0
#endif
#pragma unroll 1
            for (int rep = 0; rep < 1 + (PROBE_Q ? 1 : 0); ++rep) {
            for (;;) {
                __syncthreads();
                if (threadIdx.x == 0) *qslot = (int)atomicAdd(CTLW + 64 * l + 16 * rep, 1u);
                __syncthreads();
                int item = *qslot;
                if (item >= (rep ? Q_CONV0 : Q_END)) break;
                if (!rep) {
                    const int a0_ = RW_I1 + Q_SPLIT, nx_ = Q_END - Q_CONV0;
                    if (item >= a0_ && item < a0_ + nx_) { const int x_ = item - a0_; item = (x_ < 32) ? Q_P20 + x_ : Q_CONV0 + (x_ - 32); }
                    else if (item >= a0_ + nx_) item -= nx_;
                }
                if (item < RW_I1) {
                    if (rep && !(PROBE_Q & 1)) continue;
                    const int hh = item & 7, cc = item >> 3;
                    float* fin = (float*)(WSB + WS_PU) + (size_t)(hh * RW_NC + cc) * 8192;
                    rwkv_scan_pu(P, lds, hh, cc * RW_LC, RW_LC / 32, cc > 0 ? fin : nullptr, fin + 4096);
                    if (!rep) {
                        asm volatile("s_waitcnt vmcnt(0)" ::: "memory");
                        __syncthreads();
                        if (threadIdx.x == 0) { __builtin_amdgcn_fence(__ATOMIC_RELEASE, "agent"); asm volatile("s_waitcnt vmcnt(0)" ::: "memory");
                            __hip_atomic_fetch_add(CTLW + 64 * l + 32 + hh, 1u, __ATOMIC_RELAXED, __HIP_MEMORY_SCOPE_AGENT); }
                    }
                    continue;
                }
                if (item >= Q_CONV0) {
                    if (item < Q_P20) { conv_ffn_item(GPF(P.in[37]) + (size_t)l * DM * DFF, GPF(P.in[38]) + (size_t)l * DM * DFF, GPF(P.in[39]) + (size_t)l * DM * DFF, WSB, lds, item - Q_CONV0); continue; }
                    const int hh = (item - Q_P20) >> 2, part = (item - Q_P20) & 3;
                    if (threadIdx.x == 0) { unsigned spins = 0; while (__hip_atomic_load(CTLW + 64 * l + 32 + hh, __ATOMIC_RELAXED, __HIP_MEMORY_SCOPE_AGENT) < (unsigned)(RW_NC - 1) && ++spins < 4000000u) __builtin_amdgcn_s_sleep(2); }
                    __syncthreads();
                    __builtin_amdgcn_fence(__ATOMIC_ACQUIRE, "agent"); asm volatile("s_waitcnt vmcnt(0)" ::: "memory");
                    __syncthreads();
                    rwkv_pass2(P, lds, hh, part);
                    continue;
                }
                item -= RW_I1;
                if (item < 512) { if (rep && !(PROBE_Q & 2)) continue; attn_unit(P, lds, item & 7, 63 - (item >> 3)); }
                else { if (rep && !(PROBE_Q & 4)) continue; hgrn_c_unit(P, l, item - 512, lds); }
            }
            }
            GSYNC();
            for (int rep3 = 0; rep3 < 1 + ((PROBE_M & 1) ? 1 : 0); ++rep3)
            for (int it = bid; it < 8 * RW_NC; it += G) { const int hh = it & 7, cc = it >> 3;
                rwkv_scan_item<0>(P, l, lds, hh, cc * RW_LC, RW_LC / 32, cc ? (const float*)(WSB + WS_SINIT) + (size_t)(hh * RW_NC + cc) * 4096 : nullptr, nullptr); }
            GSYNC();
#pragma unroll 1
            for (int br = 0; br < 3; ++br) {
                const unsigned char* Ap = br == 0 ? WSB + WS_YA : (br == 1 ? WSB + WS_YB : WSB + WS_YC);
                pg8::EpiGate E{(const pg8::bf16_t*)(WSB + WS_P2) + C2_GATE + br * 1024, NP2, (pg8::bf16_t*)(WSB + WS_MERGED), DM, br == 0 ? 1 : 0};

#ifndef SKIP_G5
                GEMM_CALL1(pg8::EpiGate, Ap, WSB + WB_OUT + (size_t)br * 1024 * 512 * 2, T, DM, 512, E);
#endif

            }
            GSYNC();

#ifndef SKIP_G6
            { pg8::EpiBf16Split E{(pg8::bf16_t*)YB32, DM, 1 << 30, nullptr, 0}; GEMM_CALL(pg8::EpiBf16Split, WSB + WS_MERGED, WSB + WB_O, T, DM, DM, E); }
#endif

            GSYNC();
            if (PROBE_M & 8) phase_rowwise(YB32, HRES, (float*)ACTB, 1.0f, GPF(P.in[8]) + (size_t)l * DM, GPF(P.in[35]) + (size_t)l * DM, XNB);
            phase_rowwise(YB32, HRES, HRES, 1.0f, GPF(P.in[8]) + (size_t)l * DM, GPF(P.in[35]) + (size_t)l * DM, XNB);
            GSYNC();
        }
    }
}

extern "C" void kernel_launch(void* const* d_in, const int* in_sizes, int n_in, void* d_out, int out_size, void* d_ws, size_t ws_size, hipStream_t stream) {
    static int grid = 0;
    if (grid == 0) {
        if (n_in != 40 || out_size != T * DM || ws_size < WS_END) { fprintf(stderr, "kernel_launch: unexpected problem (n_in %d out %d ws %zu)\n", n_in, out_size, ws_size); grid = -1; return; }
        int dev = 0, cus = 0, per_cu = 0;
        hipGetDevice(&dev);
        hipDeviceGetAttribute(&cus, hipDeviceAttributeMultiprocessorCount, dev);
        hipFuncSetAttribute((const void*)fwd_kernel, hipFuncAttributeMaxDynamicSharedMemorySize, LDS_BYTES);
        hipOccupancyMaxActiveBlocksPerMultiprocessor(&per_cu, (const void*)fwd_kernel, 512, LDS_BYTES);
        (void)hipGetLastError();
        if (per_cu < 1) per_cu = 1;
        grid = cus;
        if (grid < 64) { grid = -1; return; }
    }
    if (grid < 0) return;
    hipMemsetAsync((char*)d_ws + WS_CTL, 0, 65536, stream);
    Params p{};
    for (int i = 0; i < 40; ++i) p.in[i] = d_in[i];
    p.out = (float*)d_out; p.ws = (unsigned char*)d_ws;
    void* args[] = {&p};
    hipError_t e = hipLaunchCooperativeKernel((const void*)fwd_kernel, dim3(grid), dim3(512), args, LDS_BYTES, stream);
    if (e != hipSuccess) fprintf(stderr, "cooperative launch failed: %s (grid %d)\n", hipGetErrorString(e), grid);
}
```
